# Optimizing an MI355X kernel written in HIP

```python
import math
import jax, jax.numpy as jnp
from jax import lax
import numpy as np


D_MODEL = 1024
BATCH = 2
SEQ = 8192
DEPTH = 1

CHUNK = 64
N_ATTN_HEADS = 8
HEAD_DIM = 64
D_ATTN = N_ATTN_HEADS * HEAD_DIM
D_LRU = D_MODEL - D_ATTN
N_LRU_BLOCKS = 8
LRU_BLOCK = D_LRU // N_LRU_BLOCKS
CONV_WIDTH = 4
LRU_C = 8.0
N_IDX_HEADS = 8
IDX_DIM = 64
TOPK_MAX = 256
Q_BLOCK = 128
NUM_BUCKETS = 32
MAX_DISTANCE = 128
D_FF = 2816
N_MOD = 9
EPS = 1e-6
SPLIT_SIZES = (D_ATTN, D_ATTN, D_ATTN, N_IDX_HEADS * IDX_DIM, IDX_DIM, N_IDX_HEADS, D_LRU, D_LRU)
D_IN = sum(SPLIT_SIZES)

kernel_name = "hymba_dsa_rglru_macaron_block"


def rmsnorm(x, g):
    xf = x.astype(jnp.float32)
    y = xf * lax.rsqrt(jnp.mean(xf * xf, axis=-1, keepdims=True) + EPS)
    return (y * g.astype(jnp.float32)).astype(x.dtype)


def modulate(h, shift, scale):
    return h * (1 + scale[:, None, :]) + shift[:, None, :]


def swiglu(h, w_gate, w_up, w_down):
    return (jax.nn.silu(h @ w_gate) * (h @ w_up)) @ w_down


def t5_bucket(rel):
    nb = NUM_BUCKETS // 2
    max_exact = nb // 2
    ret = jnp.where(rel > 0, nb, 0).astype(jnp.int32)
    n = jnp.abs(rel)
    nf = jnp.maximum(n, 1).astype(jnp.float32)
    large = max_exact + (jnp.log(nf / max_exact) / math.log(MAX_DISTANCE / max_exact)
                         * (nb - max_exact)).astype(jnp.int32)
    large = jnp.minimum(large, nb - 1)
    return ret + jnp.where(n < max_exact, n, large)


def dsa_attention(q, k, v, q_idx, k_idx, w_idx, rel_bias):
    B, S = q.shape[:2]
    topk = min(TOPK_MAX, S // 4)
    nblk = S // Q_BLOCK

    def to_blocks(a):
        return jnp.swapaxes(a.reshape((B, nblk, Q_BLOCK) + a.shape[2:]), 0, 1)

    key_pos = jnp.arange(S, dtype=jnp.int32)
    q_pos = key_pos.reshape(nblk, Q_BLOCK)
    gather = jax.vmap(lambda a, i: a[i])

    def block(args):
        qb, qib, wb, tpos = args
        idx_logits = jnp.einsum('bqhd,bsd->bqhs', qib, k_idx) * IDX_DIM ** -0.5
        score = jnp.einsum('bqhs,bqh->bqs', jax.nn.relu(idx_logits), wb).astype(jnp.float32)
        limit = (tpos // CHUNK + 1) * CHUNK
        admissible = key_pos[None, :] < limit[:, None]
        score = jnp.where(admissible[None], score, -jnp.inf)
        top_val, top_idx = lax.top_k(score, topk)
        valid = jnp.isfinite(top_val)
        kg = gather(k, top_idx)
        vg = gather(v, top_idx)
        logits = jnp.einsum('bqhd,bqkhd->bhqk', qb, kg).astype(jnp.float32) * HEAD_DIM ** -0.5
        bias = rel_bias[t5_bucket(top_idx - tpos[None, :, None])]
        logits = logits + jnp.transpose(bias, (0, 3, 1, 2)).astype(jnp.float32)
        logits = jnp.where(valid[:, None], logits, -jnp.inf)
        p = jax.nn.softmax(logits, axis=-1).astype(vg.dtype)
        return jnp.einsum('bhqk,bqkhd->bqhd', p, vg)

    out = lax.map(block, (to_blocks(q), to_blocks(q_idx), to_blocks(w_idx), q_pos))
    return jnp.swapaxes(out, 0, 1).reshape(B, S, D_ATTN)


def _lin_combine(left, right):
    a_l, b_l = left
    a_r, b_r = right
    return a_l * a_r, a_r * b_l + b_r


def rg_lru_branch(xr, gate, conv_w, conv_b, w_a, b_a, w_i, b_i, lam):
    B, S, _ = xr.shape
    xp = jnp.pad(xr, ((0, 0), (CONV_WIDTH - 1, 0), (0, 0)))
    xc = conv_b + xp[:, 0:S] * conv_w[0]
    for j in range(1, CONV_WIDTH):
        xc = xc + xp[:, j:j + S] * conv_w[j]
    xg = xc.reshape(B, S, N_LRU_BLOCKS, LRU_BLOCK)
    r = jax.nn.sigmoid(jnp.einsum('bsgi,gij->bsgj', xg, w_a).reshape(B, S, D_LRU) + b_a)
    i = jax.nn.sigmoid(jnp.einsum('bsgi,gij->bsgj', xg, w_i).reshape(B, S, D_LRU) + b_i)
    log_a = -LRU_C * r.astype(jnp.float32) * jax.nn.softplus(-lam.astype(jnp.float32))
    a = jnp.exp(log_a)
    mult = jnp.sqrt(-jnp.expm1(2.0 * log_a))
    b = mult * (i * xc).astype(jnp.float32)
    _, h = lax.associative_scan(_lin_combine, (a, b), axis=1)
    return h.astype(xr.dtype) * jax.nn.gelu(gate)


def setup_inputs(seed: int = 0) -> dict:
    key = jax.random.key(seed)
    ks = jax.random.split(key, 40)
    f32 = jnp.float32

    def nrm(k, shape, scale):
        return jax.random.normal(k, shape, f32) * scale

    def gain(k, shape):
        return 1.0 + 0.1 * jax.random.normal(k, shape, f32)

    L, D = DEPTH, D_MODEL
    a0 = jax.random.uniform(ks[20], (L, D_LRU), f32, 0.9, 0.999)
    a_base = a0 ** (1.0 / LRU_C)
    lru_lambda = jnp.log(a_base) - jnp.log1p(-a_base)
    return {
        "x": nrm(ks[0], (BATCH, SEQ, D), 1.0),
        "c": nrm(ks[1], (BATCH, D), 1.0),
        "w_ada": nrm(ks[2], (L, D, N_MOD * D), 0.5 * D ** -0.5),
        "b_ada": nrm(ks[3], (L, N_MOD * D), 0.02),
        "ffn1_pre_g": gain(ks[4], (L, D)),
        "ffn1_post_g": gain(ks[5], (L, D)),
        "ffn1_w_gate": nrm(ks[6], (L, D, D_FF), D ** -0.5),
        "ffn1_w_up": nrm(ks[7], (L, D, D_FF), D ** -0.5),
        "ffn1_w_down": nrm(ks[8], (L, D_FF, D), D_FF ** -0.5),
        "mix_pre_g": gain(ks[9], (L, D)),
        "mix_post_g": gain(ks[10], (L, D)),
        "w_in": nrm(ks[11], (L, D, D_IN), D ** -0.5),
        "rel_bias": nrm(ks[12], (NUM_BUCKETS, N_ATTN_HEADS), 0.5),
        "lru_conv_w": nrm(ks[13], (L, CONV_WIDTH, D_LRU), CONV_WIDTH ** -0.5),
        "lru_conv_b": nrm(ks[14], (L, D_LRU), 0.02),
        "lru_w_a": nrm(ks[15], (L, N_LRU_BLOCKS, LRU_BLOCK, LRU_BLOCK), LRU_BLOCK ** -0.5),
        "lru_b_a": nrm(ks[16], (L, D_LRU), 0.02),
        "lru_w_i": nrm(ks[17], (L, N_LRU_BLOCKS, LRU_BLOCK, LRU_BLOCK), LRU_BLOCK ** -0.5),
        "lru_b_i": nrm(ks[18], (L, D_LRU), 0.02),
        "lru_lambda": lru_lambda,
        "attn_out_g": gain(ks[21], (L, D_ATTN)),
        "lru_out_g": gain(ks[22], (L, D_LRU)),
        "w_out": nrm(ks[23], (L, D, D), D ** -0.5),
        "ffn2_pre_g": gain(ks[24], (L, D)),
        "ffn2_post_g": gain(ks[25], (L, D)),
        "ffn2_w_gate": nrm(ks[26], (L, D, D_FF), D ** -0.5),
        "ffn2_w_up": nrm(ks[27], (L, D, D_FF), D ** -0.5),
        "ffn2_w_down": nrm(ks[28], (L, D_FF, D), D_FF ** -0.5),
    }


def reference(x, c, w_ada, b_ada, ffn1_pre_g, ffn1_post_g, ffn1_w_gate, ffn1_w_up, ffn1_w_down,
              mix_pre_g, mix_post_g, w_in, rel_bias, lru_conv_w, lru_conv_b, lru_w_a, lru_b_a,
              lru_w_i, lru_b_i, lru_lambda, attn_out_g, lru_out_g, w_out,
              ffn2_pre_g, ffn2_post_g, ffn2_w_gate, ffn2_w_up, ffn2_w_down):
    B, S, D = x.shape
    offsets = np.cumsum(SPLIT_SIZES)[:-1].tolist()
    for l in range(DEPTH):
        mod = (jax.nn.silu(c) @ w_ada[l] + b_ada[l]).reshape(B, N_MOD, D)
        m = [mod[:, j] for j in range(N_MOD)]

        h = modulate(rmsnorm(x, ffn1_pre_g[l]), m[0], m[1])
        y = swiglu(h, ffn1_w_gate[l], ffn1_w_up[l], ffn1_w_down[l])
        x = x + 0.5 * m[2][:, None, :] * rmsnorm(y, ffn1_post_g[l])

        h = modulate(rmsnorm(x, mix_pre_g[l]), m[3], m[4])
        proj = h @ w_in[l]
        q, k, v, q_idx, k_idx, w_idx, x_lru, g_lru = jnp.split(proj, offsets, axis=-1)
        q = q.reshape(B, S, N_ATTN_HEADS, HEAD_DIM)
        k = k.reshape(B, S, N_ATTN_HEADS, HEAD_DIM)
        v = v.reshape(B, S, N_ATTN_HEADS, HEAD_DIM)
        q_idx = q_idx.reshape(B, S, N_IDX_HEADS, IDX_DIM)
        w_idx = w_idx * N_IDX_HEADS ** -0.5
        attn = dsa_attention(q, k, v, q_idx, k_idx, w_idx, rel_bias)
        lru = rg_lru_branch(x_lru, g_lru, lru_conv_w[l], lru_conv_b[l], lru_w_a[l], lru_b_a[l],
                            lru_w_i[l], lru_b_i[l], lru_lambda[l])
        merged = jnp.concatenate([rmsnorm(attn, attn_out_g[l]), rmsnorm(lru, lru_out_g[l])], axis=-1)
        y = merged @ w_out[l]
        x = x + m[5][:, None, :] * rmsnorm(y, mix_post_g[l])

        h = modulate(rmsnorm(x, ffn2_pre_g[l]), m[6], m[7])
        y = swiglu(h, ffn2_w_gate[l], ffn2_w_up[l], ffn2_w_down[l])
        x = x + 0.5 * m[8][:, None, :] * rmsnorm(y, ffn2_post_g[l])
    return x
```

```cpp
#include <hip/hip_runtime.h>
#include <cstdio>
#include <cstdint>

#ifndef MK_N_LAUNCHES
#define MK_N_LAUNCHES 1
#endif

namespace pg8 {
#define PG8_LAS __attribute__((address_space(3)))
typedef _Float16 h16;
typedef _Float16 h16x8 __attribute__((ext_vector_type(8)));
typedef _Float16 h16x2 __attribute__((ext_vector_type(2)));
typedef float f32x4 __attribute__((ext_vector_type(4)));
typedef float f32x2 __attribute__((ext_vector_type(2)));
typedef unsigned u32x4 __attribute__((ext_vector_type(4)));
constexpr int BM = 256, BK = 64, HALF = 128, HTB = HALF * BK * 2, STAGE_BYTES = 8 * HTB, NXCD = 8, WGM = 8;

__host__ __device__ __forceinline__ int lds_byte(int r, int c) { const int st = (r >> 4) * 2 + (c >> 5), rr = r & 15, cc = c & 31, ob = rr * 64 + cc * 2; return st * 1024 + (ob ^ (((ob >> 9) & 1) << 5)); }
__host__ __device__ __forceinline__ void stage_rc(int b, int& R, int& C) { const int st = b / 1024, sb = b % 1024, swz = sb ^ (((sb >> 9) & 1) << 5); R = (st >> 1) * 16 + swz / 64; C = (st & 1) * 32 + (swz % 64) / 2; }
__host__ __device__ __forceinline__ int perm32(int rho) { const int n = rho >> 4, i = rho & 15; return 8 * (i >> 2) + 4 * n + (i & 3); }

struct Unit { int pm, pn; };
struct Gemm { const h16* A; const h16* Bt; int M, N, K; };

struct StaticOrder {
    int nM, nN, nwg, G, c;
    __host__ __device__ void init(int M, int N, int G_, int c_) { nM = M / BM; nN = N / BM; nwg = nM * nN; G = G_; c = c_; }
    __host__ __device__ bool next(int i, Unit& u) const {
        const long L = (long)i * G + c; if (L >= nwg) return false;
        int wgid = (int)L; { const int q = nwg / NXCD, r = nwg % NXCD, xcd = wgid % NXCD, off = wgid / NXCD; wgid = (xcd < r ? xcd * (q + 1) : r * (q + 1) + (xcd - r) * q) + off; }
        const int nig = WGM * nN, gid = wgid / nig, fm = gid * WGM, gsz = (nM - fm) < WGM ? (nM - fm) : WGM;
        u.pm = fm + ((wgid % nig) % gsz); u.pn = (wgid % nig) / gsz; return true;
    }
    __device__ __forceinline__ void a_ready(const Unit&) const {}
    __device__ __forceinline__ void done(const Unit&) const {}
};

__device__ __forceinline__ unsigned cvt_pk_h16(float lo, float hi) { f32x2 v = {lo, hi}; h16x2 h = __builtin_convertvector(v, h16x2); return __builtin_bit_cast(unsigned, h); }

struct EpiF32 {
    static constexpr bool PERM = false, AFTER_DRAIN = false;
    float* C; int ldc;
    __device__ __forceinline__ void operator()(const f32x4 (&acc)[2][2][4][2], const Unit& u, int wr, int wc, int fr, int fq) const {
        const int row0 = u.pm * BM + wr * 64 + fr, col0 = u.pn * BM + wc * 32 + 4 * fq;
#pragma unroll
        for (int ai = 0; ai < 2; ++ai)
#pragma unroll
            for (int m = 0; m < 4; ++m) { float* rowp = C + (size_t)(row0 + ai * HALF + m * 16) * ldc + col0;
#pragma unroll
                for (int bj = 0; bj < 2; ++bj)
#pragma unroll
                    for (int n = 0; n < 2; ++n) *(f32x4*)(rowp + bj * HALF + n * 16) = acc[ai][bj][m][n]; }
    }
};
struct EpiSwiGLU {
    static constexpr bool PERM = true, AFTER_DRAIN = false;
    h16* O; int ldc;
    __device__ __forceinline__ void operator()(const f32x4 (&acc)[2][2][4][2], const Unit& u, int wr, int wc, int fr, int fq) const {
        const int row0 = u.pm * BM + wr * 64 + fr, col0 = u.pn * HALF + wc * 32 + 8 * fq;
#pragma unroll
        for (int ai = 0; ai < 2; ++ai)
#pragma unroll
            for (int m = 0; m < 4; ++m) { h16* rowp = O + (size_t)(row0 + ai * HALF + m * 16) * ldc + col0;
                float v[8];
#pragma unroll
                for (int n = 0; n < 2; ++n)
#pragma unroll
                    for (int i = 0; i < 4; ++i) { const float g = acc[ai][0][m][n][i], up = acc[ai][1][m][n][i];
                        const float e = __builtin_amdgcn_exp2f(-1.4426950408889634f * g); v[4 * n + i] = g * __builtin_amdgcn_rcpf(1.0f + e) * up; }
                u32x4 w; w.x = cvt_pk_h16(v[0], v[1]); w.y = cvt_pk_h16(v[2], v[3]); w.z = cvt_pk_h16(v[4], v[5]); w.w = cvt_pk_h16(v[6], v[7]);
                *(u32x4*)rowp = w; }
    }
};
struct EpiProj {
    static constexpr bool PERM = true, AFTER_DRAIN = false;
    unsigned char* qkv; size_t qkv_stride; float* QI; float* KW; h16* LRU;
    __device__ __forceinline__ void store_h16(const f32x4 (&acc)[2][2][4][2], h16* base, int ld, int row0, int c0) const {
#pragma unroll
        for (int ai = 0; ai < 2; ++ai)
#pragma unroll
            for (int m = 0; m < 4; ++m) { h16* rowp = base + (size_t)(row0 + ai * HALF + m * 16) * ld + c0;
#pragma unroll
                for (int bj = 0; bj < 2; ++bj) { const f32x4 v0 = acc[ai][bj][m][0], v1 = acc[ai][bj][m][1];
                    u32x4 w; w.x = cvt_pk_h16(v0[0], v0[1]); w.y = cvt_pk_h16(v0[2], v0[3]); w.z = cvt_pk_h16(v1[0], v1[1]); w.w = cvt_pk_h16(v1[2], v1[3]);
                    *(u32x4*)(rowp + bj * HALF) = w; } }
    }
    __device__ __forceinline__ void operator()(const f32x4 (&acc)[2][2][4][2], const Unit& u, int wr, int wc, int fr, int fq) const {
        const int row0 = u.pm * BM + wr * 64 + fr, cw = wc * 32 + 8 * fq; const int pn = u.pn;
        if (pn < 6) { store_h16(acc, (h16*)(qkv + (size_t)(pn >> 1) * qkv_stride), 512, row0, (pn & 1) * 256 + cw); }
        else if (pn >= 9) { store_h16(acc, LRU, 1024, row0, (pn - 9) * 256 + cw); }
        else if (pn < 8) {
            const int c0 = (pn - 6) * 256;
#pragma unroll
            for (int ai = 0; ai < 2; ++ai)
#pragma unroll
                for (int m = 0; m < 4; ++m) { float* rowp = QI + (size_t)(row0 + ai * HALF + m * 16) * 512 + c0 + cw;
#pragma unroll
                    for (int bj = 0; bj < 2; ++bj) { *(f32x4*)(rowp + bj * HALF) = acc[ai][bj][m][0]; *(f32x4*)(rowp + bj * HALF + 4) = acc[ai][bj][m][1]; } }
        } else {
#pragma unroll
            for (int ai = 0; ai < 2; ++ai)
#pragma unroll
                for (int m = 0; m < 4; ++m) { float* rowp = KW + (size_t)(row0 + ai * HALF + m * 16) * 128 + cw;
                    *(f32x4*)(rowp) = acc[ai][0][m][0]; *(f32x4*)(rowp + 4) = acc[ai][0][m][1]; }
        }
    }
};

template <class Epi, class Sched, bool ALIGN_EPI = false>
__device__ __forceinline__ void gemm_phase(PG8_LAS unsigned char* lds, const Gemm g, const Sched& S, const Epi& E) {
    const int tid = threadIdx.x, wid = __builtin_amdgcn_readfirstlane(tid >> 6), lane = tid & 63, wr = wid >> 2, wc = wid & 3, fr = lane & 15, fq = lane >> 4;
    const int K = g.K, nt = K / BK;
    unsigned voffA[2], voffB[2];
#pragma unroll
    for (int i = 0; i < 2; ++i) { int R, C; stage_rc(tid * 16 + i * 8192, R, C); const int Rb = Epi::PERM ? ((R & ~31) + perm32(R & 31)) : R;
        voffA[i] = (unsigned)(R * K + C) * 2u; voffB[i] = (unsigned)(Rb * K + C) * 2u; }
    const size_t kstep = (size_t)(BK * 2);
    const size_t hstep = (size_t)HALF * K * 2;
    const size_t tstep = 2 * hstep;
    const unsigned ldsw = (unsigned)wid * 1024u;
    const int aoff = lds_byte(wr * 64 + fr, fq * 8), boff = lds_byte(wc * 32 + fr, fq * 8);
#define PG8_SA(b, h) (((b) * 2 + (h)) * HTB)
#define PG8_SB(b, h) ((4 + (b) * 2 + (h)) * HTB)
#define PG8_STAGE(bufoff, gbase, voff) do { _Pragma("unroll") for (int _i = 0; _i < 2; ++_i) \
        __builtin_amdgcn_global_load_lds((const unsigned*)((const char*)(gbase) + (voff)[_i]), (PG8_LAS unsigned*)(lds + (bufoff) + ldsw + _i * 8192), 16, 0, 0); } while (0)
#define PG8_LDA(dst, b, h) do { _Pragma("unroll") for (int m = 0; m < 4; ++m) _Pragma("unroll") for (int k = 0; k < 2; ++k) dst[m][k] = *(const PG8_LAS h16x8*)(lds + PG8_SA(b, h) + aoff + m * 2048 + k * 1024); } while (0)
#define PG8_LDB(dst, b, h) do { _Pragma("unroll") for (int n = 0; n < 2; ++n) _Pragma("unroll") for (int k = 0; k < 2; ++k) dst[n][k] = *(const PG8_LAS h16x8*)(lds + PG8_SB(b, h) + boff + n * 2048 + k * 1024); } while (0)
#define PG8_MMA(ai, bj, At, Bt) do { __builtin_amdgcn_s_setprio(1); _Pragma("unroll") for (int m = 0; m < 4; ++m) _Pragma("unroll") for (int n = 0; n < 2; ++n) _Pragma("unroll") for (int k = 0; k < 2; ++k) \
        acc[ai][bj][m][n] = __builtin_amdgcn_mfma_f32_16x16x32_f16(Bt[n][k], At[m][k], acc[ai][bj][m][n], 0, 0, 0); __builtin_amdgcn_s_setprio(0); } while (0)
#define PG8_WAIT_V(n) asm volatile("s_waitcnt vmcnt(" #n ")" ::: "memory")
#define PG8_WAIT_L(n) asm volatile("s_waitcnt lgkmcnt(" #n ")" ::: "memory")
#define PG8_BAR __builtin_amdgcn_s_barrier()
#define PG8_SCHED __builtin_amdgcn_sched_barrier(0)
    Unit cur, nxt; int ui = 0;
    if (!S.next(0, cur)) return;
    f32x4 acc[2][2][4][2];
#pragma unroll
    for (int a = 0; a < 2; ++a)
#pragma unroll
        for (int b = 0; b < 2; ++b)
#pragma unroll
            for (int m = 0; m < 4; ++m)
#pragma unroll
                for (int n = 0; n < 2; ++n) acc[a][b][m][n] = (f32x4){0.f, 0.f, 0.f, 0.f};
    h16x8 At[4][2], B0[2][2], B1[2][2];
    const char* cA = (const char*)g.A + (size_t)cur.pm * tstep; const char* cB = (const char*)g.Bt + (size_t)cur.pn * tstep;
    S.a_ready(cur);
    PG8_STAGE(PG8_SB(0, 0), cB, voffB); PG8_STAGE(PG8_SB(0, 1), cB + hstep, voffB); PG8_STAGE(PG8_SA(0, 0), cA, voffA); PG8_STAGE(PG8_SA(0, 1), cA + hstep, voffA);
    if (wr == 1) PG8_BAR;
    PG8_WAIT_V(2); PG8_BAR;
    PG8_STAGE(PG8_SB(1, 0), cB + kstep, voffB); PG8_STAGE(PG8_SA(1, 0), cA + kstep, voffA); PG8_STAGE(PG8_SB(1, 1), cB + hstep + kstep, voffB);
    PG8_WAIT_V(6); PG8_BAR;
    for (;;) {
        const bool has_next = S.next(ui + 1, nxt);
        const char* nA = has_next ? (const char*)g.A + (size_t)nxt.pm * tstep : cA; const char* nB = has_next ? (const char*)g.Bt + (size_t)nxt.pn * tstep : cB;
        for (int t = 0; t < nt; t += 2) {
            const bool last = (t == nt - 2);
            const char* a1 = cA + (size_t)(t + 1) * kstep;
            const char* a2 = last ? nA : cA + (size_t)(t + 2) * kstep; const char* b2 = last ? nB : cB + (size_t)(t + 2) * kstep;
            const char* a3 = a2 + kstep; const char* b3 = b2 + kstep;
            if (last && has_next) S.a_ready(nxt);
            PG8_LDB(B0, 0, 0); PG8_LDB(B1, 0, 1); PG8_SCHED; PG8_LDA(At, 0, 0); PG8_STAGE(PG8_SA(1, 1), a1 + hstep, voffA);
            PG8_WAIT_V(8); PG8_WAIT_L(0); PG8_BAR; PG8_MMA(0, 0, At, B0); PG8_MMA(0, 1, At, B1); PG8_BAR; PG8_SCHED;
            PG8_LDA(At, 0, 1); PG8_STAGE(PG8_SB(0, 0), b2, voffB); PG8_STAGE(PG8_SB(0, 1), b2 + hstep, voffB); PG8_STAGE(PG8_SA(0, 0), a2, voffA);
            PG8_WAIT_V(8); PG8_WAIT_L(0); PG8_BAR; PG8_MMA(1, 0, At, B0); PG8_MMA(1, 1, At, B1); PG8_BAR; PG8_SCHED;
            PG8_LDB(B0, 1, 0); PG8_LDB(B1, 1, 1); PG8_SCHED; PG8_LDA(At, 1, 0); PG8_STAGE(PG8_SA(0, 1), a2 + hstep, voffA);
            PG8_WAIT_V(8); PG8_WAIT_L(0); PG8_BAR; PG8_MMA(0, 0, At, B0); PG8_MMA(0, 1, At, B1); PG8_BAR; PG8_SCHED;
            PG8_LDA(At, 1, 1); PG8_STAGE(PG8_SB(1, 0), b3, voffB); PG8_STAGE(PG8_SB(1, 1), b3 + hstep, voffB); PG8_STAGE(PG8_SA(1, 0), a3, voffA);
            PG8_WAIT_V(8); PG8_WAIT_L(0); PG8_BAR; PG8_MMA(1, 0, At, B0); PG8_MMA(1, 1, At, B1); PG8_BAR; PG8_SCHED;
        }
        if constexpr (ALIGN_EPI) { if (wr == 0) PG8_BAR; }
        E(acc, cur, wr, wc, fr, fq); S.done(cur);
        if (!has_next) break;
#pragma unroll
        for (int a = 0; a < 2; ++a)
#pragma unroll
            for (int b = 0; b < 2; ++b)
#pragma unroll
                for (int m = 0; m < 4; ++m)
#pragma unroll
                    for (int n = 0; n < 2; ++n) acc[a][b][m][n] = (f32x4){0.f, 0.f, 0.f, 0.f};
        cur = nxt; cA = nA; cB = nB; ++ui;
        if constexpr (ALIGN_EPI) { if (wr == 1) PG8_BAR; }
    }
    PG8_WAIT_V(0);
    if constexpr (!ALIGN_EPI) { if (wr == 0) PG8_BAR; }
    PG8_BAR;
#undef PG8_SA
#undef PG8_SB
#undef PG8_STAGE
#undef PG8_LDA
#undef PG8_LDB
#undef PG8_MMA
#undef PG8_WAIT_V
#undef PG8_WAIT_L
#undef PG8_BAR
#undef PG8_SCHED
}
}

constexpr int NWAVES = 8, NTHR = NWAVES * 64;
constexpr int N_LAUNCHES = MK_N_LAUNCHES;
constexpr int N_PHASES = 13;
constexpr int BATCH = 2, SEQ = 8192, D = 1024, FF = 2816, M = BATCH * SEQ;
constexpr int NGU = 2 * FF;
constexpr int NPROJ = 3328;
constexpr int DIN = 3144;
constexpr int NH = 8, HD = 64, DATT = 512, DLRU = 512, TOPK = 256, CHUNK = 64;
constexpr int LCH = 64, NLCH = SEQ / LCH;
constexpr float EPS = 1e-6f;

constexpr size_t MiB = 1u << 20;
constexpr size_t WS_CTL = 0, CTL_ZERO_BYTES = 1 * MiB;
constexpr size_t WS_MOD = 1 * MiB;
constexpr size_t WS_LRUS = 1 * MiB + 512 * 1024;
constexpr size_t WS_W1GU = 3 * MiB, WS_W1D = 14 * MiB, WS_WIN = 20 * MiB, WS_WOUT = 27 * MiB, WS_W2GU = 29 * MiB, WS_W2D = 40 * MiB;
constexpr size_t WS_H = 46 * MiB;
constexpr size_t WS_ACT = 78 * MiB;
constexpr size_t WS_Y = 166 * MiB;
constexpr size_t WS_Q = 78 * MiB, WS_K = 94 * MiB, WS_V = 110 * MiB;
constexpr size_t WS_QI = 126 * MiB;
constexpr size_t WS_KW = 158 * MiB;
constexpr size_t WS_LRU = 166 * MiB;
constexpr size_t WS_MERGED = WS_H;
constexpr size_t WS_END = 230 * MiB;
constexpr int CW_BAR = 4096;

constexpr int RING_OFF = 0, RING_BYTES = 131072;
constexpr int LDSCTL_OFF = RING_BYTES, MISC_OFF = LDSCTL_OFF + 320;
constexpr int LDS_BYTES = 147456;

#define GAS __attribute__((address_space(1)))
#define LAS __attribute__((address_space(3)))
typedef _Float16 h16;
typedef unsigned v4u __attribute__((ext_vector_type(4)));
typedef unsigned v2u __attribute__((ext_vector_type(2)));
typedef float f32x4 __attribute__((ext_vector_type(4)));
typedef _Float16 h16x8 __attribute__((ext_vector_type(8)));
typedef _Float16 h16x4 __attribute__((ext_vector_type(4)));
typedef GAS unsigned gu32;
#define RLX_AGENT __ATOMIC_RELAXED, __HIP_MEMORY_SCOPE_AGENT
#define LDS_WAIT() asm volatile("s_waitcnt lgkmcnt(0)" ::: "memory")
#define VM_WAIT() asm volatile("s_waitcnt vmcnt(0)" ::: "memory")
using pg8::cvt_pk_h16;

#define XB_TMO      128
#define XB_XCNT(j)  (256  + 64 * (j))
#define XB_XSUB(j)  (1280 + 64 * (j))
#define XB_XGEN(j)  (2304 + 64 * (j))
#define XB_TOP      3328
#define XB_TOPGEN   3392
#define XCD_BAR_WORDS 3456
#define XB_SPIN_CAP (1u << 18)
__device__ __forceinline__ unsigned xb_ld(unsigned* p)              { return __hip_atomic_load(p, __ATOMIC_RELAXED, __HIP_MEMORY_SCOPE_AGENT); }
__device__ __forceinline__ unsigned xb_add(unsigned* p, unsigned v) { return __hip_atomic_fetch_add(p, v, __ATOMIC_RELAXED, __HIP_MEMORY_SCOPE_AGENT); }
__device__ __forceinline__ unsigned xb_xcc_id() { return (unsigned)__builtin_amdgcn_s_getreg((3 << 11) | 20) & 0xFu; }
#define XB_SPIN(cond, bar) do { unsigned _sp = 0; while (cond) { __builtin_amdgcn_s_sleep(1); \
    if ((++_sp & 255u) == 0u) { if (xb_ld(&(bar)[XB_TMO])) break; if (_sp > XB_SPIN_CAP) { atomicAdd(&(bar)[XB_TMO], 1u); break; } } } } while (0)
struct XcdBarrier { unsigned* bar; unsigned x; volatile LAS unsigned* st; };
__device__ __forceinline__ XcdBarrier xcd_barrier_post(unsigned* bar, volatile LAS unsigned* st) {
    XcdBarrier b; b.bar = bar; b.x = xb_xcc_id(); b.st = st;
    if (threadIdx.x == 0) (void)xb_add(&bar[XB_XCNT(b.x)], 1u);
    return b;
}
__device__ __forceinline__ void xcd_barrier_complete(unsigned* bar, unsigned x, unsigned& nloc, unsigned& nx) {
    const unsigned G = gridDim.x * gridDim.y * gridDim.z;
    unsigned sum, cnt, mine, sp = 0u;
    for (;;) {
        sum = 0u; cnt = 0u; mine = 0u;
#pragma unroll
        for (unsigned j = 0; j < 16; ++j) { const unsigned c = xb_ld(&bar[XB_XCNT(j)]); sum += c; cnt += (c > 0u) ? 1u : 0u; mine = (j == x) ? c : mine; }
        if (sum == G) break;
        __builtin_amdgcn_s_sleep(1);
        if ((++sp & 255u) == 0u) { if (xb_ld(&bar[XB_TMO])) break; if (sp > XB_SPIN_CAP) { atomicAdd(&bar[XB_TMO], 1u); break; } }
    }
    nloc = mine > 0u ? mine : 1u; nx = cnt > 0u ? cnt : 1u;
}
__device__ __forceinline__ void xcd_barrier(const XcdBarrier& b) {
    asm volatile("s_waitcnt vmcnt(0)" ::: "memory");
    __syncthreads();
    if (threadIdx.x == 0) {
        unsigned* bar = b.bar;
        __builtin_amdgcn_s_waitcnt(0);
        unsigned nloc = b.st[0], nx = b.st[1];
        if (nloc == 0u) { xcd_barrier_complete(bar, b.x, nloc, nx); b.st[0] = nloc; b.st[1] = nx; }
        const unsigned old = xb_add(&bar[XB_XSUB(b.x)], 1u);
        const unsigned gen = old / nloc;
        if (old + 1u == (gen + 1u) * nloc) {
            __builtin_amdgcn_fence(__ATOMIC_RELEASE, "agent");
            asm volatile("s_waitcnt vmcnt(0)" ::: "memory");
            const unsigned og = xb_add(&bar[XB_TOP], 1u);
            const unsigned tg = og / nx;
            if (og + 1u == (tg + 1u) * nx) xb_add(&bar[XB_TOPGEN], 1u);
            else XB_SPIN(xb_ld(&bar[XB_TOPGEN]) == tg, bar);
            __builtin_amdgcn_fence(__ATOMIC_ACQUIRE, "agent");
            xb_add(&bar[XB_XGEN(b.x)], 1u);
            asm volatile("s_waitcnt vmcnt(0)" ::: "memory");
        } else {
            XB_SPIN(xb_ld(&bar[XB_XGEN(b.x)]) == gen, bar);
            __builtin_amdgcn_fence(__ATOMIC_ACQUIRE, "agent");
            asm volatile("s_waitcnt vmcnt(0)" ::: "memory");
        }
    }
    __syncthreads();
}

struct Frame {
    LAS unsigned char* lds;
    volatile LAS unsigned* MISC;
    gu32* ctl;
    int tid, lane, wave;
    int vcu, G;
};
struct Args { const float* in[28]; float* out; unsigned char* ws; int ph_lo, ph_hi, li, pad; };

__device__ __forceinline__ float wave_sum(float v) {
#pragma unroll
    for (int o = 1; o < 64; o <<= 1) v += __shfl_xor(v, o);
    return v;
}
__device__ __forceinline__ float wave_max(float v) {
#pragma unroll
    for (int o = 1; o < 64; o <<= 1) v = fmaxf(v, __shfl_xor(v, o));
    return v;
}

struct MapId { __device__ __forceinline__ int operator()(int n) const { return n; } };
struct MapGU { int half; __device__ __forceinline__ int operator()(int n) const { return (n >> 7) * 256 + half * 128 + (n & 127); } };
struct MapIn { __device__ __forceinline__ int operator()(int n) const { return n < 2120 ? n : n + 184; } };
template <class RowMap>
__device__ __forceinline__ void p0_transpose_item(const float* W, int K, int N, h16* WT, RowMap rm, LAS float* scr, int item, int lane) {
    const int nblk = (N + 31) / 32, kb = item / nblk, nb = item % nblk, k0 = 64 * kb, n0 = 32 * nb;
    const int nl = n0 + (lane & 31);
#pragma unroll 8
    for (int i = 0; i < 32; ++i) { const int kk = 2 * i + (lane >> 5); scr[kk * 33 + (lane & 31)] = (nl < N) ? W[(size_t)(k0 + kk) * N + nl] : 0.f; }
    LDS_WAIT(); asm volatile("" ::: "memory");
    const int c = lane & 7;
#pragma unroll
    for (int j = 0; j < 4; ++j) { const int nn = (lane >> 3) + 8 * j; const LAS float* s = scr + (8 * c) * 33 + nn;
        v4u o; o.x = cvt_pk_h16(s[0 * 33], s[1 * 33]); o.y = cvt_pk_h16(s[2 * 33], s[3 * 33]); o.z = cvt_pk_h16(s[4 * 33], s[5 * 33]); o.w = cvt_pk_h16(s[6 * 33], s[7 * 33]);
        if (n0 + nn < N) *(GAS v4u*)(WT + (size_t)rm(n0 + nn) * K + k0 + 8 * c) = o; }
    LDS_WAIT(); asm volatile("" ::: "memory");
}

__device__ __forceinline__ void p0_prologue(Frame& F, const Args& A) {
    unsigned char* ws = A.ws;
    if (blockIdx.x < 36) {
        LAS float* sc = (LAS float*)(F.lds);
        LAS float* red = (LAS float*)(F.lds + 8192);
        const float* c = A.in[1];
        for (int i = F.tid; i < 2048; i += NTHR) { const float v = c[i]; sc[i] = v / (1.0f + __expf(-v)); }
        __syncthreads();
        const float* wa = A.in[2]; const int col = blockIdx.x * 256 + 4 * F.lane;
        f32x4 a0 = {0.f, 0.f, 0.f, 0.f}, a1 = {0.f, 0.f, 0.f, 0.f};
        const int kb = F.wave * 128;
#pragma unroll 8
        for (int k = 0; k < 128; ++k) { const f32x4 w = *(const f32x4*)(wa + (size_t)(kb + k) * 9216 + col); a0 += w * sc[kb + k]; a1 += w * sc[1024 + kb + k]; }
        *(LAS f32x4*)(red + (F.wave * 2 + 0) * 256 + 4 * F.lane) = a0; *(LAS f32x4*)(red + (F.wave * 2 + 1) * 256 + 4 * F.lane) = a1;
        __syncthreads();
        { const int b = F.tid >> 8, j = F.tid & 255; float s = 0.f;
#pragma unroll
          for (int w = 0; w < 8; ++w) s += red[(w * 2 + b) * 256 + j];
          const int cc = blockIdx.x * 256 + j; ((float*)(ws + WS_MOD))[b * 9216 + cc] = s + A.in[3][cc]; }
        __syncthreads();
    }
    LAS float* scr = (LAS float*)(F.lds + RING_OFF + F.wave * 16384);
    const int gw = F.vcu * NWAVES + F.wave, NGW = F.G * NWAVES;
    constexpr int I_GU = (D / 64) * (FF / 32), I_DN = (FF / 64) * (D / 32), I_IN = (D / 64) * ((DIN + 31) / 32), I_OUT = (D / 64) * (D / 32);
    constexpr int NITEMS = 6 * I_GU + I_IN + I_OUT; static_assert(I_GU == I_DN, "items");
    h16* W1GU = (h16*)(ws + WS_W1GU); h16* W1D = (h16*)(ws + WS_W1D); h16* WIN = (h16*)(ws + WS_WIN); h16* WOUT = (h16*)(ws + WS_WOUT); h16* W2GU = (h16*)(ws + WS_W2GU); h16* W2D = (h16*)(ws + WS_W2D);
    for (int it = gw; it < NITEMS; it += NGW) {
        int r = it;
        if (r < I_GU) { p0_transpose_item(A.in[6], D, FF, W1GU, MapGU{0}, scr, r, F.lane); continue; } r -= I_GU;
        if (r < I_GU) { p0_transpose_item(A.in[7], D, FF, W1GU, MapGU{1}, scr, r, F.lane); continue; } r -= I_GU;
        if (r < I_DN) { p0_transpose_item(A.in[8], FF, D, W1D, MapId{}, scr, r, F.lane); continue; } r -= I_DN;
        if (r < I_IN) { p0_transpose_item(A.in[11], D, DIN, WIN, MapIn{}, scr, r, F.lane); continue; } r -= I_IN;
        if (r < I_OUT) { p0_transpose_item(A.in[22], D, D, WOUT, MapId{}, scr, r, F.lane); continue; } r -= I_OUT;
        if (r < I_GU) { p0_transpose_item(A.in[25], D, FF, W2GU, MapGU{0}, scr, r, F.lane); continue; } r -= I_GU;
        if (r < I_GU) { p0_transpose_item(A.in[26], D, FF, W2GU, MapGU{1}, scr, r, F.lane); continue; } r -= I_GU;
        p0_transpose_item(A.in[27], FF, D, W2D, MapId{}, scr, r, F.lane);
    }
    for (int i = blockIdx.x * NTHR + F.tid; i < 184 * 128; i += F.G * NTHR) *(GAS v4u*)(WIN + (size_t)2120 * D + (size_t)i * 8) = (v4u){0u, 0u, 0u, 0u};
}

template <bool HAS_Y, bool HAS_H>
__device__ __forceinline__ void thin_phase(Frame& F, const float* mod, const float* yin, const float* gpost, float gscale, int mg,
                                           const float* xin, float* xout, const float* gpre, int msh, int msc, h16* hout) {
    LAS float* TA = (LAS float*)(F.lds); LAS float* TB = TA + 2048; LAS float* TC = TB + 2048;
    for (int i = F.tid; i < 2048; i += NTHR) { const int b = i >> 10, cidx = i & 1023;
        if (HAS_Y) TA[i] = gscale * mod[b * 9216 + mg * 1024 + cidx] * gpost[cidx];
        if (HAS_H) { TB[i] = gpre[cidx] * (1.0f + mod[b * 9216 + msc * 1024 + cidx]); TC[i] = mod[b * 9216 + msh * 1024 + cidx]; } }
    __syncthreads();
    const int gw = F.vcu * NWAVES + F.wave, NGW = F.G * NWAVES;
    for (int row = gw; row < M; row += NGW) {
        const int b = row >> 13;
        const GAS f32x4* xr = (const GAS f32x4*)(xin + (size_t)row * D) + F.lane;
        f32x4 x[4];
#pragma unroll
        for (int j = 0; j < 4; ++j) x[j] = xr[64 * j];
        if (HAS_Y) {
            const GAS f32x4* yr = (const GAS f32x4*)(yin + (size_t)row * D) + F.lane;
            f32x4 y[4]; float s = 0.f;
#pragma unroll
            for (int j = 0; j < 4; ++j) { y[j] = yr[64 * j]; s += (y[j].x * y[j].x + y[j].y * y[j].y) + (y[j].z * y[j].z + y[j].w * y[j].w); }
            const float rstd = 1.0f / sqrtf(wave_sum(s) * (1.0f / D) + EPS);
            GAS f32x4* xo = (GAS f32x4*)(xout + (size_t)row * D) + F.lane;
#pragma unroll
            for (int j = 0; j < 4; ++j) { const f32x4 ta = *(const LAS f32x4*)(TA + b * 1024 + 4 * F.lane + 256 * j); x[j] = x[j] + ta * (y[j] * rstd); xo[64 * j] = x[j]; }
        }
        if (HAS_H) {
            float s = 0.f;
#pragma unroll
            for (int j = 0; j < 4; ++j) s += (x[j].x * x[j].x + x[j].y * x[j].y) + (x[j].z * x[j].z + x[j].w * x[j].w);
            const float rstd = 1.0f / sqrtf(wave_sum(s) * (1.0f / D) + EPS);
            GAS v2u* ho = (GAS v2u*)(hout + (size_t)row * D) + F.lane;
#pragma unroll
            for (int j = 0; j < 4; ++j) { const f32x4 tb = *(const LAS f32x4*)(TB + b * 1024 + 4 * F.lane + 256 * j), tc = *(const LAS f32x4*)(TC + b * 1024 + 4 * F.lane + 256 * j);
                const f32x4 h = (x[j] * rstd) * tb + tc; v2u o; o.x = cvt_pk_h16(h.x, h.y); o.y = cvt_pk_h16(h.z, h.w); ho[64 * j] = o; }
        }
    }
    __syncthreads();
}

__device__ __forceinline__ float gelu_tanh(float x) { const float u = 0.7978845608028654f * (x + 0.044715f * x * x * x); const float e = __expf(2.0f * u); const float t = 1.0f - 2.0f / (e + 1.0f); return 0.5f * x * (1.0f + t); }
template <bool PASS_B>
__device__ __forceinline__ void lru_phase(Frame& F, const Args& A) {
    unsigned char* ws = A.ws;
    const h16* LRU = (const h16*)(ws + WS_LRU); float* SA = (float*)(ws + WS_LRUS); float* SB = SA + BATCH * NLCH * DLRU;
    h16* MERGED = (h16*)(ws + WS_MERGED);
    const int ch = F.tid, g = F.wave, j = F.lane;
    LAS float* XC = (LAS float*)(F.lds);
    LAS float* OT = (LAS float*)(F.lds + 32768);
    float wa[64], wi[64];
#pragma unroll
    for (int i = 0; i < 64; ++i) { wa[i] = A.in[15][(g * 64 + i) * 64 + j]; wi[i] = A.in[17][(g * 64 + i) * 64 + j]; }
    const float cw0 = A.in[13][0 * DLRU + ch], cw1 = A.in[13][1 * DLRU + ch], cw2 = A.in[13][2 * DLRU + ch], cw3 = A.in[13][3 * DLRU + ch], cb = A.in[14][ch];
    const float ba = A.in[16][ch], bi = A.in[18][ch];
    const float lam = A.in[19][ch]; const float sp = (lam < -15.f) ? -lam : log1pf(__expf(-lam));
    const float og = A.in[21][ch];
    for (int task = blockIdx.x; task < BATCH * NLCH; task += F.G) {
        const int b = task / NLCH, c = task % NLCH, t0 = c * LCH;
        const h16* xb = LRU + (size_t)(b * SEQ) * 1024;
        float h = 0.f, Aprod = 1.f;
        if (PASS_B) { for (int cc = 0; cc < c; ++cc) { const float a_ = SA[(b * NLCH + cc) * DLRU + ch], b_ = SB[(b * NLCH + cc) * DLRU + ch]; h = a_ * h + b_; } }
        float xm3 = (t0 >= 3) ? (float)xb[(size_t)(t0 - 3) * 1024 + ch] : 0.f, xm2 = (t0 >= 2) ? (float)xb[(size_t)(t0 - 2) * 1024 + ch] : 0.f, xm1 = (t0 >= 1) ? (float)xb[(size_t)(t0 - 1) * 1024 + ch] : 0.f;
        for (int s0 = 0; s0 < LCH; s0 += 16) {
            float xcr[16];
#pragma unroll
            for (int tt = 0; tt < 16; ++tt) { const float x0 = (float)xb[(size_t)(t0 + s0 + tt) * 1024 + ch];
                const float xc = cb + xm3 * cw0 + xm2 * cw1 + xm1 * cw2 + x0 * cw3; xm3 = xm2; xm2 = xm1; xm1 = x0; xcr[tt] = xc; XC[tt * 512 + ch] = xc; }
            __syncthreads();
#pragma unroll
            for (int tt = 0; tt < 16; ++tt) {
                float ra = 0.f, ri = 0.f;
#pragma unroll
                for (int i4 = 0; i4 < 16; ++i4) { const f32x4 xv = *(const LAS f32x4*)(XC + tt * 512 + g * 64 + 4 * i4);
                    ra += xv.x * wa[4 * i4] + xv.y * wa[4 * i4 + 1] + xv.z * wa[4 * i4 + 2] + xv.w * wa[4 * i4 + 3];
                    ri += xv.x * wi[4 * i4] + xv.y * wi[4 * i4 + 1] + xv.z * wi[4 * i4 + 2] + xv.w * wi[4 * i4 + 3]; }
                const float r = 1.0f / (1.0f + __expf(-(ra + ba))), ig = 1.0f / (1.0f + __expf(-(ri + bi)));
                const float log_a = -8.0f * r * sp; const float a = __expf(log_a); const float mult = sqrtf(-expm1f(2.0f * log_a));
                const float bb = mult * (ig * xcr[tt]);
                h = a * h + bb; Aprod *= a;
                if (PASS_B) { const float gt = (float)xb[(size_t)(t0 + s0 + tt) * 1024 + 512 + ch]; OT[tt * 512 + ch] = h * gelu_tanh(gt); }
            }
            __syncthreads();
            if (PASS_B) {
#pragma unroll
                for (int k = 0; k < 2; ++k) { const int tt = F.wave + 8 * k;
                    const f32x4 o0 = *(const LAS f32x4*)(OT + tt * 512 + 8 * j), o1 = *(const LAS f32x4*)(OT + tt * 512 + 8 * j + 4);
                    float s = (o0.x * o0.x + o0.y * o0.y) + (o0.z * o0.z + o0.w * o0.w) + (o1.x * o1.x + o1.y * o1.y) + (o1.z * o1.z + o1.w * o1.w);
                    const float rstd = 1.0f / sqrtf(wave_sum(s) * (1.0f / DLRU) + EPS);
                    const f32x4 g0 = *(const f32x4*)(A.in[21] + 8 * j), g1 = *(const f32x4*)(A.in[21] + 8 * j + 4);
                    v4u o; o.x = cvt_pk_h16(o0.x * rstd * g0.x, o0.y * rstd * g0.y); o.y = cvt_pk_h16(o0.z * rstd * g0.z, o0.w * rstd * g0.w);
                    o.z = cvt_pk_h16(o1.x * rstd * g1.x, o1.y * rstd * g1.y); o.w = cvt_pk_h16(o1.z * rstd * g1.z, o1.w * rstd * g1.w);
                    *(GAS v4u*)(MERGED + (size_t)(b * SEQ + t0 + s0 + tt) * 1024 + 512 + 8 * j) = o; }
                __syncthreads();
            }
        }
        if (!PASS_B) { SA[(b * NLCH + c) * DLRU + ch] = Aprod; SB[(b * NLCH + c) * DLRU + ch] = h; }
    }
    (void)og;
}

__device__ __forceinline__ unsigned ord_key(float f) { const unsigned u = __float_as_uint(f); return u ^ ((u >> 31) ? 0xFFFFFFFFu : 0x80000000u); }
__device__ __forceinline__ int t5_bucket(int rel) {
    const int n = rel < 0 ? -rel : rel; int large;
    if (n < 12) large = 8; else if (n < 16) large = 9; else if (n < 23) large = 10; else if (n < 32) large = 11; else if (n < 46) large = 12; else if (n < 64) large = 13; else if (n < 91) large = 14; else large = 15;
    return (rel > 0 ? 16 : 0) + (n < 8 ? n : large);
}
__device__ __forceinline__ void attn_naive_phase(Frame& F, const Args& A) {
    unsigned char* ws = A.ws;
    const h16* Qb = (const h16*)(ws + WS_Q); const h16* Kb = (const h16*)(ws + WS_K); const h16* Vb = (const h16*)(ws + WS_V);
    const float* QI = (const float*)(ws + WS_QI); const float* KW = (const float*)(ws + WS_KW);
    h16* MERGED = (h16*)(ws + WS_MERGED);
    const float* relb = A.in[12]; const float* ag = A.in[20];
    LAS float* s_score = (LAS float*)(F.lds);
    LAS float* s_qi = (LAS float*)(F.lds + 32768);
    LAS float* s_q = (LAS float*)(F.lds + 32768 + 2048);
    LAS float* s_p = (LAS float*)(F.lds + 32768 + 4096);
    LAS int* s_sel = (LAS int*)(F.lds + 32768 + 4096 + 8192);
    LAS unsigned* s_hist = (LAS unsigned*)(F.lds + 32768 + 4096 + 8192 + 1024);
    LAS float* s_w = (LAS float*)(F.lds + 32768 + 4096 + 8192 + 2048);
    LAS unsigned* s_ctl = (LAS unsigned*)(F.lds + 32768 + 4096 + 8192 + 2048 + 64);
    LAS float* s_red = (LAS float*)(F.lds + 32768 + 4096 + 8192 + 2048 + 128);
    const int tid = F.tid;
    for (int q = blockIdx.x; q < M; q += F.G) {
        const int b = q >> 13, t = q & (SEQ - 1); const int N = ((t >> 6) + 1) << 6;
        s_qi[tid] = QI[(size_t)q * 512 + tid];
        s_q[tid] = (float)Qb[(size_t)q * 512 + tid];
        if (tid < 8) s_w[tid] = KW[(size_t)q * 128 + 64 + tid] * 0.35355339059327373f;
        __syncthreads();
        for (int s = tid; s < N; s += NTHR) {
            const float* kr = KW + (size_t)(b * SEQ + s) * 128;
            f32x4 kv[16];
#pragma unroll
            for (int i = 0; i < 16; ++i) kv[i] = *(const f32x4*)(kr + 4 * i);
            float sc = 0.f;
#pragma unroll
            for (int h = 0; h < 8; ++h) { float d = 0.f;
#pragma unroll
                for (int i = 0; i < 16; ++i) { const f32x4 qv = *(const LAS f32x4*)(s_qi + h * 64 + 4 * i); d += qv.x * kv[i].x + qv.y * kv[i].y + qv.z * kv[i].z + qv.w * kv[i].w; }
                sc += fmaxf(d * 0.125f, 0.f) * s_w[h]; }
            s_score[s] = sc;
        }
        __syncthreads();
        float thr = -INFINITY; unsigned idx_cut = 0xFFFFFFFFu;
        if (N > TOPK) {
            unsigned prefix = 0u, mask = 0u; unsigned remaining = TOPK; unsigned n_eq = 0;
            for (int pass = 0; pass < 4; ++pass) {
                const int shift = 24 - 8 * pass;
                if (tid < 256) s_hist[tid] = 0u;
                __syncthreads();
                for (int s = tid; s < N; s += NTHR) { const unsigned key = ord_key(s_score[s]); if ((key & mask) == prefix) atomicAdd((unsigned*)&s_hist[(key >> shift) & 255u], 1u); }
                __syncthreads();
                if (F.wave == 0) {
                    const int l = F.lane; const unsigned h0 = s_hist[4 * l], h1 = s_hist[4 * l + 1], h2 = s_hist[4 * l + 2], h3 = s_hist[4 * l + 3];
                    unsigned v = h0 + h1 + h2 + h3;
#pragma unroll
                    for (int off = 1; off < 64; off <<= 1) { const unsigned tv = __shfl_down(v, off); if (l + off < 64) v += tv; }
                    unsigned above = __shfl_down(v, 1); if (l == 63) above = 0u;
                    if (v >= remaining && above < remaining) {
                        unsigned cum = above; int dsel; unsigned rem; unsigned hv;
                        if (cum + h3 >= remaining) { dsel = 3; rem = remaining - cum; hv = h3; }
                        else { cum += h3; if (cum + h2 >= remaining) { dsel = 2; rem = remaining - cum; hv = h2; }
                        else { cum += h2; if (cum + h1 >= remaining) { dsel = 1; rem = remaining - cum; hv = h1; }
                        else { cum += h1; dsel = 0; rem = remaining - cum; hv = h0; } } }
                        s_ctl[0] = (unsigned)(4 * l + dsel); s_ctl[1] = rem; s_ctl[4] = hv;
                    }
                }
                __syncthreads();
                prefix |= s_ctl[0] << shift; mask |= 255u << shift; remaining = s_ctl[1]; n_eq = s_ctl[4];
                __syncthreads();
            }
            const unsigned tk = prefix; const unsigned tu = (tk & 0x80000000u) ? (tk ^ 0x80000000u) : ~tk; thr = __uint_as_float(tu);
            if (n_eq > remaining) {
                if (tid == 0) { unsigned cnt = 0, cut = 0; for (int s = 0; s < N; ++s) if (s_score[s] == thr) { ++cnt; if (cnt == remaining) { cut = (unsigned)s; break; } } s_ctl[3] = cut; }
                __syncthreads();
                idx_cut = s_ctl[3];
            }
        }
        if (tid == 0) s_ctl[2] = 0u;
        __syncthreads();
        for (int s = tid; s < N; s += NTHR) { const float sc = s_score[s];
            const bool sel = (N <= TOPK) || (sc > thr) || (sc == thr && (unsigned)s <= idx_cut);
            if (sel) { const unsigned pos = atomicAdd((unsigned*)&s_ctl[2], 1u); if (pos < TOPK) s_sel[pos] = s; } }
        __syncthreads();
        const int nsel = (int)(s_ctl[2] < (unsigned)TOPK ? s_ctl[2] : (unsigned)TOPK);
        { const int jx = tid & 255, hg = tid >> 8;
          if (jx < nsel) { const int s = s_sel[jx]; const h16* kr = Kb + (size_t)(b * SEQ + s) * 512 + hg * 256; const int bk = t5_bucket(s - t);
#pragma unroll
              for (int hh = 0; hh < 4; ++hh) { float d = 0.f;
#pragma unroll
                  for (int i = 0; i < 8; ++i) { const h16x8 kv = *(const h16x8*)(kr + hh * 64 + 8 * i);
#pragma unroll
                      for (int e = 0; e < 8; ++e) d += s_q[(hg * 4 + hh) * 64 + 8 * i + e] * (float)kv[e]; }
                  s_p[(hg * 4 + hh) * 256 + jx] = d * 0.125f + relb[bk * 8 + hg * 4 + hh]; } }
          else {
#pragma unroll
              for (int hh = 0; hh < 4; ++hh) s_p[(hg * 4 + hh) * 256 + jx] = -INFINITY; } }
        __syncthreads();
        { const int h = F.wave; float v0 = s_p[h * 256 + F.lane], v1 = s_p[h * 256 + 64 + F.lane], v2 = s_p[h * 256 + 128 + F.lane], v3 = s_p[h * 256 + 192 + F.lane];
          const float mx = wave_max(fmaxf(fmaxf(v0, v1), fmaxf(v2, v3)));
          v0 = __expf(v0 - mx); v1 = __expf(v1 - mx); v2 = __expf(v2 - mx); v3 = __expf(v3 - mx);
          const float inv = 1.0f / wave_sum((v0 + v1) + (v2 + v3));
          s_p[h * 256 + F.lane] = v0 * inv; s_p[h * 256 + 64 + F.lane] = v1 * inv; s_p[h * 256 + 128 + F.lane] = v2 * inv; s_p[h * 256 + 192 + F.lane] = v3 * inv; }
        __syncthreads();
        float o = 0.f;
        { const int h = tid >> 6; const h16* vb = Vb + (size_t)(b * SEQ) * 512 + tid;
          for (int jx = 0; jx < nsel; ++jx) o += s_p[h * 256 + jx] * (float)vb[(size_t)s_sel[jx] * 512]; }
        const float ss = wave_sum(o * o);
        if (F.lane == 0) s_red[F.wave] = ss;
        __syncthreads();
        float tot = 0.f;
#pragma unroll
        for (int w = 0; w < 8; ++w) tot += s_red[w];
        const float rstd = 1.0f / sqrtf(tot * (1.0f / DATT) + EPS);
        MERGED[(size_t)q * 1024 + tid] = (h16)(o * rstd * ag[tid]);
        __syncthreads();
    }
}

__global__ void __launch_bounds__(NTHR, 2) fwd_kernel(Args args) {
    extern __shared__ __attribute__((aligned(16))) unsigned char lds[];
    Frame F;
    F.lds = (LAS unsigned char*)lds;
    F.MISC = (volatile LAS unsigned*)(F.lds + MISC_OFF);
    F.tid = threadIdx.x; F.lane = F.tid & 63; F.wave = __builtin_amdgcn_readfirstlane(F.tid >> 6);
    F.G = gridDim.x; { const int bx = blockIdx.x; F.vcu = (F.G % 8 == 0) ? (bx % 8) * (F.G / 8) + bx / 8 : bx; }
    unsigned char* ws = args.ws;
    F.ctl = (gu32*)(ws + WS_CTL);
    for (int u = F.tid; u < (LDS_BYTES - LDSCTL_OFF) / 4; u += NTHR) ((LAS unsigned*)(F.lds + LDSCTL_OFF))[u] = 0u;
    __syncthreads();
    XcdBarrier bar; bar.bar = (unsigned*)(F.ctl + CW_BAR); bar.x = 0; bar.st = nullptr;
    if (N_LAUNCHES == 1) bar = xcd_barrier_post((unsigned*)(F.ctl + CW_BAR), F.MISC + 8);
    const int lo = args.ph_lo, hi = args.ph_hi;
#define IN(k) (lo <= (k) && (k) < hi)
#define SEAM(k) do { if (IN(k) && IN((k) + 1)) xcd_barrier(bar); } while (0)
    const float* mod = (const float*)(ws + WS_MOD);
    h16* H = (h16*)(ws + WS_H); h16* ACT = (h16*)(ws + WS_ACT); float* Y = (float*)(ws + WS_Y);
    const int bx = (int)blockIdx.x;

    if (IN(0)) { p0_prologue(F, args); } SEAM(0);
    if (IN(1)) { thin_phase<false, true>(F, mod, nullptr, nullptr, 0.f, 0, args.in[0], nullptr, args.in[4], 0, 1, H); } SEAM(1);
    if (IN(2)) { pg8::Gemm g{H, (const h16*)(ws + WS_W1GU), M, NGU, D}; pg8::StaticOrder S; S.init(M, NGU, F.G, bx);
        pg8::EpiSwiGLU E{ACT, FF}; pg8::gemm_phase<pg8::EpiSwiGLU, pg8::StaticOrder, true>(F.lds + RING_OFF, g, S, E); } SEAM(2);
    if (IN(3)) { pg8::Gemm g{ACT, (const h16*)(ws + WS_W1D), M, D, FF}; pg8::StaticOrder S; S.init(M, D, F.G, bx);
        pg8::EpiF32 E{Y, D}; pg8::gemm_phase<pg8::EpiF32, pg8::StaticOrder, false>(F.lds + RING_OFF, g, S, E); } SEAM(3);
    if (IN(4)) { thin_phase<true, true>(F, mod, Y, args.in[5], 0.5f, 2, args.in[0], args.out, args.in[9], 3, 4, H); } SEAM(4);
    if (IN(5)) { pg8::Gemm g{H, (const h16*)(ws + WS_WIN), M, NPROJ, D}; pg8::StaticOrder S; S.init(M, NPROJ, F.G, bx);
        pg8::EpiProj E{ws + WS_Q, (size_t)(WS_K - WS_Q), (float*)(ws + WS_QI), (float*)(ws + WS_KW), (h16*)(ws + WS_LRU)};
        pg8::gemm_phase<pg8::EpiProj, pg8::StaticOrder, true>(F.lds + RING_OFF, g, S, E); } SEAM(5);
    if (IN(6)) { lru_phase<false>(F, args); } SEAM(6);
    if (IN(7)) { lru_phase<true>(F, args); __syncthreads(); attn_naive_phase(F, args); } SEAM(7);
    if (IN(8)) { pg8::Gemm g{(const h16*)(ws + WS_MERGED), (const h16*)(ws + WS_WOUT), M, D, D}; pg8::StaticOrder S; S.init(M, D, F.G, bx);
        pg8::EpiF32 E{Y, D}; pg8::gemm_phase<pg8::EpiF32, pg8::StaticOrder, false>(F.lds + RING_OFF, g, S, E); } SEAM(8);
    if (IN(9)) { thin_phase<true, true>(F, mod, Y, args.in[10], 1.0f, 5, args.out, args.out, args.in[23], 6, 7, H); } SEAM(9);
    if (IN(10)) { pg8::Gemm g{H, (const h16*)(ws + WS_W2GU), M, NGU, D}; pg8::StaticOrder S; S.init(M, NGU, F.G, bx);
        pg8::EpiSwiGLU E{ACT, FF}; pg8::gemm_phase<pg8::EpiSwiGLU, pg8::StaticOrder, true>(F.lds + RING_OFF, g, S, E); } SEAM(10);
    if (IN(11)) { pg8::Gemm g{ACT, (const h16*)(ws + WS_W2D), M, D, FF}; pg8::StaticOrder S; S.init(M, D, F.G, bx);
        pg8::EpiF32 E{Y, D}; pg8::gemm_phase<pg8::EpiF32, pg8::StaticOrder, false>(F.lds + RING_OFF, g, S, E); } SEAM(11);
    if (IN(12)) { thin_phase<true, false>(F, mod, Y, args.in[24], 0.5f, 8, args.out, args.out, nullptr, 0, 0, nullptr); }
#undef IN
#undef SEAM
}

extern "C" void kernel_launch(void* const* d_in, const int* in_sizes, int n_in, void* d_out, int out_size, void* d_ws, size_t ws_size, hipStream_t stream) {
    static int grid = 0;
    if (grid == 0) {
        if (n_in != 28 || in_sizes[0] != M * D || out_size != M * D || ws_size < WS_END) { fprintf(stderr, "kernel_launch: unexpected shapes (n_in %d, in0 %d, out %d, ws %zu); nothing launched\n", n_in, n_in > 0 ? in_sizes[0] : -1, out_size, ws_size); grid = -1; return; }
        int dev = 0, cus = 0, per_cu = 0;
        if (hipGetDevice(&dev) != hipSuccess || hipDeviceGetAttribute(&cus, hipDeviceAttributeMultiprocessorCount, dev) != hipSuccess) { grid = -1; return; }
        if (hipFuncSetAttribute((const void*)fwd_kernel, hipFuncAttributeMaxDynamicSharedMemorySize, LDS_BYTES) != hipSuccess) { fprintf(stderr, "kernel_launch: hipFuncSetAttribute failed\n"); grid = -1; return; }
        if (hipOccupancyMaxActiveBlocksPerMultiprocessor(&per_cu, (const void*)fwd_kernel, NTHR, LDS_BYTES) != hipSuccess || per_cu < 1) { fprintf(stderr, "kernel_launch: occupancy query reports %d\n", per_cu); }
        (void)hipGetLastError();
        grid = cus;
    }
    if (grid < 0) return;
    if (hipMemsetAsync((char*)d_ws + WS_CTL, 0, CTL_ZERO_BYTES, stream) != hipSuccess) return;
    Args a{};
    for (int i = 0; i < 28; ++i) a.in[i] = (const float*)d_in[i];
    a.out = (float*)d_out; a.ws = (unsigned char*)d_ws;
    if (N_LAUNCHES == 1) { a.ph_lo = 0; a.ph_hi = N_PHASES; a.li = 0; hipLaunchKernelGGL(fwd_kernel, dim3(grid), dim3(NTHR), LDS_BYTES, stream, a); }
    else { for (int p = 0; p < N_PHASES; ++p) { a.ph_lo = p; a.ph_hi = p + 1; a.li = p; hipLaunchKernelGGL(fwd_kernel, dim3(grid), dim3(NTHR), LDS_BYTES, stream, a); } }
}
```

```cpp
#include <hip/hip_runtime.h>
#include <cstdio>
#include <cstdint>

#ifndef MK_N_LAUNCHES
#define MK_N_LAUNCHES 1
#endif

namespace pg8 {
#define PG8_LAS __attribute__((address_space(3)))
typedef _Float16 h16;
typedef _Float16 h16x8 __attribute__((ext_vector_type(8)));
typedef _Float16 h16x2 __attribute__((ext_vector_type(2)));
typedef float f32x4 __attribute__((ext_vector_type(4)));
typedef float f32x2 __attribute__((ext_vector_type(2)));
typedef unsigned u32x4 __attribute__((ext_vector_type(4)));
constexpr int BM = 256, BK = 64, HALF = 128, HTB = HALF * BK * 2, STAGE_BYTES = 8 * HTB, NXCD = 8, WGM = 8;

__host__ __device__ __forceinline__ int lds_byte(int r, int c) { const int st = (r >> 4) * 2 + (c >> 5), rr = r & 15, cc = c & 31, ob = rr * 64 + cc * 2; return st * 1024 + (ob ^ (((ob >> 9) & 1) << 5)); }
__host__ __device__ __forceinline__ void stage_rc(int b, int& R, int& C) { const int st = b / 1024, sb = b % 1024, swz = sb ^ (((sb >> 9) & 1) << 5); R = (st >> 1) * 16 + swz / 64; C = (st & 1) * 32 + (swz % 64) / 2; }
__host__ __device__ __forceinline__ int perm32(int rho) { const int n = rho >> 4, i = rho & 15; return 8 * (i >> 2) + 4 * n + (i & 3); }

struct Unit { int pm, pn; };
struct Gemm { const h16* A; const h16* Bt; int M, N, K; };

struct StaticOrder {
    int nM, nN, nwg, G, c;
    __host__ __device__ void init(int M, int N, int G_, int c_) { nM = M / BM; nN = N / BM; nwg = nM * nN; G = G_; c = c_; }
    __host__ __device__ bool next(int i, Unit& u) const {
        const long L = (long)i * G + c; if (L >= nwg) return false;
        int wgid = (int)L; { const int q = nwg / NXCD, r = nwg % NXCD, xcd = wgid % NXCD, off = wgid / NXCD; wgid = (xcd < r ? xcd * (q + 1) : r * (q + 1) + (xcd - r) * q) + off; }
        const int nig = WGM * nN, gid = wgid / nig, fm = gid * WGM, gsz = (nM - fm) < WGM ? (nM - fm) : WGM;
        u.pm = fm + ((wgid % nig) % gsz); u.pn = (wgid % nig) / gsz; return true;
    }
    __device__ __forceinline__ void a_ready(const Unit&) const {}
    __device__ __forceinline__ void done(const Unit&) const {}
};

__device__ __forceinline__ unsigned cvt_pk_h16(float lo, float hi) { f32x2 v = {lo, hi}; h16x2 h = __builtin_convertvector(v, h16x2); return __builtin_bit_cast(unsigned, h); }

struct EpiF32 {
    static constexpr bool PERM = false, AFTER_DRAIN = false;
    float* C; int ldc;
    __device__ __forceinline__ void operator()(const f32x4 (&acc)[2][2][4][2], const Unit& u, int wr, int wc, int fr, int fq) const {
        const int row0 = u.pm * BM + wr * 64 + fr, col0 = u.pn * BM + wc * 32 + 4 * fq;
#pragma unroll
        for (int ai = 0; ai < 2; ++ai)
#pragma unroll
            for (int m = 0; m < 4; ++m) { float* rowp = C + (size_t)(row0 + ai * HALF + m * 16) * ldc + col0;
#pragma unroll
                for (int bj = 0; bj < 2; ++bj)
#pragma unroll
                    for (int n = 0; n < 2; ++n) *(f32x4*)(rowp + bj * HALF + n * 16) = acc[ai][bj][m][n]; }
    }
};
struct EpiSwiGLU {
    static constexpr bool PERM = true, AFTER_DRAIN = false;
    h16* O; int ldc;
    __device__ __forceinline__ void operator()(const f32x4 (&acc)[2][2][4][2], const Unit& u, int wr, int wc, int fr, int fq) const {
        const int row0 = u.pm * BM + wr * 64 + fr, col0 = u.pn * HALF + wc * 32 + 8 * fq;
#pragma unroll
        for (int ai = 0; ai < 2; ++ai)
#pragma unroll
            for (int m = 0; m < 4; ++m) { h16* rowp = O + (size_t)(row0 + ai * HALF + m * 16) * ldc + col0;
                float v[8];
#pragma unroll
                for (int n = 0; n < 2; ++n)
#pragma unroll
                    for (int i = 0; i < 4; ++i) { const float g = acc[ai][0][m][n][i], up = acc[ai][1][m][n][i];
                        const float e = __builtin_amdgcn_exp2f(-1.4426950408889634f * g); v[4 * n + i] = g * __builtin_amdgcn_rcpf(1.0f + e) * up; }
                u32x4 w; w.x = cvt_pk_h16(v[0], v[1]); w.y = cvt_pk_h16(v[2], v[3]); w.z = cvt_pk_h16(v[4], v[5]); w.w = cvt_pk_h16(v[6], v[7]);
                *(u32x4*)rowp = w; }
    }
};
struct EpiProj {
    static constexpr bool PERM = true, AFTER_DRAIN = false;
    unsigned char* qkv; size_t qkv_stride; h16* QS; h16* KI; float* WI; h16* LRU;
    __device__ __forceinline__ void store_h16(const f32x4 (&acc)[2][2][4][2], h16* base, int ld, int row0, int c0, float sc) const {
#pragma unroll
        for (int ai = 0; ai < 2; ++ai)
#pragma unroll
            for (int m = 0; m < 4; ++m) { h16* rowp = base + (size_t)(row0 + ai * HALF + m * 16) * ld + c0;
#pragma unroll
                for (int bj = 0; bj < 2; ++bj) { const f32x4 v0 = acc[ai][bj][m][0] * sc, v1 = acc[ai][bj][m][1] * sc;
                    u32x4 w; w.x = cvt_pk_h16(v0[0], v0[1]); w.y = cvt_pk_h16(v0[2], v0[3]); w.z = cvt_pk_h16(v1[0], v1[1]); w.w = cvt_pk_h16(v1[2], v1[3]);
                    *(u32x4*)(rowp + bj * HALF) = w; } }
    }
    __device__ __forceinline__ void operator()(const f32x4 (&acc)[2][2][4][2], const Unit& u, int wr, int wc, int fr, int fq) const {
        const int row0 = u.pm * BM + wr * 64 + fr, cw = wc * 32 + 8 * fq; const int pn = u.pn;
        if (pn < 6) { store_h16(acc, (h16*)(qkv + (size_t)(pn >> 1) * qkv_stride), 512, row0, (pn & 1) * 256 + cw, pn < 2 ? 0.125f * 1.4426950408889634f : 1.0f); }
        else if (pn >= 9) { store_h16(acc, LRU, 1024, row0, (pn - 9) * 256 + cw, 1.0f); }
        else if (pn < 8) { store_h16(acc, QS, 512, row0, (pn - 6) * 256 + cw, 0.125f); }
        else {
#pragma unroll
            for (int ai = 0; ai < 2; ++ai)
#pragma unroll
                for (int m = 0; m < 4; ++m) { const size_t row = (size_t)(row0 + ai * HALF + m * 16); const f32x4 v0 = acc[ai][0][m][0], v1 = acc[ai][0][m][1];
                    if (cw < 64) { u32x4 w; w.x = cvt_pk_h16(v0[0], v0[1]); w.y = cvt_pk_h16(v0[2], v0[3]); w.z = cvt_pk_h16(v1[0], v1[1]); w.w = cvt_pk_h16(v1[2], v1[3]); *(u32x4*)(KI + row * 64 + cw) = w; }
                    else if (cw == 64) { const float sc = 0.5f * 0.35355339059327373f; *(f32x4*)(WI + row * 8) = v0 * sc; *(f32x4*)(WI + row * 8 + 4) = v1 * sc; } }
        }
    }
};

template <class Epi, class Sched, bool ALIGN_EPI = false>
__device__ __forceinline__ void gemm_phase(PG8_LAS unsigned char* lds, const Gemm g, const Sched& S, const Epi& E) {
    const int tid = threadIdx.x, wid = __builtin_amdgcn_readfirstlane(tid >> 6), lane = tid & 63, wr = wid >> 2, wc = wid & 3, fr = lane & 15, fq = lane >> 4;
    const int K = g.K, nt = K / BK;
    unsigned voffA[2], voffB[2];
#pragma unroll
    for (int i = 0; i < 2; ++i) { int R, C; stage_rc(tid * 16 + i * 8192, R, C); const int Rb = Epi::PERM ? ((R & ~31) + perm32(R & 31)) : R;
        voffA[i] = (unsigned)(R * K + C) * 2u; voffB[i] = (unsigned)(Rb * K + C) * 2u; }
    const size_t kstep = (size_t)(BK * 2);
    const size_t hstep = (size_t)HALF * K * 2;
    const size_t tstep = 2 * hstep;
    const unsigned ldsw = (unsigned)wid * 1024u;
    const int aoff = lds_byte(wr * 64 + fr, fq * 8), boff = lds_byte(wc * 32 + fr, fq * 8);
#define PG8_SA(b, h) (((b) * 2 + (h)) * HTB)
#define PG8_SB(b, h) ((4 + (b) * 2 + (h)) * HTB)
#define PG8_STAGE(bufoff, gbase, voff) do { _Pragma("unroll") for (int _i = 0; _i < 2; ++_i) \
        __builtin_amdgcn_global_load_lds((const unsigned*)((const char*)(gbase) + (voff)[_i]), (PG8_LAS unsigned*)(lds + (bufoff) + ldsw + _i * 8192), 16, 0, 0); } while (0)
#define PG8_LDA(dst, b, h) do { _Pragma("unroll") for (int m = 0; m < 4; ++m) _Pragma("unroll") for (int k = 0; k < 2; ++k) dst[m][k] = *(const PG8_LAS h16x8*)(lds + PG8_SA(b, h) + aoff + m * 2048 + k * 1024); } while (0)
#define PG8_LDB(dst, b, h) do { _Pragma("unroll") for (int n = 0; n < 2; ++n) _Pragma("unroll") for (int k = 0; k < 2; ++k) dst[n][k] = *(const PG8_LAS h16x8*)(lds + PG8_SB(b, h) + boff + n * 2048 + k * 1024); } while (0)
#define PG8_MMA(ai, bj, At, Bt) do { __builtin_amdgcn_s_setprio(1); _Pragma("unroll") for (int m = 0; m < 4; ++m) _Pragma("unroll") for (int n = 0; n < 2; ++n) _Pragma("unroll") for (int k = 0; k < 2; ++k) \
        acc[ai][bj][m][n] = __builtin_amdgcn_mfma_f32_16x16x32_f16(Bt[n][k], At[m][k], acc[ai][bj][m][n], 0, 0, 0); __builtin_amdgcn_s_setprio(0); } while (0)
#define PG8_WAIT_V(n) asm volatile("s_waitcnt vmcnt(" #n ")" ::: "memory")
#define PG8_WAIT_L(n) asm volatile("s_waitcnt lgkmcnt(" #n ")" ::: "memory")
#define PG8_BAR __builtin_amdgcn_s_barrier()
#define PG8_SCHED __builtin_amdgcn_sched_barrier(0)
    Unit cur, nxt; int ui = 0;
    if (!S.next(0, cur)) return;
    f32x4 acc[2][2][4][2];
#pragma unroll
    for (int a = 0; a < 2; ++a)
#pragma unroll
        for (int b = 0; b < 2; ++b)
#pragma unroll
            for (int m = 0; m < 4; ++m)
#pragma unroll
                for (int n = 0; n < 2; ++n) acc[a][b][m][n] = (f32x4){0.f, 0.f, 0.f, 0.f};
    h16x8 At[4][2], B0[2][2], B1[2][2];
    const char* cA = (const char*)g.A + (size_t)cur.pm * tstep; const char* cB = (const char*)g.Bt + (size_t)cur.pn * tstep;
    S.a_ready(cur);
    PG8_STAGE(PG8_SB(0, 0), cB, voffB); PG8_STAGE(PG8_SB(0, 1), cB + hstep, voffB); PG8_STAGE(PG8_SA(0, 0), cA, voffA); PG8_STAGE(PG8_SA(0, 1), cA + hstep, voffA);
    if (wr == 1) PG8_BAR;
    PG8_WAIT_V(2); PG8_BAR;
    PG8_STAGE(PG8_SB(1, 0), cB + kstep, voffB); PG8_STAGE(PG8_SA(1, 0), cA + kstep, voffA); PG8_STAGE(PG8_SB(1, 1), cB + hstep + kstep, voffB);
    PG8_WAIT_V(6); PG8_BAR;
    for (;;) {
        const bool has_next = S.next(ui + 1, nxt);
        const char* nA = has_next ? (const char*)g.A + (size_t)nxt.pm * tstep : cA; const char* nB = has_next ? (const char*)g.Bt + (size_t)nxt.pn * tstep : cB;
        for (int t = 0; t < nt; t += 2) {
            const bool last = (t == nt - 2);
            const char* a1 = cA + (size_t)(t + 1) * kstep;
            const char* a2 = last ? nA : cA + (size_t)(t + 2) * kstep; const char* b2 = last ? nB : cB + (size_t)(t + 2) * kstep;
            const char* a3 = a2 + kstep; const char* b3 = b2 + kstep;
            if (last && has_next) S.a_ready(nxt);
            PG8_LDB(B0, 0, 0); PG8_LDB(B1, 0, 1); PG8_SCHED; PG8_LDA(At, 0, 0); PG8_STAGE(PG8_SA(1, 1), a1 + hstep, voffA);
            PG8_WAIT_V(8); PG8_WAIT_L(0); PG8_BAR; PG8_MMA(0, 0, At, B0); PG8_MMA(0, 1, At, B1); PG8_BAR; PG8_SCHED;
            PG8_LDA(At, 0, 1); PG8_STAGE(PG8_SB(0, 0), b2, voffB); PG8_STAGE(PG8_SB(0, 1), b2 + hstep, voffB); PG8_STAGE(PG8_SA(0, 0), a2, voffA);
            PG8_WAIT_V(8); PG8_WAIT_L(0); PG8_BAR; PG8_MMA(1, 0, At, B0); PG8_MMA(1, 1, At, B1); PG8_BAR; PG8_SCHED;
            PG8_LDB(B0, 1, 0); PG8_LDB(B1, 1, 1); PG8_SCHED; PG8_LDA(At, 1, 0); PG8_STAGE(PG8_SA(0, 1), a2 + hstep, voffA);
            PG8_WAIT_V(8); PG8_WAIT_L(0); PG8_BAR; PG8_MMA(0, 0, At, B0); PG8_MMA(0, 1, At, B1); PG8_BAR; PG8_SCHED;
            PG8_LDA(At, 1, 1); PG8_STAGE(PG8_SB(1, 0), b3, voffB); PG8_STAGE(PG8_SB(1, 1), b3 + hstep, voffB); PG8_STAGE(PG8_SA(1, 0), a3, voffA);
            PG8_WAIT_V(8); PG8_WAIT_L(0); PG8_BAR; PG8_MMA(1, 0, At, B0); PG8_MMA(1, 1, At, B1); PG8_BAR; PG8_SCHED;
        }
        if constexpr (ALIGN_EPI) { if (wr == 0) PG8_BAR; }
        E(acc, cur, wr, wc, fr, fq); S.done(cur);
        if (!has_next) break;
#pragma unroll
        for (int a = 0; a < 2; ++a)
#pragma unroll
            for (int b = 0; b < 2; ++b)
#pragma unroll
                for (int m = 0; m < 4; ++m)
#pragma unroll
                    for (int n = 0; n < 2; ++n) acc[a][b][m][n] = (f32x4){0.f, 0.f, 0.f, 0.f};
        cur = nxt; cA = nA; cB = nB; ++ui;
        if constexpr (ALIGN_EPI) { if (wr == 1) PG8_BAR; }
    }
    PG8_WAIT_V(0);
    if constexpr (!ALIGN_EPI) { if (wr == 0) PG8_BAR; }
    PG8_BAR;
#undef PG8_SA
#undef PG8_SB
#undef PG8_STAGE
#undef PG8_LDA
#undef PG8_LDB
#undef PG8_MMA
#undef PG8_WAIT_V
#undef PG8_WAIT_L
#undef PG8_BAR
#undef PG8_SCHED
}
}

constexpr int NWAVES = 8, NTHR = NWAVES * 64;
constexpr int N_LAUNCHES = MK_N_LAUNCHES;
constexpr int N_PHASES = 14;
constexpr int BATCH = 2, SEQ = 8192, D = 1024, FF = 2816, M = BATCH * SEQ;
constexpr int NGU = 2 * FF;
constexpr int NPROJ = 3328;
constexpr int DIN = 3144;
constexpr int NH = 8, HD = 64, DATT = 512, DLRU = 512, TOPK = 256, CHUNK = 64;
constexpr int LCH = 64, NLCH = SEQ / LCH;
constexpr float EPS = 1e-6f;

constexpr size_t MiB = 1u << 20;
constexpr size_t WS_CTL = 0, CTL_ZERO_BYTES = 1 * MiB;
constexpr size_t WS_MOD = 1 * MiB;
constexpr size_t WS_LRUS = 1 * MiB + 512 * 1024;
constexpr size_t WS_W1GU = 3 * MiB, WS_W1D = 14 * MiB, WS_WIN = 20 * MiB, WS_WOUT = 27 * MiB, WS_W2GU = 29 * MiB, WS_W2D = 40 * MiB;
constexpr size_t WS_H = 46 * MiB;
constexpr size_t WS_ACT = 78 * MiB;
constexpr size_t WS_Y = 166 * MiB;
constexpr size_t WS_Q = 78 * MiB, WS_K = 94 * MiB, WS_V = 110 * MiB;
constexpr size_t WS_QS = 126 * MiB;
constexpr size_t WS_O = 142 * MiB;
constexpr size_t WS_KI = 158 * MiB;
constexpr size_t WS_WI = 160 * MiB;
constexpr size_t WS_MASK = 230 * MiB;
constexpr size_t WS_LRU = 166 * MiB;
constexpr size_t WS_MERGED = WS_H;
constexpr size_t WS_END = 246 * MiB;
constexpr int CW_BAR = 4096;

constexpr int RING_OFF = 0, RING_BYTES = 131072;
constexpr int LDSCTL_OFF = RING_BYTES, MISC_OFF = LDSCTL_OFF + 320;
constexpr int LDS_BYTES = 147456;

#define GAS __attribute__((address_space(1)))
#define LAS __attribute__((address_space(3)))
typedef _Float16 h16;
typedef unsigned v4u __attribute__((ext_vector_type(4)));
typedef unsigned v2u __attribute__((ext_vector_type(2)));
typedef float f32x4 __attribute__((ext_vector_type(4)));
typedef _Float16 h16x8 __attribute__((ext_vector_type(8)));
typedef _Float16 h16x4 __attribute__((ext_vector_type(4)));
typedef GAS unsigned gu32;
#define RLX_AGENT __ATOMIC_RELAXED, __HIP_MEMORY_SCOPE_AGENT
#define LDS_WAIT() asm volatile("s_waitcnt lgkmcnt(0)" ::: "memory")
#define VM_WAIT() asm volatile("s_waitcnt vmcnt(0)" ::: "memory")
using pg8::cvt_pk_h16;

#define XB_TMO      128
#define XB_XCNT(j)  (256  + 64 * (j))
#define XB_XSUB(j)  (1280 + 64 * (j))
#define XB_XGEN(j)  (2304 + 64 * (j))
#define XB_TOP      3328
#define XB_TOPGEN   3392
#define XCD_BAR_WORDS 3456
#define XB_SPIN_CAP (1u << 18)
__device__ __forceinline__ unsigned xb_ld(unsigned* p)              { return __hip_atomic_load(p, __ATOMIC_RELAXED, __HIP_MEMORY_SCOPE_AGENT); }
__device__ __forceinline__ unsigned xb_add(unsigned* p, unsigned v) { return __hip_atomic_fetch_add(p, v, __ATOMIC_RELAXED, __HIP_MEMORY_SCOPE_AGENT); }
__device__ __forceinline__ unsigned xb_xcc_id() { return (unsigned)__builtin_amdgcn_s_getreg((3 << 11) | 20) & 0xFu; }
#define XB_SPIN(cond, bar) do { unsigned _sp = 0; while (cond) { __builtin_amdgcn_s_sleep(1); \
    if ((++_sp & 255u) == 0u) { if (xb_ld(&(bar)[XB_TMO])) break; if (_sp > XB_SPIN_CAP) { atomicAdd(&(bar)[XB_TMO], 1u); break; } } } } while (0)
struct XcdBarrier { unsigned* bar; unsigned x; volatile LAS unsigned* st; };
__device__ __forceinline__ XcdBarrier xcd_barrier_post(unsigned* bar, volatile LAS unsigned* st) {
    XcdBarrier b; b.bar = bar; b.x = xb_xcc_id(); b.st = st;
    if (threadIdx.x == 0) (void)xb_add(&bar[XB_XCNT(b.x)], 1u);
    return b;
}
__device__ __forceinline__ void xcd_barrier_complete(unsigned* bar, unsigned x, unsigned& nloc, unsigned& nx) {
    const unsigned G = gridDim.x * gridDim.y * gridDim.z;
    unsigned sum, cnt, mine, sp = 0u;
    for (;;) {
        sum = 0u; cnt = 0u; mine = 0u;
#pragma unroll
        for (unsigned j = 0; j < 16; ++j) { const unsigned c = xb_ld(&bar[XB_XCNT(j)]); sum += c; cnt += (c > 0u) ? 1u : 0u; mine = (j == x) ? c : mine; }
        if (sum == G) break;
        __builtin_amdgcn_s_sleep(1);
        if ((++sp & 255u) == 0u) { if (xb_ld(&bar[XB_TMO])) break; if (sp > XB_SPIN_CAP) { atomicAdd(&bar[XB_TMO], 1u); break; } }
    }
    nloc = mine > 0u ? mine : 1u; nx = cnt > 0u ? cnt : 1u;
}
__device__ __forceinline__ void xcd_barrier(const XcdBarrier& b) {
    asm volatile("s_waitcnt vmcnt(0)" ::: "memory");
    __syncthreads();
    if (threadIdx.x == 0) {
        unsigned* bar = b.bar;
        __builtin_amdgcn_s_waitcnt(0);
        unsigned nloc = b.st[0], nx = b.st[1];
        if (nloc == 0u) { xcd_barrier_complete(bar, b.x, nloc, nx); b.st[0] = nloc; b.st[1] = nx; }
        const unsigned old = xb_add(&bar[XB_XSUB(b.x)], 1u);
        const unsigned gen = old / nloc;
        if (old + 1u == (gen + 1u) * nloc) {
            __builtin_amdgcn_fence(__ATOMIC_RELEASE, "agent");
            asm volatile("s_waitcnt vmcnt(0)" ::: "memory");
            const unsigned og = xb_add(&bar[XB_TOP], 1u);
            const unsigned tg = og / nx;
            if (og + 1u == (tg + 1u) * nx) xb_add(&bar[XB_TOPGEN], 1u);
            else XB_SPIN(xb_ld(&bar[XB_TOPGEN]) == tg, bar);
            __builtin_amdgcn_fence(__ATOMIC_ACQUIRE, "agent");
            xb_add(&bar[XB_XGEN(b.x)], 1u);
            asm volatile("s_waitcnt vmcnt(0)" ::: "memory");
        } else {
            XB_SPIN(xb_ld(&bar[XB_XGEN(b.x)]) == gen, bar);
            __builtin_amdgcn_fence(__ATOMIC_ACQUIRE, "agent");
            asm volatile("s_waitcnt vmcnt(0)" ::: "memory");
        }
    }
    __syncthreads();
}

struct Frame {
    LAS unsigned char* lds;
    volatile LAS unsigned* MISC;
    gu32* ctl;
    int tid, lane, wave;
    int vcu, G;
};
struct Args { const float* in[28]; float* out; unsigned char* ws; int ph_lo, ph_hi, li, pad; };

__device__ __forceinline__ float wave_sum(float v) {
#pragma unroll
    for (int o = 1; o < 64; o <<= 1) v += __shfl_xor(v, o);
    return v;
}
__device__ __forceinline__ float wave_max(float v) {
#pragma unroll
    for (int o = 1; o < 64; o <<= 1) v = fmaxf(v, __shfl_xor(v, o));
    return v;
}

struct MapId { __device__ __forceinline__ int operator()(int n) const { return n; } };
struct MapGU { int half; __device__ __forceinline__ int operator()(int n) const { return (n >> 7) * 256 + half * 128 + (n & 127); } };
struct MapIn { __device__ __forceinline__ int operator()(int n) const { return n < 2120 ? n : n + 184; } };
template <class RowMap>
__device__ __forceinline__ void p0_transpose_item(const float* W, int K, int N, h16* WT, RowMap rm, LAS float* scr, int item, int lane) {
    const int nblk = (N + 31) / 32, kb = item / nblk, nb = item % nblk, k0 = 64 * kb, n0 = 32 * nb;
    const int nl = n0 + (lane & 31);
#pragma unroll 8
    for (int i = 0; i < 32; ++i) { const int kk = 2 * i + (lane >> 5); scr[kk * 33 + (lane & 31)] = (nl < N) ? W[(size_t)(k0 + kk) * N + nl] : 0.f; }
    LDS_WAIT(); asm volatile("" ::: "memory");
    const int c = lane & 7;
#pragma unroll
    for (int j = 0; j < 4; ++j) { const int nn = (lane >> 3) + 8 * j; const LAS float* s = scr + (8 * c) * 33 + nn;
        v4u o; o.x = cvt_pk_h16(s[0 * 33], s[1 * 33]); o.y = cvt_pk_h16(s[2 * 33], s[3 * 33]); o.z = cvt_pk_h16(s[4 * 33], s[5 * 33]); o.w = cvt_pk_h16(s[6 * 33], s[7 * 33]);
        if (n0 + nn < N) *(GAS v4u*)(WT + (size_t)rm(n0 + nn) * K + k0 + 8 * c) = o; }
    LDS_WAIT(); asm volatile("" ::: "memory");
}

__device__ __forceinline__ void p0_prologue(Frame& F, const Args& A) {
    unsigned char* ws = A.ws;
    if (blockIdx.x < 36) {
        LAS float* sc = (LAS float*)(F.lds);
        LAS float* red = (LAS float*)(F.lds + 8192);
        const float* c = A.in[1];
        for (int i = F.tid; i < 2048; i += NTHR) { const float v = c[i]; sc[i] = v / (1.0f + __expf(-v)); }
        __syncthreads();
        const float* wa = A.in[2]; const int col = blockIdx.x * 256 + 4 * F.lane;
        f32x4 a0 = {0.f, 0.f, 0.f, 0.f}, a1 = {0.f, 0.f, 0.f, 0.f};
        const int kb = F.wave * 128;
#pragma unroll 8
        for (int k = 0; k < 128; ++k) { const f32x4 w = *(const f32x4*)(wa + (size_t)(kb + k) * 9216 + col); a0 += w * sc[kb + k]; a1 += w * sc[1024 + kb + k]; }
        *(LAS f32x4*)(red + (F.wave * 2 + 0) * 256 + 4 * F.lane) = a0; *(LAS f32x4*)(red + (F.wave * 2 + 1) * 256 + 4 * F.lane) = a1;
        __syncthreads();
        { const int b = F.tid >> 8, j = F.tid & 255; float s = 0.f;
#pragma unroll
          for (int w = 0; w < 8; ++w) s += red[(w * 2 + b) * 256 + j];
          const int cc = blockIdx.x * 256 + j; ((float*)(ws + WS_MOD))[b * 9216 + cc] = s + A.in[3][cc]; }
        __syncthreads();
    }
    LAS float* scr = (LAS float*)(F.lds + RING_OFF + F.wave * 16384);
    const int gw = F.vcu * NWAVES + F.wave, NGW = F.G * NWAVES;
    constexpr int I_GU = (D / 64) * (FF / 32), I_DN = (FF / 64) * (D / 32), I_IN = (D / 64) * ((DIN + 31) / 32), I_OUT = (D / 64) * (D / 32);
    constexpr int NITEMS = 6 * I_GU + I_IN + I_OUT; static_assert(I_GU == I_DN, "items");
    h16* W1GU = (h16*)(ws + WS_W1GU); h16* W1D = (h16*)(ws + WS_W1D); h16* WIN = (h16*)(ws + WS_WIN); h16* WOUT = (h16*)(ws + WS_WOUT); h16* W2GU = (h16*)(ws + WS_W2GU); h16* W2D = (h16*)(ws + WS_W2D);
    for (int it = gw; it < NITEMS; it += NGW) {
        int r = it;
        if (r < I_GU) { p0_transpose_item(A.in[6], D, FF, W1GU, MapGU{0}, scr, r, F.lane); continue; } r -= I_GU;
        if (r < I_GU) { p0_transpose_item(A.in[7], D, FF, W1GU, MapGU{1}, scr, r, F.lane); continue; } r -= I_GU;
        if (r < I_DN) { p0_transpose_item(A.in[8], FF, D, W1D, MapId{}, scr, r, F.lane); continue; } r -= I_DN;
        if (r < I_IN) { p0_transpose_item(A.in[11], D, DIN, WIN, MapIn{}, scr, r, F.lane); continue; } r -= I_IN;
        if (r < I_OUT) { p0_transpose_item(A.in[22], D, D, WOUT, MapId{}, scr, r, F.lane); continue; } r -= I_OUT;
        if (r < I_GU) { p0_transpose_item(A.in[25], D, FF, W2GU, MapGU{0}, scr, r, F.lane); continue; } r -= I_GU;
        if (r < I_GU) { p0_transpose_item(A.in[26], D, FF, W2GU, MapGU{1}, scr, r, F.lane); continue; } r -= I_GU;
        p0_transpose_item(A.in[27], FF, D, W2D, MapId{}, scr, r, F.lane);
    }
    for (int i = blockIdx.x * NTHR + F.tid; i < 184 * 128; i += F.G * NTHR) *(GAS v4u*)(WIN + (size_t)2120 * D + (size_t)i * 8) = (v4u){0u, 0u, 0u, 0u};
}

template <bool HAS_Y, bool HAS_H>
__device__ __forceinline__ void thin_phase(Frame& F, const float* mod, const float* yin, const float* gpost, float gscale, int mg,
                                           const float* xin, float* xout, const float* gpre, int msh, int msc, h16* hout) {
    LAS float* TA = (LAS float*)(F.lds); LAS float* TB = TA + 2048; LAS float* TC = TB + 2048;
    for (int i = F.tid; i < 2048; i += NTHR) { const int b = i >> 10, cidx = i & 1023;
        if (HAS_Y) TA[i] = gscale * mod[b * 9216 + mg * 1024 + cidx] * gpost[cidx];
        if (HAS_H) { TB[i] = gpre[cidx] * (1.0f + mod[b * 9216 + msc * 1024 + cidx]); TC[i] = mod[b * 9216 + msh * 1024 + cidx]; } }
    __syncthreads();
    const int gw = F.vcu * NWAVES + F.wave, NGW = F.G * NWAVES;
    for (int row = gw; row < M; row += NGW) {
        const int b = row >> 13;
        const GAS f32x4* xr = (const GAS f32x4*)(xin + (size_t)row * D) + F.lane;
        f32x4 x[4];
#pragma unroll
        for (int j = 0; j < 4; ++j) x[j] = xr[64 * j];
        if (HAS_Y) {
            const GAS f32x4* yr = (const GAS f32x4*)(yin + (size_t)row * D) + F.lane;
            f32x4 y[4]; float s = 0.f;
#pragma unroll
            for (int j = 0; j < 4; ++j) { y[j] = yr[64 * j]; s += (y[j].x * y[j].x + y[j].y * y[j].y) + (y[j].z * y[j].z + y[j].w * y[j].w); }
            const float rstd = 1.0f / sqrtf(wave_sum(s) * (1.0f / D) + EPS);
            GAS f32x4* xo = (GAS f32x4*)(xout + (size_t)row * D) + F.lane;
#pragma unroll
            for (int j = 0; j < 4; ++j) { const f32x4 ta = *(const LAS f32x4*)(TA + b * 1024 + 4 * F.lane + 256 * j); x[j] = x[j] + ta * (y[j] * rstd); xo[64 * j] = x[j]; }
        }
        if (HAS_H) {
            float s = 0.f;
#pragma unroll
            for (int j = 0; j < 4; ++j) s += (x[j].x * x[j].x + x[j].y * x[j].y) + (x[j].z * x[j].z + x[j].w * x[j].w);
            const float rstd = 1.0f / sqrtf(wave_sum(s) * (1.0f / D) + EPS);
            GAS v2u* ho = (GAS v2u*)(hout + (size_t)row * D) + F.lane;
#pragma unroll
            for (int j = 0; j < 4; ++j) { const f32x4 tb = *(const LAS f32x4*)(TB + b * 1024 + 4 * F.lane + 256 * j), tc = *(const LAS f32x4*)(TC + b * 1024 + 4 * F.lane + 256 * j);
                const f32x4 h = (x[j] * rstd) * tb + tc; v2u o; o.x = cvt_pk_h16(h.x, h.y); o.y = cvt_pk_h16(h.z, h.w); ho[64 * j] = o; }
        }
    }
    __syncthreads();
}

__device__ __forceinline__ float gelu_tanh(float x) { const float u = 0.7978845608028654f * (x + 0.044715f * x * x * x); const float e = __expf(2.0f * u); const float t = 1.0f - 2.0f / (e + 1.0f); return 0.5f * x * (1.0f + t); }
template <bool PASS_B>
__device__ __forceinline__ void lru_phase(Frame& F, const Args& A) {
    unsigned char* ws = A.ws;
    const h16* LRU = (const h16*)(ws + WS_LRU); float* SA = (float*)(ws + WS_LRUS); float* SB = SA + BATCH * NLCH * DLRU;
    h16* MERGED = (h16*)(ws + WS_MERGED);
    const int ch = F.tid, g = F.wave, j = F.lane;
    LAS float* XC = (LAS float*)(F.lds);
    LAS float* OT = (LAS float*)(F.lds + 32768);
    float wa[64], wi[64];
#pragma unroll
    for (int i = 0; i < 64; ++i) { wa[i] = A.in[15][(g * 64 + i) * 64 + j]; wi[i] = A.in[17][(g * 64 + i) * 64 + j]; }
    const float cw0 = A.in[13][0 * DLRU + ch], cw1 = A.in[13][1 * DLRU + ch], cw2 = A.in[13][2 * DLRU + ch], cw3 = A.in[13][3 * DLRU + ch], cb = A.in[14][ch];
    const float ba = A.in[16][ch], bi = A.in[18][ch];
    const float lam = A.in[19][ch]; const float sp = (lam < -15.f) ? -lam : log1pf(__expf(-lam));
    const float og = A.in[21][ch];
    for (int task = blockIdx.x; task < BATCH * NLCH; task += F.G) {
        const int b = task / NLCH, c = task % NLCH, t0 = c * LCH;
        const h16* xb = LRU + (size_t)(b * SEQ) * 1024;
        float h = 0.f, Aprod = 1.f;
        if (PASS_B) { for (int cc = 0; cc < c; ++cc) { const float a_ = SA[(b * NLCH + cc) * DLRU + ch], b_ = SB[(b * NLCH + cc) * DLRU + ch]; h = a_ * h + b_; } }
        float xm3 = (t0 >= 3) ? (float)xb[(size_t)(t0 - 3) * 1024 + ch] : 0.f, xm2 = (t0 >= 2) ? (float)xb[(size_t)(t0 - 2) * 1024 + ch] : 0.f, xm1 = (t0 >= 1) ? (float)xb[(size_t)(t0 - 1) * 1024 + ch] : 0.f;
        for (int s0 = 0; s0 < LCH; s0 += 16) {
            float xcr[16];
#pragma unroll
            for (int tt = 0; tt < 16; ++tt) { const float x0 = (float)xb[(size_t)(t0 + s0 + tt) * 1024 + ch];
                const float xc = cb + xm3 * cw0 + xm2 * cw1 + xm1 * cw2 + x0 * cw3; xm3 = xm2; xm2 = xm1; xm1 = x0; xcr[tt] = xc; XC[tt * 512 + ch] = xc; }
            __syncthreads();
#pragma unroll
            for (int tt = 0; tt < 16; ++tt) {
                float ra = 0.f, ri = 0.f;
#pragma unroll
                for (int i4 = 0; i4 < 16; ++i4) { const f32x4 xv = *(const LAS f32x4*)(XC + tt * 512 + g * 64 + 4 * i4);
                    ra += xv.x * wa[4 * i4] + xv.y * wa[4 * i4 + 1] + xv.z * wa[4 * i4 + 2] + xv.w * wa[4 * i4 + 3];
                    ri += xv.x * wi[4 * i4] + xv.y * wi[4 * i4 + 1] + xv.z * wi[4 * i4 + 2] + xv.w * wi[4 * i4 + 3]; }
                const float r = 1.0f / (1.0f + __expf(-(ra + ba))), ig = 1.0f / (1.0f + __expf(-(ri + bi)));
                const float log_a = -8.0f * r * sp; const float a = __expf(log_a); const float mult = sqrtf(-expm1f(2.0f * log_a));
                const float bb = mult * (ig * xcr[tt]);
                h = a * h + bb; Aprod *= a;
                if (PASS_B) { const float gt = (float)xb[(size_t)(t0 + s0 + tt) * 1024 + 512 + ch]; OT[tt * 512 + ch] = h * gelu_tanh(gt); }
            }
            __syncthreads();
            if (PASS_B) {
#pragma unroll
                for (int k = 0; k < 2; ++k) { const int tt = F.wave + 8 * k;
                    const f32x4 o0 = *(const LAS f32x4*)(OT + tt * 512 + 8 * j), o1 = *(const LAS f32x4*)(OT + tt * 512 + 8 * j + 4);
                    float s = (o0.x * o0.x + o0.y * o0.y) + (o0.z * o0.z + o0.w * o0.w) + (o1.x * o1.x + o1.y * o1.y) + (o1.z * o1.z + o1.w * o1.w);
                    const float rstd = 1.0f / sqrtf(wave_sum(s) * (1.0f / DLRU) + EPS);
                    const f32x4 g0 = *(const f32x4*)(A.in[21] + 8 * j), g1 = *(const f32x4*)(A.in[21] + 8 * j + 4);
                    v4u o; o.x = cvt_pk_h16(o0.x * rstd * g0.x, o0.y * rstd * g0.y); o.y = cvt_pk_h16(o0.z * rstd * g0.z, o0.w * rstd * g0.w);
                    o.z = cvt_pk_h16(o1.x * rstd * g1.x, o1.y * rstd * g1.y); o.w = cvt_pk_h16(o1.z * rstd * g1.z, o1.w * rstd * g1.w);
                    *(GAS v4u*)(MERGED + (size_t)(b * SEQ + t0 + s0 + tt) * 1024 + 512 + 8 * j) = o; }
                __syncthreads();
            }
        }
        if (!PASS_B) { SA[(b * NLCH + c) * DLRU + ch] = Aprod; SB[(b * NLCH + c) * DLRU + ch] = h; }
    }
    (void)og;
}

typedef float f32x16 __attribute__((ext_vector_type(16)));
constexpr int IDX_CAP = 128;
constexpr int IL_QL = 0, IL_WL = 36864, IL_INFO = 37888, IL_CNT = 38400, IL_HIST = 65536, IL_CAND = 65536, IL_SCR = 98304;
constexpr int SL_SCORE = 65536, SL_HIST = 98304, SL_CTL = 99328;
__device__ __forceinline__ int crow(int r, int hi) { return (r & 3) + 8 * (r >> 2) + 4 * hi; }
__device__ __forceinline__ unsigned ord_key(float f) { const unsigned u = __float_as_uint(f); return u ^ ((u >> 31) ? 0xFFFFFFFFu : 0x80000000u); }
__device__ __forceinline__ int t5_bucket(int rel) {
    const int n = rel < 0 ? -rel : rel; int large;
    if (n < 12) large = 8; else if (n < 16) large = 9; else if (n < 23) large = 10; else if (n < 32) large = 11; else if (n < 46) large = 12; else if (n < 64) large = 13; else if (n < 91) large = 14; else large = 15;
    return (rel > 0 ? 16 : 0) + (n < 8 ? n : large);
}
__device__ __forceinline__ void idx_scores(f32x16 (&S)[2], const h16x8 (&a)[2][4], const LAS unsigned char* ql, int foff, int sw, int hh, const LAS float* wl) {
    {   h16x8 qf[4];
#pragma unroll
        for (int s = 0; s < 4; ++s) qf[s] = *(const LAS h16x8*)(ql + 8 * 4096 + foff + (((2 * s + hh) ^ sw) << 4));
#pragma unroll
        for (int sub = 0; sub < 2; ++sub) { f32x16 acc = {};
#pragma unroll
            for (int s = 0; s < 4; ++s) acc = __builtin_amdgcn_mfma_f32_32x32x16_f16(a[sub][s], qf[s], acc, 0, 0, 0);
            S[sub] = acc; } }
#pragma unroll 1
    for (int h = 0; h < 8; ++h) {
        h16x8 qf[4]; const float wh = wl[h];
#pragma unroll
        for (int s = 0; s < 4; ++s) qf[s] = *(const LAS h16x8*)(ql + h * 4096 + foff + (((2 * s + hh) ^ sw) << 4));
#pragma unroll
        for (int sub = 0; sub < 2; ++sub) { f32x16 acc = {};
#pragma unroll
            for (int s = 0; s < 4; ++s) acc = __builtin_amdgcn_mfma_f32_32x32x16_f16(a[sub][s], qf[s], acc, 0, 0, 0);
#pragma unroll
            for (int i = 0; i < 16; ++i) S[sub][i] = __builtin_fmaf(__builtin_fabsf(acc[i]), wh, S[sub][i]); }
    }
}
__device__ __forceinline__ void idx_phase(Frame& F, const Args& A) {
    unsigned char* ws = A.ws;
    const h16* QS = (const h16*)(ws + WS_QS); const h16* KI = (const h16*)(ws + WS_KI); const float* WI = (const float*)(ws + WS_WI);
    unsigned* MASK = (unsigned*)(ws + WS_MASK);
    LAS unsigned char* L = F.lds;
    const int tid = F.tid, lane = F.lane, wave = F.wave, r = lane & 31, hh = lane >> 5;
    LAS float* WL = (LAS float*)(L + IL_WL); LAS int* INFO = (LAS int*)(L + IL_INFO); LAS unsigned* CNT = (LAS unsigned*)(L + IL_CNT);
    LAS unsigned* HIST = (LAS unsigned*)(L + IL_HIST);
    for (int p = blockIdx.x; p < 256; p += F.G) {
        const int b = p >> 7, jj = p & 127;
        for (int uu = 0; uu < 2; ++uu) {
            const int j = uu ? 255 - jj : jj;
            const int q0 = 32 * j, rowb = b * SEQ + q0, N = ((j >> 1) + 1) * 64, NC = N >> 6;
            unsigned* mrow = MASK + ((size_t)(b * 128) * 8192 + q0) * 2;
            if (N <= TOPK) {
                for (int i = tid; i < NC * 64; i += NTHR) mrow[(size_t)(i >> 6) * 16384 + (i & 63)] = 0xFFFFFFFFu;
                continue;
            }
            __syncthreads();
#pragma unroll
            for (int i = 0; i < 4; ++i) { const int idx = tid + NTHR * i, q = idx >> 6, cc = idx & 63, head = cc >> 3, c8 = cc & 7;
                const v4u v = *(const GAS v4u*)(QS + (size_t)(rowb + q) * 512 + cc * 8);
                *(LAS v4u*)(L + IL_QL + head * 4096 + q * 128 + ((c8 ^ (q & 7)) << 4)) = v; }
            if (tid < 256) WL[tid] = WI[(size_t)rowb * 8 + tid];
            for (int i = tid; i < 16384; i += NTHR) HIST[i] = 0u;
            if (tid < 32) CNT[tid] = 0u;
            __syncthreads();
            { const int q = tid >> 4, dg = tid & 15, c8 = dg >> 1; float a0 = 0.f, a1 = 0.f, a2 = 0.f, a3 = 0.f;
              const int o = q * 128 + ((c8 ^ (q & 7)) << 4) + (dg & 1) * 8;
#pragma unroll
              for (int h = 0; h < 8; ++h) { const h16x4 v = *(const LAS h16x4*)(L + IL_QL + h * 4096 + o); const float wv = WL[q * 8 + h];
                  a0 += wv * (float)v[0]; a1 += wv * (float)v[1]; a2 += wv * (float)v[2]; a3 += wv * (float)v[3]; }
              v2u pk; pk.x = cvt_pk_h16(a0, a1); pk.y = cvt_pk_h16(a2, a3); *(LAS v2u*)(L + IL_QL + 8 * 4096 + o) = pk; }
            __syncthreads();
            const LAS float* w = WL + r * 8;
            const int foff = r * 128, sw = r & 7;
            const h16* kbase = KI + (size_t)(b * SEQ) * 64 + (size_t)r * 64 + 8 * hh;
            const LAS unsigned char* ql = L + IL_QL;
#define IDX_LOADA(dst, c) do { _Pragma("unroll") for (int sub_ = 0; sub_ < 2; ++sub_) _Pragma("unroll") for (int s_ = 0; s_ < 4; ++s_) \
                dst[sub_][s_] = *(const h16x8*)(kbase + (size_t)(64 * (c) + 32 * sub_) * 64 + 16 * s_); } while (0)
            h16x8 a[2][4]; f32x16 S[2];
            IDX_LOADA(a, 0); idx_scores(S, a, ql, foff, sw, hh, w);
            float s1 = 0.f, s2 = 0.f;
#pragma unroll
            for (int sub = 0; sub < 2; ++sub)
#pragma unroll
                for (int i = 0; i < 16; ++i) { s1 += S[sub][i]; s2 += S[sub][i] * S[sub][i]; }
            s1 += __shfl_xor(s1, 32); s2 += __shfl_xor(s2, 32);
            const float mean = s1 * (1.0f / 64.0f), sd = sqrtf(fmaxf(s2 * (1.0f / 64.0f) - mean * mean, 1e-30f));
            const float inv_w = 510.0f / (8.0f * sd), off = 1.0f - (mean - 3.0f * sd) * inv_w;
            const int rot = 8 * ((r * 5) & 63);
            LAS unsigned* hq = HIST + r * 512;
            for (int c = wave; c < NC; c += 8) {
                IDX_LOADA(a, c); idx_scores(S, a, ql, foff, sw, hh, w);
#pragma unroll
                for (int sub = 0; sub < 2; ++sub)
#pragma unroll
                    for (int i = 0; i < 16; ++i) { const float f = floorf(__builtin_fmaf(S[sub][i], inv_w, off)); const int bin = (int)fminf(fmaxf(f, 0.f), 511.f);
                        __hip_atomic_fetch_add(hq + ((bin + rot) & 511), 1u, __ATOMIC_RELAXED, __HIP_MEMORY_SCOPE_WORKGROUP); }
            }
            __syncthreads();
#pragma unroll 1
            for (int k = 0; k < 4; ++k) { const int q = 4 * wave + k, rotq = 8 * ((q * 5) & 63), pos = (8 * lane + rotq) & 511;
                const v4u c0 = *(const LAS v4u*)(HIST + q * 512 + pos), c1 = *(const LAS v4u*)(HIST + q * 512 + pos + 4);
                const unsigned cn[8] = {c0.x, c0.y, c0.z, c0.w, c1.x, c1.y, c1.z, c1.w};
                unsigned v = ((cn[0] + cn[1]) + (cn[2] + cn[3])) + ((cn[4] + cn[5]) + (cn[6] + cn[7]));
#pragma unroll
                for (int o = 1; o < 64; o <<= 1) { const unsigned tv = __shfl_down(v, o); if (lane + o < 64) v += tv; }
                unsigned above = __shfl_down(v, 1); if (lane == 63) above = 0u;
                if (v >= (unsigned)TOPK && above < (unsigned)TOPK) {
                    unsigned cum = above; int bsel = -1; unsigned cb = 0u, ca = 0u;
#pragma unroll
                    for (int jx = 7; jx >= 0; --jx) { if (bsel < 0) { if (cum + cn[jx] >= (unsigned)TOPK) { bsel = 8 * lane + jx; cb = cn[jx]; ca = cum; } else cum += cn[jx]; } }
                    int slow = (bsel <= 0 || bsel >= 511 || cb > (unsigned)IDX_CAP) ? 1 : 0;
#ifdef IDX_FORCE_SLOW
                    if (((rowb + q) % 251) == 0) slow = 1;
#endif
                    INFO[q * 4 + 0] = bsel; INFO[q * 4 + 1] = TOPK - (int)ca; INFO[q * 4 + 2] = slow; }
            }
            __syncthreads();
            const float blo = (float)INFO[r * 4 + 0], bhi = blo + 1.0f;
            LAS float* scr = (LAS float*)(L + IL_SCR + wave * 4096);
            LAS unsigned* cand = (LAS unsigned*)(L + IL_CAND);
            for (int c = wave; c < NC; c += 8) {
                IDX_LOADA(a, c); idx_scores(S, a, ql, foff, sw, hh, w);
                unsigned selw = 0u, cndw = 0u;
#pragma unroll
                for (int sub = 0; sub < 2; ++sub)
#pragma unroll
                    for (int i = 0; i < 16; ++i) { const float f = __builtin_fmaf(S[sub][i], inv_w, off); selw = selw * 2u + (f >= bhi ? 1u : 0u); cndw = cndw * 2u + (f >= blo ? 1u : 0u); }
                selw = (selw >> 16) | (selw << 16); cndw = (cndw >> 16) | (cndw << 16);
                mrow[(size_t)c * 16384 + (r * 2 + hh)] = selw;
                unsigned rem = cndw & ~selw;
                if (__any(rem != 0u)) {
#pragma unroll
                    for (int sub = 0; sub < 2; ++sub) {
                        LDS_WAIT();
#pragma unroll
                        for (int i = 0; i < 16; ++i) scr[i * 64 + lane] = S[sub][i];
                        LDS_WAIT();
                        unsigned bits = (rem >> (16 * sub)) & 0xFFFFu;
                        while (bits) { const int bp = 31 - __clz((int)bits), i = 15 - bp; bits &= ~(1u << bp);
                            const float val = scr[i * 64 + lane]; const unsigned key = (unsigned)(64 * c + 32 * sub + crow(i, hh));
                            const unsigned pos = __hip_atomic_fetch_add(CNT + r, 1u, __ATOMIC_RELAXED, __HIP_MEMORY_SCOPE_WORKGROUP);
                            if (pos < (unsigned)IDX_CAP) { cand[(r * IDX_CAP + pos) * 2] = __float_as_uint(val); cand[(r * IDX_CAP + pos) * 2 + 1] = key; } }
                    }
                }
            }
            VM_WAIT(); __syncthreads();
#pragma unroll 1
            for (int k = 0; k < 4; ++k) { const int q = 4 * wave + k; const unsigned cc = CNT[q]; const int need = INFO[q * 4 + 1];
                if (cc > (unsigned)IDX_CAP) { if (lane == 0) INFO[q * 4 + 2] = 1; continue; }
                if (INFO[q * 4 + 2]) continue;
                for (unsigned i = lane; i < cc; i += 64) { const float si = __uint_as_float(cand[(q * IDX_CAP + i) * 2]); const unsigned ki = cand[(q * IDX_CAP + i) * 2 + 1]; int rank = 0;
                    for (unsigned jx = 0; jx < cc; ++jx) { const float sj = __uint_as_float(cand[(q * IDX_CAP + jx) * 2]); const unsigned kj = cand[(q * IDX_CAP + jx) * 2 + 1]; rank += (sj > si || (sj == si && kj < ki)) ? 1 : 0; }
                    if (rank < need) { const unsigned c = ki >> 6, sub = (ki >> 5) & 1u, row = ki & 31u, hk = (row >> 2) & 1u, rr = (row & 3u) + 4u * (row >> 3);
                        __hip_atomic_fetch_or(mrow + (size_t)c * 16384 + (q * 2 + hk), 1u << (16u * sub + 15u - rr), __ATOMIC_RELAXED, __HIP_MEMORY_SCOPE_AGENT); } }
            }
            __syncthreads();
#pragma unroll 1
            for (int q = 0; q < 32; ++q) {
                if (!INFO[q * 4 + 2]) continue;
                LAS float* s_score = (LAS float*)(L + SL_SCORE); LAS unsigned* s_hist = (LAS unsigned*)(L + SL_HIST); LAS unsigned* s_ctl = (LAS unsigned*)(L + SL_CTL);
                __syncthreads();
                for (int s = tid; s < N; s += NTHR) {
                    const h16* kr = KI + (size_t)(b * SEQ + s) * 64; float kv[64];
#pragma unroll
                    for (int i = 0; i < 8; ++i) { const h16x8 t8 = *(const h16x8*)(kr + 8 * i);
#pragma unroll
                        for (int e = 0; e < 8; ++e) kv[8 * i + e] = (float)t8[e]; }
                    float sc = 0.f;
#pragma unroll 1
                    for (int h = 0; h < 9; ++h) { float d = 0.f;
#pragma unroll
                        for (int c8 = 0; c8 < 8; ++c8) { const h16x8 qv = *(const LAS h16x8*)(L + IL_QL + h * 4096 + q * 128 + ((c8 ^ (q & 7)) << 4));
#pragma unroll
                            for (int e = 0; e < 8; ++e) d += (float)qv[e] * kv[8 * c8 + e]; }
                        sc += (h == 8) ? d : fabsf(d) * WL[q * 8 + h]; }
                    s_score[s] = sc;
                }
                __syncthreads();
                unsigned prefix = 0u, msk = 0u, remaining = TOPK, n_eq = 0u;
                for (int pass = 0; pass < 4; ++pass) {
                    const int shift = 24 - 8 * pass;
                    if (tid < 256) s_hist[tid] = 0u;
                    __syncthreads();
                    for (int s = tid; s < N; s += NTHR) { const unsigned key = ord_key(s_score[s]); if ((key & msk) == prefix) __hip_atomic_fetch_add(s_hist + ((key >> shift) & 255u), 1u, __ATOMIC_RELAXED, __HIP_MEMORY_SCOPE_WORKGROUP); }
                    __syncthreads();
                    if (wave == 0) {
                        const unsigned h0 = s_hist[4 * lane], h1 = s_hist[4 * lane + 1], h2 = s_hist[4 * lane + 2], h3 = s_hist[4 * lane + 3];
                        unsigned v = h0 + h1 + h2 + h3;
#pragma unroll
                        for (int o = 1; o < 64; o <<= 1) { const unsigned tv = __shfl_down(v, o); if (lane + o < 64) v += tv; }
                        unsigned above = __shfl_down(v, 1); if (lane == 63) above = 0u;
                        if (v >= remaining && above < remaining) {
                            unsigned cum = above; int dsel; unsigned rem; unsigned hv;
                            if (cum + h3 >= remaining) { dsel = 3; rem = remaining - cum; hv = h3; }
                            else { cum += h3; if (cum + h2 >= remaining) { dsel = 2; rem = remaining - cum; hv = h2; }
                            else { cum += h2; if (cum + h1 >= remaining) { dsel = 1; rem = remaining - cum; hv = h1; }
                            else { cum += h1; dsel = 0; rem = remaining - cum; hv = h0; } } }
                            s_ctl[0] = (unsigned)(4 * lane + dsel); s_ctl[1] = rem; s_ctl[4] = hv; }
                    }
                    __syncthreads();
                    prefix |= s_ctl[0] << shift; msk |= 255u << shift; remaining = s_ctl[1]; n_eq = s_ctl[4];
                    __syncthreads();
                }
                const unsigned tu = (prefix & 0x80000000u) ? (prefix ^ 0x80000000u) : ~prefix; const float thr = __uint_as_float(tu);
                unsigned idx_cut = 0xFFFFFFFFu;
                if (n_eq > remaining) {
                    if (tid == 0) { unsigned cnt = 0, cut = 0; for (int s = 0; s < N; ++s) if (s_score[s] == thr) { ++cnt; if (cnt == remaining) { cut = (unsigned)s; break; } } s_ctl[3] = cut; }
                    __syncthreads();
                    idx_cut = s_ctl[3];
                }
                for (int i = tid; i < NC * 2; i += NTHR) { const int c = i >> 1, hk = i & 1; unsigned word = 0u;
#pragma unroll
                    for (int sub = 0; sub < 2; ++sub)
#pragma unroll
                        for (int rr = 0; rr < 16; ++rr) { const int key = 64 * c + 32 * sub + crow(rr, hk); const float sc = s_score[key];
                            if (sc > thr || (sc == thr && (unsigned)key <= idx_cut)) word |= 1u << (16 * sub + 15 - rr); }
                    mrow[(size_t)c * 16384 + (q * 2 + hk)] = word; }
                __syncthreads();
            }
#undef IDX_LOADA
        }
    }
}

namespace at {
typedef short s16x4 __attribute__((ext_vector_type(4)));
constexpr int NSLOT = 3, SLOTB = 8192;
constexpr int LDS_K = 0, LDS_V = NSLOT * SLOTB, LDS_WS = 2 * NSLOT * SLOTB, LDS_TB = LDS_WS + 8 * 256, LDS_OST = 53248, LDS_BYTES = LDS_OST + 8 * 4096;
constexpr float LOG2E = 1.4426950408889634f;
__device__ __forceinline__ void glds16(const void* gsrc, unsigned lds_dst) { unsigned keep;
    asm volatile("s_mov_b32 %0, m0\n\ts_mov_b32 m0, %2\n\ts_nop 0\n\tglobal_load_lds_dwordx4 %1, off\n\ts_mov_b32 m0, %0" : "=&s"(keep) : "v"(gsrc), "s"(lds_dst) : "memory"); }
#define AT_WAIT_BAR(N) asm volatile("s_waitcnt vmcnt(" #N ") lgkmcnt(0)\n\ts_barrier" ::: "memory")
__device__ __forceinline__ h16x8 vtr8(const LAS unsigned char* p0, const LAS unsigned char* p1) {
    const s16x4 lo = __builtin_amdgcn_ds_read_tr16_b64_v4i16((LAS s16x4*)p0), hi = __builtin_amdgcn_ds_read_tr16_b64_v4i16((LAS s16x4*)p1);
    typedef short s16x8 __attribute__((ext_vector_type(8)));
    const s16x8 v = {lo[0], lo[1], lo[2], lo[3], hi[0], hi[1], hi[2], hi[3]}; return __builtin_bit_cast(h16x8, v); }
__device__ __forceinline__ h16x8 pack8(const f32x16& p, int b) {
    v4u w; w.x = cvt_pk_h16(p[b], p[b + 1]); w.y = cvt_pk_h16(p[b + 2], p[b + 3]); w.z = cvt_pk_h16(p[b + 4], p[b + 5]); w.w = cvt_pk_h16(p[b + 6], p[b + 7]); return __builtin_bit_cast(h16x8, w); }

__device__ __forceinline__ void attn_unit(int b, int h, int qb, const h16* Q, const h16* K, const h16* V, const unsigned* MASK, const float* relb, h16* O, LAS unsigned char* shm) {
    const int tid = threadIdx.x, lane = tid & 63, r32 = lane & 31, hi = lane >> 5; const int wid = __builtin_amdgcn_readfirstlane(tid >> 6);
    const long rowbase = (long)b * SEQ; const int q0 = qb * 256, qw = q0 + wid * 32, cq = qw >> 6, NT = 4 * qb + 4;
    const h16* Qw = Q + (rowbase + qw) * 512 + h * 64;
    const h16* Kh = K + rowbase * 512 + h * 64; const h16* Vh = V + rowbase * 512 + h * 64;
    const unsigned lds0 = (unsigned)(uintptr_t)shm;
    LAS float* wsf = (LAS float*)(shm + LDS_WS) + wid * 64;
    LAS float* Tb = (LAS float*)(shm + LDS_TB);
    const h16* ksrc = Kh + (long)lane * 512 + wid * 8;
    const h16* vsrc = Vh + (long)(16 * (wid & 3) + (lane >> 2)) * 512 + (wid >> 2) * 32 + (lane & 3) * 8;
    const unsigned kdst = lds0 + LDS_K + wid * 1024, vdst = lds0 + LDS_V + wid * 1024;
#define AT_DMA_K(t, slot) glds16(ksrc + (long)(t) * 64 * 512, (unsigned)__builtin_amdgcn_readfirstlane(kdst + (slot)))
#define AT_DMA_V(t, slot) glds16(vsrc + (long)(t) * 64 * 512, (unsigned)__builtin_amdgcn_readfirstlane(vdst + (slot)))
    AT_DMA_K(0, 0); AT_DMA_V(0, 0); AT_DMA_K(1, SLOTB); AT_DMA_V(1, SLOTB);
    if (tid < 255) Tb[tid] = relb[t5_bucket(tid - 191) * 8 + h] * LOG2E;
    const float b15l = relb[15 * 8 + h] * LOG2E;
    h16x8 qr[4];
#pragma unroll
    for (int d0 = 0; d0 < 4; ++d0) qr[d0] = *(const h16x8*)(Qw + (long)r32 * 512 + d0 * 16 + hi * 8);
    const unsigned* mk = MASK + ((size_t)(b * 128) * 8192 + (qw + r32)) * 2 + hi;
    const LAS unsigned char* kp0 = shm + LDS_K + hi * 1024 + r32 * 16;
    const LAS unsigned char* vp0 = shm + LDS_V + ((lane >> 4) & 1) * 32 + (lane & 3) * 8 + (4 * hi + ((lane & 15) >> 2)) * 64;
    f32x16 o[2]; o[0] = f32x16{}; o[1] = f32x16{};
    float m = -1e30f, l = 0.f;
    int slot = 0, slot2 = 2 * SLOTB;
#pragma unroll 1
    for (int t = 0; t < NT; ++t) {
        if (t + 1 < NT) { AT_WAIT_BAR(2); } else { AT_WAIT_BAR(0); }
        if (t + 2 < NT) { AT_DMA_K(t + 2, slot2); AT_DMA_V(t + 2, slot2); }
        if (t <= cq) {
            const unsigned mw = mk[(size_t)t * 16384];
            const bool nearb = (t >= cq - 2);
            const float c0 = nearb ? 0.f : b15l;
            f32x16 p0, p1;
#pragma unroll
            for (int r = 0; r < 16; ++r) { p0[r] = c0; p1[r] = c0; }
            const LAS unsigned char* kb = kp0 + slot;
#pragma unroll
            for (int d0 = 0; d0 < 4; ++d0) { const h16x8 k0 = *(const LAS h16x8*)(kb + d0 * 2048), k1 = *(const LAS h16x8*)(kb + d0 * 2048 + 512);
                p0 = __builtin_amdgcn_mfma_f32_32x32x16_f16(k0, qr[d0], p0, 0, 0, 0); p1 = __builtin_amdgcn_mfma_f32_32x32x16_f16(k1, qr[d0], p1, 0, 0, 0); }
            if (nearb) { const int ib = 64 * t - (qw + r32) + 191 + 4 * hi;
#pragma unroll
                for (int r = 0; r < 16; ++r) { const int kk = (r & 3) + 8 * (r >> 2); p0[r] += Tb[ib + kk]; p1[r] += Tb[ib + 32 + kk]; } }
#pragma unroll
            for (int r = 0; r < 16; ++r) { p0[r] = ((mw >> (15 - r)) & 1u) ? p0[r] : -INFINITY; p1[r] = ((mw >> (31 - r)) & 1u) ? p1[r] : -INFINITY; }
            float mx = fmaxf(p0[0], p1[0]);
#pragma unroll
            for (int r = 1; r < 16; ++r) mx = fmaxf(mx, fmaxf(p0[r], p1[r]));
            { auto rr = __builtin_amdgcn_permlane32_swap(__float_as_uint(mx), __float_as_uint(mx), false, false); mx = fmaxf(__uint_as_float(rr[0]), __uint_as_float(rr[1])); }
            const float mn = fmaxf(m, mx), alpha = __builtin_amdgcn_exp2f(m - mn); m = mn;
            float ps = 0.f;
#pragma unroll
            for (int r = 0; r < 16; ++r) { p0[r] = __builtin_amdgcn_exp2f(p0[r] - mn); p1[r] = __builtin_amdgcn_exp2f(p1[r] - mn); ps += p0[r] + p1[r]; }
            l = l * alpha + ps;
            if (!__all(alpha == 1.0f)) {
                if (hi == 0) wsf[r32] = alpha;
                LDS_WAIT();
#pragma unroll
                for (int r = 0; r < 16; ++r) { const float f = wsf[crow(r, hi)]; o[0][r] *= f; o[1][r] *= f; }
            }
            const h16x8 pa0 = pack8(p0, 0), pa1 = pack8(p0, 8), pa2 = pack8(p1, 0), pa3 = pack8(p1, 8);
            const LAS unsigned char* vb = vp0 + slot;
#pragma unroll
            for (int d0 = 0; d0 < 2; ++d0) {
                const h16x8 v0 = vtr8(vb + d0 * 4096, vb + d0 * 4096 + 512), v1 = vtr8(vb + d0 * 4096 + 1024, vb + d0 * 4096 + 1024 + 512);
                const h16x8 v2 = vtr8(vb + d0 * 4096 + 2048, vb + d0 * 4096 + 2048 + 512), v3 = vtr8(vb + d0 * 4096 + 3072, vb + d0 * 4096 + 3072 + 512);
                o[d0] = __builtin_amdgcn_mfma_f32_32x32x16_f16(pa0, v0, o[d0], 0, 0, 0); o[d0] = __builtin_amdgcn_mfma_f32_32x32x16_f16(pa1, v1, o[d0], 0, 0, 0);
                o[d0] = __builtin_amdgcn_mfma_f32_32x32x16_f16(pa2, v2, o[d0], 0, 0, 0); o[d0] = __builtin_amdgcn_mfma_f32_32x32x16_f16(pa3, v3, o[d0], 0, 0, 0); }
        }
        slot2 = slot; slot = (slot == (NSLOT - 1) * SLOTB) ? 0 : slot + SLOTB;
    }
    { auto rr = __builtin_amdgcn_permlane32_swap(__float_as_uint(l), __float_as_uint(l), false, false); l = __uint_as_float(rr[0]) + __uint_as_float(rr[1]); }
    if (hi == 0) wsf[32 + r32] = l;
    LDS_WAIT();
    h16* Ow = O + (rowbase + qw) * 512 + h * 64;
    { LAS h16* stg = (LAS h16*)(shm + LDS_OST) + wid * 2048;
#pragma unroll
      for (int r = 0; r < 16; ++r) { const int orow = crow(r, hi); const float rl = 1.0f / wsf[32 + orow];
#pragma unroll
          for (int d0 = 0; d0 < 2; ++d0) stg[orow * 64 + d0 * 32 + r32] = (h16)(o[d0][r] * rl); }
      LDS_WAIT();
#pragma unroll
      for (int i = 0; i < 4; ++i) { const int row = i * 8 + (lane >> 3), ch = lane & 7; const v4u v = *(const LAS v4u*)(stg + row * 64 + ch * 8); *(GAS v4u*)(Ow + (long)row * 512 + ch * 8) = v; } }
    asm volatile("s_waitcnt lgkmcnt(0)\n\ts_barrier" ::: "memory");
#undef AT_DMA_K
#undef AT_DMA_V
}
__device__ __forceinline__ void attn_phase(Frame& F, const Args& A) {
    unsigned char* ws = A.ws;
    for (int v = F.vcu; v < 256; v += F.G) {
        const int bh = v >> 4, s = v & 15;
#pragma unroll 1
        for (int i = 0; i < 2; ++i) attn_unit(bh >> 3, bh & 7, i ? 31 - s : s, (const h16*)(ws + WS_Q), (const h16*)(ws + WS_K), (const h16*)(ws + WS_V), (const unsigned*)(ws + WS_MASK), A.in[12], (h16*)(ws + WS_O), F.lds + RING_OFF);
    }
}
#undef AT_WAIT_BAR
}

__device__ __forceinline__ void attn_norm_phase(Frame& F, const Args& A) {
    unsigned char* ws = A.ws; const h16* O = (const h16*)(ws + WS_O); h16* MERGED = (h16*)(ws + WS_MERGED);
    const f32x4 g0 = *(const f32x4*)(A.in[20] + 8 * F.lane), g1 = *(const f32x4*)(A.in[20] + 8 * F.lane + 4);
    const int gw = F.vcu * NWAVES + F.wave, NGW = F.G * NWAVES;
    for (int row = gw; row < M; row += NGW) {
        const h16x8 v = *(const h16x8*)(O + (size_t)row * 512 + 8 * F.lane); float f[8]; float s = 0.f;
#pragma unroll
        for (int e = 0; e < 8; ++e) { f[e] = (float)v[e]; s += f[e] * f[e]; }
        const float rstd = 1.0f / sqrtf(wave_sum(s) * (1.0f / DATT) + EPS);
        v4u o; o.x = cvt_pk_h16(f[0] * rstd * g0.x, f[1] * rstd * g0.y); o.y = cvt_pk_h16(f[2] * rstd * g0.z, f[3] * rstd * g0.w);
        o.z = cvt_pk_h16(f[4] * rstd * g1.x, f[5] * rstd * g1.y); o.w = cvt_pk_h16(f[6] * rstd * g1.z, f[7] * rstd * g1.w);
        *(GAS v4u*)(MERGED + (size_t)row * 1024 + 8 * F.lane) = o;
    }
}

__global__ void __launch_bounds__(NTHR, 2) fwd_kernel(Args args) {
    extern __shared__ __attribute__((aligned(16))) unsigned char lds[];
    Frame F;
    F.lds = (LAS unsigned char*)lds;
    F.MISC = (volatile LAS unsigned*)(F.lds + MISC_OFF);
    F.tid = threadIdx.x; F.lane = F.tid & 63; F.wave = __builtin_amdgcn_readfirstlane(F.tid >> 6);
    F.G = gridDim.x; { const int bx = blockIdx.x; F.vcu = (F.G % 8 == 0) ? (bx % 8) * (F.G / 8) + bx / 8 : bx; }
    unsigned char* ws = args.ws;
    F.ctl = (gu32*)(ws + WS_CTL);
    for (int u = F.tid; u < (LDS_BYTES - LDSCTL_OFF) / 4; u += NTHR) ((LAS unsigned*)(F.lds + LDSCTL_OFF))[u] = 0u;
    __syncthreads();
    XcdBarrier bar; bar.bar = (unsigned*)(F.ctl + CW_BAR); bar.x = 0; bar.st = nullptr;
    if (N_LAUNCHES == 1) bar = xcd_barrier_post((unsigned*)(F.ctl + CW_BAR), F.MISC + 8);
    const int lo = args.ph_lo, hi = args.ph_hi;
#define IN(k) (lo <= (k) && (k) < hi)
#define SEAM(k) do { if (IN(k) && IN((k) + 1)) xcd_barrier(bar); } while (0)
    const float* mod = (const float*)(ws + WS_MOD);
    h16* H = (h16*)(ws + WS_H); h16* ACT = (h16*)(ws + WS_ACT); float* Y = (float*)(ws + WS_Y);
    const int bx = (int)blockIdx.x;

    if (IN(0)) { p0_prologue(F, args); } SEAM(0);
    if (IN(1)) { thin_phase<false, true>(F, mod, nullptr, nullptr, 0.f, 0, args.in[0], nullptr, args.in[4], 0, 1, H); } SEAM(1);
    if (IN(2)) { pg8::Gemm g{H, (const h16*)(ws + WS_W1GU), M, NGU, D}; pg8::StaticOrder S; S.init(M, NGU, F.G, bx);
        pg8::EpiSwiGLU E{ACT, FF}; pg8::gemm_phase<pg8::EpiSwiGLU, pg8::StaticOrder, true>(F.lds + RING_OFF, g, S, E); } SEAM(2);
    if (IN(3)) { pg8::Gemm g{ACT, (const h16*)(ws + WS_W1D), M, D, FF}; pg8::StaticOrder S; S.init(M, D, F.G, bx);
        pg8::EpiF32 E{Y, D}; pg8::gemm_phase<pg8::EpiF32, pg8::StaticOrder, false>(F.lds + RING_OFF, g, S, E); } SEAM(3);
    if (IN(4)) { thin_phase<true, true>(F, mod, Y, args.in[5], 0.5f, 2, args.in[0], args.out, args.in[9], 3, 4, H); } SEAM(4);
    if (IN(5)) { pg8::Gemm g{H, (const h16*)(ws + WS_WIN), M, NPROJ, D}; pg8::StaticOrder S; S.init(M, NPROJ, F.G, bx);
        pg8::EpiProj E{ws + WS_Q, (size_t)(WS_K - WS_Q), (h16*)(ws + WS_QS), (h16*)(ws + WS_KI), (float*)(ws + WS_WI), (h16*)(ws + WS_LRU)};
        pg8::gemm_phase<pg8::EpiProj, pg8::StaticOrder, true>(F.lds + RING_OFF, g, S, E); } SEAM(5);
    if (IN(6)) { lru_phase<false>(F, args); __syncthreads(); idx_phase(F, args); } SEAM(6);
    if (IN(7)) { lru_phase<true>(F, args); __syncthreads(); at::attn_phase(F, args); } SEAM(7);
    if (IN(8)) { attn_norm_phase(F, args); } SEAM(8);
    if (IN(9)) { pg8::Gemm g{(const h16*)(ws + WS_MERGED), (const h16*)(ws + WS_WOUT), M, D, D}; pg8::StaticOrder S; S.init(M, D, F.G, bx);
        pg8::EpiF32 E{Y, D}; pg8::gemm_phase<pg8::EpiF32, pg8::StaticOrder, false>(F.lds + RING_OFF, g, S, E); } SEAM(9);
    if (IN(10)) { thin_phase<true, true>(F, mod, Y, args.in[10], 1.0f, 5, args.out, args.out, args.in[23], 6, 7, H); } SEAM(10);
    if (IN(11)) { pg8::Gemm g{H, (const h16*)(ws + WS_W2GU), M, NGU, D}; pg8::StaticOrder S; S.init(M, NGU, F.G, bx);
        pg8::EpiSwiGLU E{ACT, FF}; pg8::gemm_phase<pg8::EpiSwiGLU, pg8::StaticOrder, true>(F.lds + RING_OFF, g, S, E); } SEAM(11);
    if (IN(12)) { pg8::Gemm g{ACT, (const h16*)(ws + WS_W2D), M, D, FF}; pg8::StaticOrder S; S.init(M, D, F.G, bx);
        pg8::EpiF32 E{Y, D}; pg8::gemm_phase<pg8::EpiF32, pg8::StaticOrder, false>(F.lds + RING_OFF, g, S, E); } SEAM(12);
    if (IN(13)) { thin_phase<true, false>(F, mod, Y, args.in[24], 0.5f, 8, args.out, args.out, nullptr, 0, 0, nullptr); }
#undef IN
#undef SEAM
}

extern "C" void kernel_launch(void* const* d_in, const int* in_sizes, int n_in, void* d_out, int out_size, void* d_ws, size_t ws_size, hipStream_t stream) {
    static int grid = 0;
    if (grid == 0) {
        if (n_in != 28 || in_sizes[0] != M * D || out_size != M * D || ws_size < WS_END) { fprintf(stderr, "kernel_launch: unexpected shapes (n_in %d, in0 %d, out %d, ws %zu); nothing launched\n", n_in, n_in > 0 ? in_sizes[0] : -1, out_size, ws_size); grid = -1; return; }
        int dev = 0, cus = 0, per_cu = 0;
        if (hipGetDevice(&dev) != hipSuccess || hipDeviceGetAttribute(&cus, hipDeviceAttributeMultiprocessorCount, dev) != hipSuccess) { grid = -1; return; }
        if (hipFuncSetAttribute((const void*)fwd_kernel, hipFuncAttributeMaxDynamicSharedMemorySize, LDS_BYTES) != hipSuccess) { fprintf(stderr, "kernel_launch: hipFuncSetAttribute failed\n"); grid = -1; return; }
        if (hipOccupancyMaxActiveBlocksPerMultiprocessor(&per_cu, (const void*)fwd_kernel, NTHR, LDS_BYTES) != hipSuccess || per_cu < 1) { fprintf(stderr, "kernel_launch: occupancy query reports %d\n", per_cu); }
        (void)hipGetLastError();
        grid = cus;
    }
    if (grid < 0) return;
    if (hipMemsetAsync((char*)d_ws + WS_CTL, 0, CTL_ZERO_BYTES, stream) != hipSuccess) return;
    Args a{};
    for (int i = 0; i < 28; ++i) a.in[i] = (const float*)d_in[i];
    a.out = (float*)d_out; a.ws = (unsigned char*)d_ws;
    if (N_LAUNCHES == 1) { a.ph_lo = 0; a.ph_hi = N_PHASES; a.li = 0; hipLaunchKernelGGL(fwd_kernel, dim3(grid), dim3(NTHR), LDS_BYTES, stream, a); }
    else { for (int p = 0; p < N_PHASES; ++p) { a.ph_lo = p; a.ph_hi = p + 1; a.li = p; hipLaunchKernelGGL(fwd_kernel, dim3(grid), dim3(NTHR), LDS_BYTES, stream, a); } }
}
```

```cpp
#include <hip/hip_runtime.h>
#include <cstdio>
#include <cstdint>

#ifndef PROBE_PHASE
#define PROBE_PHASE -1
#endif
#ifndef MK_N_LAUNCHES
#define MK_N_LAUNCHES 1
#endif

namespace pg8 {
#define PG8_LAS __attribute__((address_space(3)))
typedef _Float16 h16;
typedef _Float16 h16x8 __attribute__((ext_vector_type(8)));
typedef _Float16 h16x2 __attribute__((ext_vector_type(2)));
typedef float f32x4 __attribute__((ext_vector_type(4)));
typedef float f32x2 __attribute__((ext_vector_type(2)));
typedef unsigned u32x4 __attribute__((ext_vector_type(4)));
constexpr int BM = 256, BK = 64, HALF = 128, HTB = HALF * BK * 2, STAGE_BYTES = 8 * HTB, NXCD = 8, WGM = 8;

__host__ __device__ __forceinline__ int lds_byte(int r, int c) { const int st = (r >> 4) * 2 + (c >> 5), rr = r & 15, cc = c & 31, ob = rr * 64 + cc * 2; return st * 1024 + (ob ^ (((ob >> 9) & 1) << 5)); }
__host__ __device__ __forceinline__ void stage_rc(int b, int& R, int& C) { const int st = b / 1024, sb = b % 1024, swz = sb ^ (((sb >> 9) & 1) << 5); R = (st >> 1) * 16 + swz / 64; C = (st & 1) * 32 + (swz % 64) / 2; }
__host__ __device__ __forceinline__ int perm32(int rho) { const int n = rho >> 4, i = rho & 15; return 8 * (i >> 2) + 4 * n + (i & 3); }

struct Unit { int pm, pn; };
struct Gemm { const h16* A; const h16* Bt; int M, N, K; };

struct StaticOrder {
    int nM, nN, nwg, G, c;
    __host__ __device__ void init(int M, int N, int G_, int c_) { nM = M / BM; nN = N / BM; nwg = nM * nN; G = G_; c = c_; }
    __host__ __device__ bool next(int i, Unit& u) const {
        const long L = (long)i * G + c; if (L >= nwg) return false;
        int wgid = (int)L; { const int q = nwg / NXCD, r = nwg % NXCD, xcd = wgid % NXCD, off = wgid / NXCD; wgid = (xcd < r ? xcd * (q + 1) : r * (q + 1) + (xcd - r) * q) + off; }
        const int nig = WGM * nN, gid = wgid / nig, fm = gid * WGM, gsz = (nM - fm) < WGM ? (nM - fm) : WGM;
        u.pm = fm + ((wgid % nig) % gsz); u.pn = (wgid % nig) / gsz; return true;
    }
    __device__ __forceinline__ void a_ready(const Unit&) const {}
    __device__ __forceinline__ void done(const Unit&) const {}
};

__device__ __forceinline__ unsigned cvt_pk_h16(float lo, float hi) { f32x2 v = {lo, hi}; h16x2 h = __builtin_convertvector(v, h16x2); return __builtin_bit_cast(unsigned, h); }

struct EpiF32 {
    static constexpr bool PERM = false, AFTER_DRAIN = false;
    float* C; int ldc;
    __device__ __forceinline__ void operator()(const f32x4 (&acc)[2][2][4][2], const Unit& u, int wr, int wc, int fr, int fq) const {
        const int row0 = u.pm * BM + wr * 64 + fr, col0 = u.pn * BM + wc * 32 + 4 * fq;
#pragma unroll
        for (int ai = 0; ai < 2; ++ai)
#pragma unroll
            for (int m = 0; m < 4; ++m) { float* rowp = C + (size_t)(row0 + ai * HALF + m * 16) * ldc + col0;
#pragma unroll
                for (int bj = 0; bj < 2; ++bj)
#pragma unroll
                    for (int n = 0; n < 2; ++n) *(f32x4*)(rowp + bj * HALF + n * 16) = acc[ai][bj][m][n]; }
    }
};
struct EpiSwiGLU {
    static constexpr bool PERM = true, AFTER_DRAIN = false;
    h16* O; int ldc;
    __device__ __forceinline__ void operator()(const f32x4 (&acc)[2][2][4][2], const Unit& u, int wr, int wc, int fr, int fq) const {
        const int row0 = u.pm * BM + wr * 64 + fr, col0 = u.pn * HALF + wc * 32 + 8 * fq;
#pragma unroll
        for (int ai = 0; ai < 2; ++ai)
#pragma unroll
            for (int m = 0; m < 4; ++m) { h16* rowp = O + (size_t)(row0 + ai * HALF + m * 16) * ldc + col0;
                float v[8];
#pragma unroll
                for (int n = 0; n < 2; ++n)
#pragma unroll
                    for (int i = 0; i < 4; ++i) { const float g = acc[ai][0][m][n][i], up = acc[ai][1][m][n][i];
                        const float e = __builtin_amdgcn_exp2f(-1.4426950408889634f * g); v[4 * n + i] = g * __builtin_amdgcn_rcpf(1.0f + e) * up; }
                u32x4 w; w.x = cvt_pk_h16(v[0], v[1]); w.y = cvt_pk_h16(v[2], v[3]); w.z = cvt_pk_h16(v[4], v[5]); w.w = cvt_pk_h16(v[6], v[7]);
                *(u32x4*)rowp = w; }
    }
};
struct EpiProj {
    static constexpr bool PERM = true, AFTER_DRAIN = false;
    unsigned char* qkv; size_t qkv_stride; h16* QS; h16* KI; float* WI; h16* LRU;
    __device__ __forceinline__ void store_h16(const f32x4 (&acc)[2][2][4][2], h16* base, int ld, int row0, int c0, float sc) const {
#pragma unroll
        for (int ai = 0; ai < 2; ++ai)
#pragma unroll
            for (int m = 0; m < 4; ++m) { h16* rowp = base + (size_t)(row0 + ai * HALF + m * 16) * ld + c0;
#pragma unroll
                for (int bj = 0; bj < 2; ++bj) { const f32x4 v0 = acc[ai][bj][m][0] * sc, v1 = acc[ai][bj][m][1] * sc;
                    u32x4 w; w.x = cvt_pk_h16(v0[0], v0[1]); w.y = cvt_pk_h16(v0[2], v0[3]); w.z = cvt_pk_h16(v1[0], v1[1]); w.w = cvt_pk_h16(v1[2], v1[3]);
                    *(u32x4*)(rowp + bj * HALF) = w; } }
    }
    __device__ __forceinline__ void operator()(const f32x4 (&acc)[2][2][4][2], const Unit& u, int wr, int wc, int fr, int fq) const {
        const int row0 = u.pm * BM + wr * 64 + fr, cw = wc * 32 + 8 * fq; const int pn = u.pn;
        if (pn < 6) { store_h16(acc, (h16*)(qkv + (size_t)(pn >> 1) * qkv_stride), 512, row0, (pn & 1) * 256 + cw, pn < 2 ? 0.125f * 1.4426950408889634f : 1.0f); }
        else if (pn >= 9) { store_h16(acc, LRU, 1024, row0, (pn - 9) * 256 + cw, 1.0f); }
        else if (pn < 8) { store_h16(acc, QS, 512, row0, (pn - 6) * 256 + cw, 0.125f); }
        else {
#pragma unroll
            for (int ai = 0; ai < 2; ++ai)
#pragma unroll
                for (int m = 0; m < 4; ++m) { const size_t row = (size_t)(row0 + ai * HALF + m * 16); const f32x4 v0 = acc[ai][0][m][0], v1 = acc[ai][0][m][1];
                    if (cw < 64) { u32x4 w; w.x = cvt_pk_h16(v0[0], v0[1]); w.y = cvt_pk_h16(v0[2], v0[3]); w.z = cvt_pk_h16(v1[0], v1[1]); w.w = cvt_pk_h16(v1[2], v1[3]); *(u32x4*)(KI + row * 64 + cw) = w; }
                    else if (cw == 64) { const float sc = 0.5f * 0.35355339059327373f; *(f32x4*)(WI + row * 8) = v0 * sc; *(f32x4*)(WI + row * 8 + 4) = v1 * sc; } }
        }
    }
};

template <class Epi, class Sched, bool ALIGN_EPI = false>
__device__ __forceinline__ void gemm_phase(PG8_LAS unsigned char* lds, const Gemm g, const Sched& S, const Epi& E) {
    const int tid = threadIdx.x, wid = __builtin_amdgcn_readfirstlane(tid >> 6), lane = tid & 63, wr = wid >> 2, wc = wid & 3, fr = lane & 15, fq = lane >> 4;
    const int K = g.K, nt = K / BK;
    unsigned voffA[2], voffB[2];
#pragma unroll
    for (int i = 0; i < 2; ++i) { int R, C; stage_rc(tid * 16 + i * 8192, R, C); const int Rb = Epi::PERM ? ((R & ~31) + perm32(R & 31)) : R;
        voffA[i] = (unsigned)(R * K + C) * 2u; voffB[i] = (unsigned)(Rb * K + C) * 2u; }
    const size_t kstep = (size_t)(BK * 2);
    const size_t hstep = (size_t)HALF * K * 2;
    const size_t tstep = 2 * hstep;
    const unsigned ldsw = (unsigned)wid * 1024u;
    const int aoff = lds_byte(wr * 64 + fr, fq * 8), boff = lds_byte(wc * 32 + fr, fq * 8);
#define PG8_SA(b, h) (((b) * 2 + (h)) * HTB)
#define PG8_SB(b, h) ((4 + (b) * 2 + (h)) * HTB)
#define PG8_STAGE(bufoff, gbase, voff) do { _Pragma("unroll") for (int _i = 0; _i < 2; ++_i) \
        __builtin_amdgcn_global_load_lds((const unsigned*)((const char*)(gbase) + (voff)[_i]), (PG8_LAS unsigned*)(lds + (bufoff) + ldsw + _i * 8192), 16, 0, 0); } while (0)
#define PG8_LDA(dst, b, h) do { _Pragma("unroll") for (int m = 0; m < 4; ++m) _Pragma("unroll") for (int k = 0; k < 2; ++k) dst[m][k] = *(const PG8_LAS h16x8*)(lds + PG8_SA(b, h) + aoff + m * 2048 + k * 1024); } while (0)
#define PG8_LDB(dst, b, h) do { _Pragma("unroll") for (int n = 0; n < 2; ++n) _Pragma("unroll") for (int k = 0; k < 2; ++k) dst[n][k] = *(const PG8_LAS h16x8*)(lds + PG8_SB(b, h) + boff + n * 2048 + k * 1024); } while (0)
#define PG8_MMA(ai, bj, At, Bt) do { __builtin_amdgcn_s_setprio(1); _Pragma("unroll") for (int m = 0; m < 4; ++m) _Pragma("unroll") for (int n = 0; n < 2; ++n) _Pragma("unroll") for (int k = 0; k < 2; ++k) \
        acc[ai][bj][m][n] = __builtin_amdgcn_mfma_f32_16x16x32_f16(Bt[n][k], At[m][k], acc[ai][bj][m][n], 0, 0, 0); __builtin_amdgcn_s_setprio(0); } while (0)
#define PG8_WAIT_V(n) asm volatile("s_waitcnt vmcnt(" #n ")" ::: "memory")
#define PG8_WAIT_L(n) asm volatile("s_waitcnt lgkmcnt(" #n ")" ::: "memory")
#define PG8_BAR __builtin_amdgcn_s_barrier()
#define PG8_SCHED __builtin_amdgcn_sched_barrier(0)
    Unit cur, nxt; int ui = 0;
    if (!S.next(0, cur)) return;
    f32x4 acc[2][2][4][2];
#pragma unroll
    for (int a = 0; a < 2; ++a)
#pragma unroll
        for (int b = 0; b < 2; ++b)
#pragma unroll
            for (int m = 0; m < 4; ++m)
#pragma unroll
                for (int n = 0; n < 2; ++n) acc[a][b][m][n] = (f32x4){0.f, 0.f, 0.f, 0.f};
    h16x8 At[4][2], B0[2][2], B1[2][2];
    const char* cA = (const char*)g.A + (size_t)cur.pm * tstep; const char* cB = (const char*)g.Bt + (size_t)cur.pn * tstep;
    S.a_ready(cur);
    PG8_STAGE(PG8_SB(0, 0), cB, voffB); PG8_STAGE(PG8_SB(0, 1), cB + hstep, voffB); PG8_STAGE(PG8_SA(0, 0), cA, voffA); PG8_STAGE(PG8_SA(0, 1), cA + hstep, voffA);
    if (wr == 1) PG8_BAR;
    PG8_WAIT_V(2); PG8_BAR;
    PG8_STAGE(PG8_SB(1, 0), cB + kstep, voffB); PG8_STAGE(PG8_SA(1, 0), cA + kstep, voffA); PG8_STAGE(PG8_SB(1, 1), cB + hstep + kstep, voffB);
    PG8_WAIT_V(6); PG8_BAR;
    for (;;) {
        const bool has_next = S.next(ui + 1, nxt);
        const char* nA = has_next ? (const char*)g.A + (size_t)nxt.pm * tstep : cA; const char* nB = has_next ? (const char*)g.Bt + (size_t)nxt.pn * tstep : cB;
        for (int t = 0; t < nt; t += 2) {
            const bool last = (t == nt - 2);
            const char* a1 = cA + (size_t)(t + 1) * kstep;
            const char* a2 = last ? nA : cA + (size_t)(t + 2) * kstep; const char* b2 = last ? nB : cB + (size_t)(t + 2) * kstep;
            const char* a3 = a2 + kstep; const char* b3 = b2 + kstep;
            if (last && has_next) S.a_ready(nxt);
            PG8_LDB(B0, 0, 0); PG8_LDB(B1, 0, 1); PG8_SCHED; PG8_LDA(At, 0, 0); PG8_STAGE(PG8_SA(1, 1), a1 + hstep, voffA);
            PG8_WAIT_V(8); PG8_WAIT_L(0); PG8_BAR; PG8_MMA(0, 0, At, B0); PG8_MMA(0, 1, At, B1); PG8_BAR; PG8_SCHED;
            PG8_LDA(At, 0, 1); PG8_STAGE(PG8_SB(0, 0), b2, voffB); PG8_STAGE(PG8_SB(0, 1), b2 + hstep, voffB); PG8_STAGE(PG8_SA(0, 0), a2, voffA);
            PG8_WAIT_V(8); PG8_WAIT_L(0); PG8_BAR; PG8_MMA(1, 0, At, B0); PG8_MMA(1, 1, At, B1); PG8_BAR; PG8_SCHED;
            PG8_LDB(B0, 1, 0); PG8_LDB(B1, 1, 1); PG8_SCHED; PG8_LDA(At, 1, 0); PG8_STAGE(PG8_SA(0, 1), a2 + hstep, voffA);
            PG8_WAIT_V(8); PG8_WAIT_L(0); PG8_BAR; PG8_MMA(0, 0, At, B0); PG8_MMA(0, 1, At, B1); PG8_BAR; PG8_SCHED;
            PG8_LDA(At, 1, 1); PG8_STAGE(PG8_SB(1, 0), b3, voffB); PG8_STAGE(PG8_SB(1, 1), b3 + hstep, voffB); PG8_STAGE(PG8_SA(1, 0), a3, voffA);
            PG8_WAIT_V(8); PG8_WAIT_L(0); PG8_BAR; PG8_MMA(1, 0, At, B0); PG8_MMA(1, 1, At, B1); PG8_BAR; PG8_SCHED;
        }
        if constexpr (ALIGN_EPI) { if (wr == 0) PG8_BAR; }
        E(acc, cur, wr, wc, fr, fq); S.done(cur);
        if (!has_next) break;
#pragma unroll
        for (int a = 0; a < 2; ++a)
#pragma unroll
            for (int b = 0; b < 2; ++b)
#pragma unroll
                for (int m = 0; m < 4; ++m)
#pragma unroll
                    for (int n = 0; n < 2; ++n) acc[a][b][m][n] = (f32x4){0.f, 0.f, 0.f, 0.f};
        cur = nxt; cA = nA; cB = nB; ++ui;
        if constexpr (ALIGN_EPI) { if (wr == 1) PG8_BAR; }
    }
    PG8_WAIT_V(0);
    if constexpr (!ALIGN_EPI) { if (wr == 0) PG8_BAR; }
    PG8_BAR;
#undef PG8_SA
#undef PG8_SB
#undef PG8_STAGE
#undef PG8_LDA
#undef PG8_LDB
#undef PG8_MMA
#undef PG8_WAIT_V
#undef PG8_WAIT_L
#undef PG8_BAR
#undef PG8_SCHED
}
}

constexpr int NWAVES = 8, NTHR = NWAVES * 64;
constexpr int N_LAUNCHES = MK_N_LAUNCHES;
constexpr int N_PHASES = 16;
constexpr int BATCH = 2, SEQ = 8192, D = 1024, FF = 2816, M = BATCH * SEQ;
constexpr int NGU = 2 * FF;
constexpr int NPROJ = 3328;
constexpr int DIN = 3144;
constexpr int NH = 8, HD = 64, DATT = 512, DLRU = 512, TOPK = 256, CHUNK = 64;
constexpr int LCH = 32, NLCH = SEQ / LCH;
constexpr float EPS = 1e-6f;

constexpr size_t MiB = 1u << 20;
constexpr size_t WS_CTL = 0, CTL_ZERO_BYTES = 1 * MiB;
constexpr size_t WS_MOD = 1 * MiB;
constexpr size_t WS_LRUW = 2 * MiB;
constexpr size_t WS_LRUS = 246 * MiB;
constexpr size_t WS_W1GU = 3 * MiB, WS_W1D = 14 * MiB, WS_WIN = 20 * MiB, WS_WOUT = 27 * MiB, WS_W2GU = 29 * MiB, WS_W2D = 40 * MiB;
constexpr size_t WS_H = 46 * MiB;
constexpr size_t WS_ACT = 78 * MiB;
constexpr size_t WS_Y = 166 * MiB;
constexpr size_t WS_Q = 78 * MiB, WS_K = 94 * MiB, WS_V = 110 * MiB;
constexpr size_t WS_QS = 126 * MiB;
constexpr size_t WS_O = 142 * MiB;
constexpr size_t WS_KI = 158 * MiB;
constexpr size_t WS_WI = 160 * MiB;
constexpr size_t WS_MASK = 230 * MiB;
constexpr size_t WS_LRU = 166 * MiB;
constexpr size_t WS_MERGED = WS_H;
constexpr size_t WS_END = 248 * MiB;
constexpr int CW_BAR = 4096;

constexpr int RING_OFF = 0, RING_BYTES = 131072;
constexpr int LDSCTL_OFF = RING_BYTES, MISC_OFF = LDSCTL_OFF + 320;
constexpr int LDS_BYTES = 147456;

#define GAS __attribute__((address_space(1)))
#define LAS __attribute__((address_space(3)))
typedef _Float16 h16;
typedef unsigned v4u __attribute__((ext_vector_type(4)));
typedef unsigned v2u __attribute__((ext_vector_type(2)));
typedef float f32x4 __attribute__((ext_vector_type(4)));
typedef _Float16 h16x8 __attribute__((ext_vector_type(8)));
typedef _Float16 h16x4 __attribute__((ext_vector_type(4)));
typedef GAS unsigned gu32;
#define RLX_AGENT __ATOMIC_RELAXED, __HIP_MEMORY_SCOPE_AGENT
#define LDS_WAIT() asm volatile("s_waitcnt lgkmcnt(0)" ::: "memory")
#define VM_WAIT() asm volatile("s_waitcnt vmcnt(0)" ::: "memory")
using pg8::cvt_pk_h16;

#define XB_TMO      128
#define XB_XCNT(j)  (256  + 64 * (j))
#define XB_XSUB(j)  (1280 + 64 * (j))
#define XB_XGEN(j)  (2304 + 64 * (j))
#define XB_TOP      3328
#define XB_TOPGEN   3392
#define XCD_BAR_WORDS 3456
#define XB_SPIN_CAP (1u << 18)
__device__ __forceinline__ unsigned xb_ld(unsigned* p)              { return __hip_atomic_load(p, __ATOMIC_RELAXED, __HIP_MEMORY_SCOPE_AGENT); }
__device__ __forceinline__ unsigned xb_add(unsigned* p, unsigned v) { return __hip_atomic_fetch_add(p, v, __ATOMIC_RELAXED, __HIP_MEMORY_SCOPE_AGENT); }
__device__ __forceinline__ unsigned xb_xcc_id() { return (unsigned)__builtin_amdgcn_s_getreg((3 << 11) | 20) & 0xFu; }
#define XB_SPIN(cond, bar) do { unsigned _sp = 0; while (cond) { __builtin_amdgcn_s_sleep(1); \
    if ((++_sp & 255u) == 0u) { if (xb_ld(&(bar)[XB_TMO])) break; if (_sp > XB_SPIN_CAP) { atomicAdd(&(bar)[XB_TMO], 1u); break; } } } } while (0)
struct XcdBarrier { unsigned* bar; unsigned x; volatile LAS unsigned* st; };
__device__ __forceinline__ XcdBarrier xcd_barrier_post(unsigned* bar, volatile LAS unsigned* st) {
    XcdBarrier b; b.bar = bar; b.x = xb_xcc_id(); b.st = st;
    if (threadIdx.x == 0) (void)xb_add(&bar[XB_XCNT(b.x)], 1u);
    return b;
}
__device__ __forceinline__ void xcd_barrier_complete(unsigned* bar, unsigned x, unsigned& nloc, unsigned& nx) {
    const unsigned G = gridDim.x * gridDim.y * gridDim.z;
    unsigned sum, cnt, mine, sp = 0u;
    for (;;) {
        sum = 0u; cnt = 0u; mine = 0u;
#pragma unroll
        for (unsigned j = 0; j < 16; ++j) { const unsigned c = xb_ld(&bar[XB_XCNT(j)]); sum += c; cnt += (c > 0u) ? 1u : 0u; mine = (j == x) ? c : mine; }
        if (sum == G) break;
        __builtin_amdgcn_s_sleep(1);
        if ((++sp & 255u) == 0u) { if (xb_ld(&bar[XB_TMO])) break; if (sp > XB_SPIN_CAP) { atomicAdd(&bar[XB_TMO], 1u); break; } }
    }
    nloc = mine > 0u ? mine : 1u; nx = cnt > 0u ? cnt : 1u;
}
__device__ __forceinline__ void xcd_barrier(const XcdBarrier& b) {
    asm volatile("s_waitcnt vmcnt(0)" ::: "memory");
    __syncthreads();
    if (threadIdx.x == 0) {
        unsigned* bar = b.bar;
        __builtin_amdgcn_s_waitcnt(0);
        unsigned nloc = b.st[0], nx = b.st[1];
        if (nloc == 0u) { xcd_barrier_complete(bar, b.x, nloc, nx); b.st[0] = nloc; b.st[1] = nx; }
        const unsigned old = xb_add(&bar[XB_XSUB(b.x)], 1u);
        const unsigned gen = old / nloc;
        if (old + 1u == (gen + 1u) * nloc) {
            __builtin_amdgcn_fence(__ATOMIC_RELEASE, "agent");
            asm volatile("s_waitcnt vmcnt(0)" ::: "memory");
            const unsigned og = xb_add(&bar[XB_TOP], 1u);
            const unsigned tg = og / nx;
            if (og + 1u == (tg + 1u) * nx) xb_add(&bar[XB_TOPGEN], 1u);
            else XB_SPIN(xb_ld(&bar[XB_TOPGEN]) == tg, bar);
            __builtin_amdgcn_fence(__ATOMIC_ACQUIRE, "agent");
            xb_add(&bar[XB_XGEN(b.x)], 1u);
            asm volatile("s_waitcnt vmcnt(0)" ::: "memory");
        } else {
            XB_SPIN(xb_ld(&bar[XB_XGEN(b.x)]) == gen, bar);
            __builtin_amdgcn_fence(__ATOMIC_ACQUIRE, "agent");
            asm volatile("s_waitcnt vmcnt(0)" ::: "memory");
        }
    }
    __syncthreads();
}

struct Frame {
    LAS unsigned char* lds;
    volatile LAS unsigned* MISC;
    gu32* ctl;
    int tid, lane, wave;
    int vcu, G;
};
struct Args { const float* in[28]; float* out; unsigned char* ws; int ph_lo, ph_hi, li, pad; };

__device__ __forceinline__ float wave_sum(float v) {
#pragma unroll
    for (int o = 1; o < 64; o <<= 1) v += __shfl_xor(v, o);
    return v;
}
__device__ __forceinline__ float wave_max(float v) {
#pragma unroll
    for (int o = 1; o < 64; o <<= 1) v = fmaxf(v, __shfl_xor(v, o));
    return v;
}

struct MapId { __device__ __forceinline__ int operator()(int n) const { return n; } };
struct MapGU { int half; __device__ __forceinline__ int operator()(int n) const { return (n >> 7) * 256 + half * 128 + (n & 127); } };
struct MapIn { __device__ __forceinline__ int operator()(int n) const { return n < 2120 ? n : n + 184; } };
template <class RowMap>
__device__ __forceinline__ void p0_transpose_item(const float* W, int K, int N, h16* WT, RowMap rm, LAS float* scr, int item, int lane) {
    const int nblk = (N + 31) / 32, kb = item / nblk, nb = item % nblk, k0 = 64 * kb, n0 = 32 * nb;
    const int nl = n0 + (lane & 31);
#pragma unroll 8
    for (int i = 0; i < 32; ++i) { const int kk = 2 * i + (lane >> 5); scr[kk * 33 + (lane & 31)] = (nl < N) ? W[(size_t)(k0 + kk) * N + nl] : 0.f; }
    LDS_WAIT(); asm volatile("" ::: "memory");
    const int c = lane & 7;
#pragma unroll
    for (int j = 0; j < 4; ++j) { const int nn = (lane >> 3) + 8 * j; const LAS float* s = scr + (8 * c) * 33 + nn;
        v4u o; o.x = cvt_pk_h16(s[0 * 33], s[1 * 33]); o.y = cvt_pk_h16(s[2 * 33], s[3 * 33]); o.z = cvt_pk_h16(s[4 * 33], s[5 * 33]); o.w = cvt_pk_h16(s[6 * 33], s[7 * 33]);
        if (n0 + nn < N) *(GAS v4u*)(WT + (size_t)rm(n0 + nn) * K + k0 + 8 * c) = o; }
    LDS_WAIT(); asm volatile("" ::: "memory");
}

__device__ __forceinline__ void p0_prologue(Frame& F, const Args& A) {
    unsigned char* ws = A.ws;
    if (blockIdx.x < 36) {
        LAS float* sc = (LAS float*)(F.lds);
        LAS float* red = (LAS float*)(F.lds + 8192);
        const float* c = A.in[1];
        for (int i = F.tid; i < 2048; i += NTHR) { const float v = c[i]; sc[i] = v / (1.0f + __expf(-v)); }
        __syncthreads();
        const float* wa = A.in[2]; const int col = blockIdx.x * 256 + 4 * F.lane;
        f32x4 a0 = {0.f, 0.f, 0.f, 0.f}, a1 = {0.f, 0.f, 0.f, 0.f};
        const int kb = F.wave * 128;
#pragma unroll 8
        for (int k = 0; k < 128; ++k) { const f32x4 w = *(const f32x4*)(wa + (size_t)(kb + k) * 9216 + col); a0 += w * sc[kb + k]; a1 += w * sc[1024 + kb + k]; }
        *(LAS f32x4*)(red + (F.wave * 2 + 0) * 256 + 4 * F.lane) = a0; *(LAS f32x4*)(red + (F.wave * 2 + 1) * 256 + 4 * F.lane) = a1;
        __syncthreads();
        { const int b = F.tid >> 8, j = F.tid & 255; float s = 0.f;
#pragma unroll
          for (int w = 0; w < 8; ++w) s += red[(w * 2 + b) * 256 + j];
          const int cc = blockIdx.x * 256 + j; ((float*)(ws + WS_MOD))[b * 9216 + cc] = s + A.in[3][cc]; }
        __syncthreads();
    }
    LAS float* scr = (LAS float*)(F.lds + RING_OFF + F.wave * 16384);
    const int gw = F.vcu * NWAVES + F.wave, NGW = F.G * NWAVES;
    constexpr int I_GU = (D / 64) * (FF / 32), I_DN = (FF / 64) * (D / 32), I_IN = (D / 64) * ((DIN + 31) / 32), I_OUT = (D / 64) * (D / 32);
    constexpr int NITEMS = 6 * I_GU + I_IN + I_OUT; static_assert(I_GU == I_DN, "items");
    h16* W1GU = (h16*)(ws + WS_W1GU); h16* W1D = (h16*)(ws + WS_W1D); h16* WIN = (h16*)(ws + WS_WIN); h16* WOUT = (h16*)(ws + WS_WOUT); h16* W2GU = (h16*)(ws + WS_W2GU); h16* W2D = (h16*)(ws + WS_W2D);
    for (int it = gw; it < NITEMS; it += NGW) {
        int r = it;
        if (r < I_GU) { p0_transpose_item(A.in[6], D, FF, W1GU, MapGU{0}, scr, r, F.lane); continue; } r -= I_GU;
        if (r < I_GU) { p0_transpose_item(A.in[7], D, FF, W1GU, MapGU{1}, scr, r, F.lane); continue; } r -= I_GU;
        if (r < I_DN) { p0_transpose_item(A.in[8], FF, D, W1D, MapId{}, scr, r, F.lane); continue; } r -= I_DN;
        if (r < I_IN) { p0_transpose_item(A.in[11], D, DIN, WIN, MapIn{}, scr, r, F.lane); continue; } r -= I_IN;
        if (r < I_OUT) { p0_transpose_item(A.in[22], D, D, WOUT, MapId{}, scr, r, F.lane); continue; } r -= I_OUT;
        if (r < I_GU) { p0_transpose_item(A.in[25], D, FF, W2GU, MapGU{0}, scr, r, F.lane); continue; } r -= I_GU;
        if (r < I_GU) { p0_transpose_item(A.in[26], D, FF, W2GU, MapGU{1}, scr, r, F.lane); continue; } r -= I_GU;
        p0_transpose_item(A.in[27], FF, D, W2D, MapId{}, scr, r, F.lane);
    }
    for (int tk = gw; tk < 128; tk += NGW) { const int s4 = tk & 3, jt = (tk >> 2) & 1, g = (tk >> 3) & 7, gate = tk >> 6; const float* W = A.in[gate ? 17 : 15]; const int r = F.lane & 31, hh = F.lane >> 5;
        float v[8];
#pragma unroll
        for (int e = 0; e < 8; ++e) v[e] = W[(g * 64 + 16 * s4 + 8 * hh + e) * 64 + 32 * jt + r];
        v4u o; o.x = cvt_pk_h16(v[0], v[1]); o.y = cvt_pk_h16(v[2], v[3]); o.z = cvt_pk_h16(v[4], v[5]); o.w = cvt_pk_h16(v[6], v[7]);
        *(GAS v4u*)(ws + WS_LRUW + ((size_t)tk * 64 + F.lane) * 16) = o; }
    for (int i = blockIdx.x * NTHR + F.tid; i < 184 * 128; i += F.G * NTHR) *(GAS v4u*)(WIN + (size_t)2120 * D + (size_t)i * 8) = (v4u){0u, 0u, 0u, 0u};
}

template <bool HAS_Y, bool HAS_H>
__device__ __forceinline__ void thin_phase(Frame& F, const float* mod, const float* yin, const float* gpost, float gscale, int mg,
                                           const float* xin, float* xout, const float* gpre, int msh, int msc, h16* hout) {
    LAS float* TA = (LAS float*)(F.lds); LAS float* TB = TA + 2048; LAS float* TC = TB + 2048;
    for (int i = F.tid; i < 2048; i += NTHR) { const int b = i >> 10, cidx = i & 1023;
        if (HAS_Y) TA[i] = gscale * mod[b * 9216 + mg * 1024 + cidx] * gpost[cidx];
        if (HAS_H) { TB[i] = gpre[cidx] * (1.0f + mod[b * 9216 + msc * 1024 + cidx]); TC[i] = mod[b * 9216 + msh * 1024 + cidx]; } }
    __syncthreads();
    const int gw = F.vcu * NWAVES + F.wave, NGW = F.G * NWAVES;
    for (int row = gw; row < M; row += NGW) {
        const int b = row >> 13;
        const GAS f32x4* xr = (const GAS f32x4*)(xin + (size_t)row * D) + F.lane;
        f32x4 x[4];
#pragma unroll
        for (int j = 0; j < 4; ++j) x[j] = xr[64 * j];
        if (HAS_Y) {
            const GAS f32x4* yr = (const GAS f32x4*)(yin + (size_t)row * D) + F.lane;
            f32x4 y[4]; float s = 0.f;
#pragma unroll
            for (int j = 0; j < 4; ++j) { y[j] = yr[64 * j]; s += (y[j].x * y[j].x + y[j].y * y[j].y) + (y[j].z * y[j].z + y[j].w * y[j].w); }
            const float rstd = 1.0f / sqrtf(wave_sum(s) * (1.0f / D) + EPS);
            GAS f32x4* xo = (GAS f32x4*)(xout + (size_t)row * D) + F.lane;
#pragma unroll
            for (int j = 0; j < 4; ++j) { const f32x4 ta = *(const LAS f32x4*)(TA + b * 1024 + 4 * F.lane + 256 * j); x[j] = x[j] + ta * (y[j] * rstd); xo[64 * j] = x[j]; }
        }
        if (HAS_H) {
            float s = 0.f;
#pragma unroll
            for (int j = 0; j < 4; ++j) s += (x[j].x * x[j].x + x[j].y * x[j].y) + (x[j].z * x[j].z + x[j].w * x[j].w);
            const float rstd = 1.0f / sqrtf(wave_sum(s) * (1.0f / D) + EPS);
            GAS v2u* ho = (GAS v2u*)(hout + (size_t)row * D) + F.lane;
#pragma unroll
            for (int j = 0; j < 4; ++j) { const f32x4 tb = *(const LAS f32x4*)(TB + b * 1024 + 4 * F.lane + 256 * j), tc = *(const LAS f32x4*)(TC + b * 1024 + 4 * F.lane + 256 * j);
                const f32x4 h = (x[j] * rstd) * tb + tc; v2u o; o.x = cvt_pk_h16(h.x, h.y); o.y = cvt_pk_h16(h.z, h.w); ho[64 * j] = o; }
        }
    }
    __syncthreads();
}

__device__ __forceinline__ float gelu_tanh(float x) { const float u = 0.7978845608028654f * (x + 0.044715f * x * x * x); const float e = __expf(2.0f * u); const float t = 1.0f - 2.0f / (e + 1.0f); return 0.5f * x * (1.0f + t); }
__device__ __forceinline__ float lane_partner(float x, int hh) { auto rr = __builtin_amdgcn_permlane32_swap(__float_as_uint(x), __float_as_uint(x), false, false); return __uint_as_float(hh ? rr[0] : rr[1]); }
typedef float f32x16 __attribute__((ext_vector_type(16)));
__device__ __forceinline__ int crow(int r, int hi) { return (r & 3) + 8 * (r >> 2) + 4 * hi; }
constexpr int LL_XC = 0, LL_OUT = 32768, LL_CAR = 131072 + 1024;
template <bool PASS_B>
__device__ __forceinline__ void lru_phase(Frame& F, const Args& A) {
    unsigned char* ws = A.ws;
    const h16* LRU = (const h16*)(ws + WS_LRU); float* SA = (float*)(ws + WS_LRUS); float* SB = SA + BATCH * NLCH * DLRU;
    h16* MERGED = (h16*)(ws + WS_MERGED);
    const int tid = F.tid, lane = F.lane, g = F.wave, r = lane & 31, hh = lane >> 5;
    LAS unsigned char* XC = F.lds + LL_XC; LAS float* OUT = (LAS float*)(F.lds + LL_OUT); LAS float* CAR = (LAS float*)(F.lds + LL_CAR);
    const h16x8* LW = (const h16x8*)(ws + WS_LRUW);
    float ba[2], bi[2], sp8[2];
#pragma unroll
    for (int jt = 0; jt < 2; ++jt) { const int ch = g * 64 + 32 * jt + r; ba[jt] = A.in[16][ch]; bi[jt] = A.in[18][ch]; const float lam = A.in[19][ch]; sp8[jt] = 8.0f * ((lam < -15.f) ? -lam : log1pf(__expf(-lam))); }
    for (int p = blockIdx.x; p < 256; p += F.G) {
#pragma unroll 1
        for (int uu = 0; uu < 2; ++uu) {
            const int b = p >> 7, c = uu ? 255 - (p & 127) : (p & 127), t0 = c * LCH;
            const h16* xb = LRU + (size_t)(b * SEQ) * 1024;
            __syncthreads();
            { h16x8 xr[7]; f32x4 cwv[4][2], cbv[2];
              cbv[0] = *(const f32x4*)(A.in[14] + 8 * lane); cbv[1] = *(const f32x4*)(A.in[14] + 8 * lane + 4);
#pragma unroll
              for (int jx = 0; jx < 4; ++jx) { cwv[jx][0] = *(const f32x4*)(A.in[13] + jx * DLRU + 8 * lane); cwv[jx][1] = *(const f32x4*)(A.in[13] + jx * DLRU + 8 * lane + 4); }
#pragma unroll
              for (int k = 0; k < 7; ++k) { const int t = t0 + 4 * g - 3 + k; if (t >= 0) xr[k] = *(const h16x8*)(xb + (size_t)t * 1024 + 8 * lane); else xr[k] = (h16x8){0, 0, 0, 0, 0, 0, 0, 0}; }
#pragma unroll
              for (int tt = 0; tt < 4; ++tt) { float v[8];
#pragma unroll
                  for (int e = 0; e < 8; ++e) v[e] = cbv[e >> 2][e & 3] + (float)xr[tt][e] * cwv[0][e >> 2][e & 3] + (float)xr[tt + 1][e] * cwv[1][e >> 2][e & 3] + (float)xr[tt + 2][e] * cwv[2][e >> 2][e & 3] + (float)xr[tt + 3][e] * cwv[3][e >> 2][e & 3];
                  v4u o; o.x = cvt_pk_h16(v[0], v[1]); o.y = cvt_pk_h16(v[2], v[3]); o.z = cvt_pk_h16(v[4], v[5]); o.w = cvt_pk_h16(v[6], v[7]);
                  const int row = 4 * g + tt; *(LAS v4u*)(XC + row * 1024 + ((lane ^ (row & 7)) << 4)) = o; } }
            if (PASS_B) { float H = 0.f; const float* pa = SA + (size_t)(b * NLCH) * DLRU + tid; const float* pb = SB + (size_t)(b * NLCH) * DLRU + tid;
#pragma unroll 8
                for (int cc = 0; cc < c; ++cc) H = pa[(size_t)cc * DLRU] * H + pb[(size_t)cc * DLRU];
                CAR[tid] = H; }
            __syncthreads();
            h16x8 af[4];
#pragma unroll
            for (int s = 0; s < 4; ++s) af[s] = *(const LAS h16x8*)(XC + r * 1024 + (((g * 8 + 2 * s + hh) ^ (r & 7)) << 4));
#pragma unroll
            for (int jt = 0; jt < 2; ++jt) {
                float gt[16];
                if (PASS_B) {
#pragma unroll
                    for (int i = 0; i < 16; ++i) gt[i] = (float)xb[(size_t)(t0 + crow(i, hh)) * 1024 + 512 + g * 64 + 32 * jt + r]; }
                float av[16], bv[16];
                const int ch = g * 64 + 32 * jt + r;
                {   h16x8 wf[4];
#pragma unroll
                    for (int s = 0; s < 4; ++s) wf[s] = LW[(((0 * 8 + g) * 2 + jt) * 4 + s) * 64 + lane];
                    f32x16 za = {};
#pragma unroll
                    for (int s = 0; s < 4; ++s) za = __builtin_amdgcn_mfma_f32_32x32x16_f16(af[s], wf[s], za, 0, 0, 0);
#pragma unroll
                    for (int i = 0; i < 16; ++i) { const float rg = 1.0f / (1.0f + __expf(-(za[i] + ba[jt]))); const float la = -sp8[jt] * rg, y = 2.0f * la;
                        const float em = (y > -0.03f) ? -y * (1.0f + y * (0.5f + y * (0.16666667f + y * 0.041666668f))) : 1.0f - __expf(y);
                        av[i] = __expf(la); bv[i] = sqrtf(em); } }
                {   h16x8 wf[4];
#pragma unroll
                    for (int s = 0; s < 4; ++s) wf[s] = LW[(((1 * 8 + g) * 2 + jt) * 4 + s) * 64 + lane];
                    f32x16 zi = {};
#pragma unroll
                    for (int s = 0; s < 4; ++s) zi = __builtin_amdgcn_mfma_f32_32x32x16_f16(af[s], wf[s], zi, 0, 0, 0);
#pragma unroll
                    for (int i = 0; i < 16; ++i) { const int t = crow(i, hh); const float ig = 1.0f / (1.0f + __expf(-(zi[i] + bi[jt])));
                        const float xcv = (float)*(const LAS h16*)(XC + t * 1024 + ((((ch >> 3)) ^ (t & 7)) << 4) + (ch & 7) * 2);
                        bv[i] *= ig * xcv; } }
                float GA[4], GB[4];
#pragma unroll
                for (int k = 0; k < 4; ++k) { float Ak = av[4 * k], Bk = bv[4 * k];
#pragma unroll
                    for (int e = 1; e < 4; ++e) { Bk = av[4 * k + e] * Bk + bv[4 * k + e]; Ak *= av[4 * k + e]; }
                    GA[k] = Ak; GB[k] = Bk; }
                float state = PASS_B ? CAR[ch] : 0.f; float cin[4];
#pragma unroll
                for (int k = 0; k < 4; ++k) { const float out0 = GA[k] * state + GB[k]; const float p0 = lane_partner(out0, hh); const float in1 = hh ? p0 : state; cin[k] = in1;
                    const float out1 = GA[k] * in1 + GB[k]; const float p1 = lane_partner(out1, hh); state = hh ? out1 : p1; }
                if (!PASS_B) { float P = (GA[0] * GA[1]) * (GA[2] * GA[3]); P *= lane_partner(P, hh);
                    if (hh == 0) { SA[(size_t)(b * NLCH + c) * DLRU + ch] = P; SB[(size_t)(b * NLCH + c) * DLRU + ch] = state; } }
                else {
#pragma unroll
                    for (int k = 0; k < 4; ++k) { float h = cin[k];
#pragma unroll
                        for (int e = 0; e < 4; ++e) { const int i = 4 * k + e; h = av[i] * h + bv[i]; OUT[crow(i, hh) * 512 + ch] = h * gelu_tanh(gt[i]); } } }
            }
            if (PASS_B) {
                __syncthreads();
#pragma unroll
                for (int k = 0; k < 4; ++k) { const int tt = 4 * g + k;
                    const f32x4 o0 = *(const LAS f32x4*)(OUT + tt * 512 + 8 * lane), o1 = *(const LAS f32x4*)(OUT + tt * 512 + 8 * lane + 4);
                    const float s = (o0.x * o0.x + o0.y * o0.y) + (o0.z * o0.z + o0.w * o0.w) + (o1.x * o1.x + o1.y * o1.y) + (o1.z * o1.z + o1.w * o1.w);
                    const float rstd = 1.0f / sqrtf(wave_sum(s) * (1.0f / DLRU) + EPS);
                    const f32x4 g0 = *(const f32x4*)(A.in[21] + 8 * lane), g1 = *(const f32x4*)(A.in[21] + 8 * lane + 4);
                    v4u o; o.x = cvt_pk_h16(o0.x * rstd * g0.x, o0.y * rstd * g0.y); o.y = cvt_pk_h16(o0.z * rstd * g0.z, o0.w * rstd * g0.w);
                    o.z = cvt_pk_h16(o1.x * rstd * g1.x, o1.y * rstd * g1.y); o.w = cvt_pk_h16(o1.z * rstd * g1.z, o1.w * rstd * g1.w);
                    *(GAS v4u*)(MERGED + (size_t)(b * SEQ + t0 + tt) * 1024 + 512 + 8 * lane) = o; }
            }
        }
    }
}

constexpr int IDX_CAP = 128;
constexpr int IL_QL = 0, IL_WL = 36864, IL_INFO = 37888, IL_CNT = 38400, IL_HIST = 65536, IL_CAND = 65536, IL_SCR = 98304;
constexpr int SL_SCORE = 65536, SL_HIST = 98304, SL_CTL = 99328;
__device__ __forceinline__ unsigned ord_key(float f) { const unsigned u = __float_as_uint(f); return u ^ ((u >> 31) ? 0xFFFFFFFFu : 0x80000000u); }
__device__ __forceinline__ int t5_bucket(int rel) {
    const int n = rel < 0 ? -rel : rel; int large;
    if (n < 12) large = 8; else if (n < 16) large = 9; else if (n < 23) large = 10; else if (n < 32) large = 11; else if (n < 46) large = 12; else if (n < 64) large = 13; else if (n < 91) large = 14; else large = 15;
    return (rel > 0 ? 16 : 0) + (n < 8 ? n : large);
}
__device__ __forceinline__ void idx_scores(f32x16 (&S)[2], const h16x8 (&a)[2][4], const LAS unsigned char* ql, int foff, int sw, int hh, const LAS float* wl) {
    {   h16x8 qf[4];
#pragma unroll
        for (int s = 0; s < 4; ++s) qf[s] = *(const LAS h16x8*)(ql + 8 * 4096 + foff + (((2 * s + hh) ^ sw) << 4));
#pragma unroll
        for (int sub = 0; sub < 2; ++sub) { f32x16 acc = {};
#pragma unroll
            for (int s = 0; s < 4; ++s) acc = __builtin_amdgcn_mfma_f32_32x32x16_f16(a[sub][s], qf[s], acc, 0, 0, 0);
            S[sub] = acc; } }
#pragma unroll 1
    for (int h = 0; h < 8; ++h) {
        h16x8 qf[4]; const float wh = wl[h];
#pragma unroll
        for (int s = 0; s < 4; ++s) qf[s] = *(const LAS h16x8*)(ql + h * 4096 + foff + (((2 * s + hh) ^ sw) << 4));
#pragma unroll
        for (int sub = 0; sub < 2; ++sub) { f32x16 acc = {};
#pragma unroll
            for (int s = 0; s < 4; ++s) acc = __builtin_amdgcn_mfma_f32_32x32x16_f16(a[sub][s], qf[s], acc, 0, 0, 0);
#pragma unroll
            for (int i = 0; i < 16; ++i) S[sub][i] = __builtin_fmaf(__builtin_fabsf(acc[i]), wh, S[sub][i]); }
    }
}
__device__ __forceinline__ void idx_phase(Frame& F, const Args& A) {
    unsigned char* ws = A.ws;
    const h16* QS = (const h16*)(ws + WS_QS); const h16* KI = (const h16*)(ws + WS_KI); const float* WI = (const float*)(ws + WS_WI);
    unsigned* MASK = (unsigned*)(ws + WS_MASK);
    LAS unsigned char* L = F.lds;
    const int tid = F.tid, lane = F.lane, wave = F.wave, r = lane & 31, hh = lane >> 5;
    LAS float* WL = (LAS float*)(L + IL_WL); LAS int* INFO = (LAS int*)(L + IL_INFO); LAS unsigned* CNT = (LAS unsigned*)(L + IL_CNT);
    LAS unsigned* HIST = (LAS unsigned*)(L + IL_HIST);
    for (int p = blockIdx.x; p < 256; p += F.G) {
        const int b = p >> 7, jj = p & 127;
        for (int uu = 0; uu < 2; ++uu) {
            const int j = uu ? 255 - jj : jj;
            const int q0 = 32 * j, rowb = b * SEQ + q0, N = ((j >> 1) + 1) * 64, NC = N >> 6;
            unsigned* mrow = MASK + ((size_t)(b * 128) * 8192 + q0) * 2;
            if (N <= TOPK) {
                for (int i = tid; i < NC * 64; i += NTHR) mrow[(size_t)(i >> 6) * 16384 + (i & 63)] = 0xFFFFFFFFu;
                continue;
            }
            __syncthreads();
#pragma unroll
            for (int i = 0; i < 4; ++i) { const int idx = tid + NTHR * i, q = idx >> 6, cc = idx & 63, head = cc >> 3, c8 = cc & 7;
                const v4u v = *(const GAS v4u*)(QS + (size_t)(rowb + q) * 512 + cc * 8);
                *(LAS v4u*)(L + IL_QL + head * 4096 + q * 128 + ((c8 ^ (q & 7)) << 4)) = v; }
            if (tid < 256) WL[tid] = WI[(size_t)rowb * 8 + tid];
            for (int i = tid; i < 16384; i += NTHR) HIST[i] = 0u;
            if (tid < 32) CNT[tid] = 0u;
            __syncthreads();
            { const int q = tid >> 4, dg = tid & 15, c8 = dg >> 1; float a0 = 0.f, a1 = 0.f, a2 = 0.f, a3 = 0.f;
              const int o = q * 128 + ((c8 ^ (q & 7)) << 4) + (dg & 1) * 8;
#pragma unroll
              for (int h = 0; h < 8; ++h) { const h16x4 v = *(const LAS h16x4*)(L + IL_QL + h * 4096 + o); const float wv = WL[q * 8 + h];
                  a0 += wv * (float)v[0]; a1 += wv * (float)v[1]; a2 += wv * (float)v[2]; a3 += wv * (float)v[3]; }
              v2u pk; pk.x = cvt_pk_h16(a0, a1); pk.y = cvt_pk_h16(a2, a3); *(LAS v2u*)(L + IL_QL + 8 * 4096 + o) = pk; }
            __syncthreads();
            const LAS float* w = WL + r * 8;
            const int foff = r * 128, sw = r & 7;
            const h16* kbase = KI + (size_t)(b * SEQ) * 64 + (size_t)r * 64 + 8 * hh;
            const LAS unsigned char* ql = L + IL_QL;
#define IDX_LOADA(dst, c) do { _Pragma("unroll") for (int sub_ = 0; sub_ < 2; ++sub_) _Pragma("unroll") for (int s_ = 0; s_ < 4; ++s_) \
                dst[sub_][s_] = *(const h16x8*)(kbase + (size_t)(64 * (c) + 32 * sub_) * 64 + 16 * s_); } while (0)
            h16x8 a[2][4]; f32x16 S[2];
            IDX_LOADA(a, 0); idx_scores(S, a, ql, foff, sw, hh, w);
            float s1 = 0.f, s2 = 0.f;
#pragma unroll
            for (int sub = 0; sub < 2; ++sub)
#pragma unroll
                for (int i = 0; i < 16; ++i) { s1 += S[sub][i]; s2 += S[sub][i] * S[sub][i]; }
            s1 += __shfl_xor(s1, 32); s2 += __shfl_xor(s2, 32);
            const float mean = s1 * (1.0f / 64.0f), sd = sqrtf(fmaxf(s2 * (1.0f / 64.0f) - mean * mean, 1e-30f));
            const float inv_w = 510.0f / (8.0f * sd), off = 1.0f - (mean - 3.0f * sd) * inv_w;
            const int rot = 8 * ((r * 5) & 63);
            LAS unsigned* hq = HIST + r * 512;
            for (int c = wave; c < NC; c += 8) {
                IDX_LOADA(a, c); idx_scores(S, a, ql, foff, sw, hh, w);
#pragma unroll
                for (int sub = 0; sub < 2; ++sub)
#pragma unroll
                    for (int i = 0; i < 16; ++i) { const float f = floorf(__builtin_fmaf(S[sub][i], inv_w, off)); const int bin = (int)fminf(fmaxf(f, 0.f), 511.f);
                        __hip_atomic_fetch_add(hq + ((bin + rot) & 511), 1u, __ATOMIC_RELAXED, __HIP_MEMORY_SCOPE_WORKGROUP); }
            }
            __syncthreads();
#pragma unroll 1
            for (int k = 0; k < 4; ++k) { const int q = 4 * wave + k, rotq = 8 * ((q * 5) & 63), pos = (8 * lane + rotq) & 511;
                const v4u c0 = *(const LAS v4u*)(HIST + q * 512 + pos), c1 = *(const LAS v4u*)(HIST + q * 512 + pos + 4);
                const unsigned cn[8] = {c0.x, c0.y, c0.z, c0.w, c1.x, c1.y, c1.z, c1.w};
                unsigned v = ((cn[0] + cn[1]) + (cn[2] + cn[3])) + ((cn[4] + cn[5]) + (cn[6] + cn[7]));
#pragma unroll
                for (int o = 1; o < 64; o <<= 1) { const unsigned tv = __shfl_down(v, o); if (lane + o < 64) v += tv; }
                unsigned above = __shfl_down(v, 1); if (lane == 63) above = 0u;
                if (v >= (unsigned)TOPK && above < (unsigned)TOPK) {
                    unsigned cum = above; int bsel = -1; unsigned cb = 0u, ca = 0u;
#pragma unroll
                    for (int jx = 7; jx >= 0; --jx) { if (bsel < 0) { if (cum + cn[jx] >= (unsigned)TOPK) { bsel = 8 * lane + jx; cb = cn[jx]; ca = cum; } else cum += cn[jx]; } }
                    int slow = (bsel <= 0 || bsel >= 511 || cb > (unsigned)IDX_CAP) ? 1 : 0;
#ifdef IDX_FORCE_SLOW
                    if (((rowb + q) % 251) == 0) slow = 1;
#endif
                    INFO[q * 4 + 0] = bsel; INFO[q * 4 + 1] = TOPK - (int)ca; INFO[q * 4 + 2] = slow; }
            }
            __syncthreads();
            const float blo = (float)INFO[r * 4 + 0], bhi = blo + 1.0f;
            LAS float* scr = (LAS float*)(L + IL_SCR + wave * 4096);
            LAS unsigned* cand = (LAS unsigned*)(L + IL_CAND);
            for (int c = wave; c < NC; c += 8) {
                IDX_LOADA(a, c); idx_scores(S, a, ql, foff, sw, hh, w);
                unsigned selw = 0u, cndw = 0u;
#pragma unroll
                for (int sub = 0; sub < 2; ++sub)
#pragma unroll
                    for (int i = 0; i < 16; ++i) { const float f = __builtin_fmaf(S[sub][i], inv_w, off); selw = selw * 2u + (f >= bhi ? 1u : 0u); cndw = cndw * 2u + (f >= blo ? 1u : 0u); }
                selw = (selw >> 16) | (selw << 16); cndw = (cndw >> 16) | (cndw << 16);
                mrow[(size_t)c * 16384 + (r * 2 + hh)] = selw;
                unsigned rem = cndw & ~selw;
                if (__any(rem != 0u)) {
#pragma unroll
                    for (int sub = 0; sub < 2; ++sub) {
                        LDS_WAIT();
#pragma unroll
                        for (int i = 0; i < 16; ++i) scr[i * 64 + lane] = S[sub][i];
                        LDS_WAIT();
                        unsigned bits = (rem >> (16 * sub)) & 0xFFFFu;
                        while (bits) { const int bp = 31 - __clz((int)bits), i = 15 - bp; bits &= ~(1u << bp);
                            const float val = scr[i * 64 + lane]; const unsigned key = (unsigned)(64 * c + 32 * sub + crow(i, hh));
                            const unsigned pos = __hip_atomic_fetch_add(CNT + r, 1u, __ATOMIC_RELAXED, __HIP_MEMORY_SCOPE_WORKGROUP);
                            if (pos < (unsigned)IDX_CAP) { cand[(r * IDX_CAP + pos) * 2] = __float_as_uint(val); cand[(r * IDX_CAP + pos) * 2 + 1] = key; } }
                    }
                }
            }
            VM_WAIT(); __syncthreads();
#pragma unroll 1
            for (int k = 0; k < 4; ++k) { const int q = 4 * wave + k; const unsigned cc = CNT[q]; const int need = INFO[q * 4 + 1];
                if (cc > (unsigned)IDX_CAP) { if (lane == 0) INFO[q * 4 + 2] = 1; continue; }
                if (INFO[q * 4 + 2]) continue;
                for (unsigned i = lane; i < cc; i += 64) { const float si = __uint_as_float(cand[(q * IDX_CAP + i) * 2]); const unsigned ki = cand[(q * IDX_CAP + i) * 2 + 1]; int rank = 0;
                    for (unsigned jx = 0; jx < cc; ++jx) { const float sj = __uint_as_float(cand[(q * IDX_CAP + jx) * 2]); const unsigned kj = cand[(q * IDX_CAP + jx) * 2 + 1]; rank += (sj > si || (sj == si && kj < ki)) ? 1 : 0; }
                    if (rank < need) { const unsigned c = ki >> 6, sub = (ki >> 5) & 1u, row = ki & 31u, hk = (row >> 2) & 1u, rr = (row & 3u) + 4u * (row >> 3);
                        __hip_atomic_fetch_or(mrow + (size_t)c * 16384 + (q * 2 + hk), 1u << (16u * sub + 15u - rr), __ATOMIC_RELAXED, __HIP_MEMORY_SCOPE_AGENT); } }
            }
            __syncthreads();
#pragma unroll 1
            for (int q = 0; q < 32; ++q) {
                if (!INFO[q * 4 + 2]) continue;
                LAS float* s_score = (LAS float*)(L + SL_SCORE); LAS unsigned* s_hist = (LAS unsigned*)(L + SL_HIST); LAS unsigned* s_ctl = (LAS unsigned*)(L + SL_CTL);
                __syncthreads();
                for (int s = tid; s < N; s += NTHR) {
                    const h16* kr = KI + (size_t)(b * SEQ + s) * 64; float kv[64];
#pragma unroll
                    for (int i = 0; i < 8; ++i) { const h16x8 t8 = *(const h16x8*)(kr + 8 * i);
#pragma unroll
                        for (int e = 0; e < 8; ++e) kv[8 * i + e] = (float)t8[e]; }
                    float sc = 0.f;
#pragma unroll 1
                    for (int h = 0; h < 9; ++h) { float d = 0.f;
#pragma unroll
                        for (int c8 = 0; c8 < 8; ++c8) { const h16x8 qv = *(const LAS h16x8*)(L + IL_QL + h * 4096 + q * 128 + ((c8 ^ (q & 7)) << 4));
#pragma unroll
                            for (int e = 0; e < 8; ++e) d += (float)qv[e] * kv[8 * c8 + e]; }
                        sc += (h == 8) ? d : fabsf(d) * WL[q * 8 + h]; }
                    s_score[s] = sc;
                }
                __syncthreads();
                unsigned prefix = 0u, msk = 0u, remaining = TOPK, n_eq = 0u;
                for (int pass = 0; pass < 4; ++pass) {
                    const int shift = 24 - 8 * pass;
                    if (tid < 256) s_hist[tid] = 0u;
                    __syncthreads();
                    for (int s = tid; s < N; s += NTHR) { const unsigned key = ord_key(s_score[s]); if ((key & msk) == prefix) __hip_atomic_fetch_add(s_hist + ((key >> shift) & 255u), 1u, __ATOMIC_RELAXED, __HIP_MEMORY_SCOPE_WORKGROUP); }
                    __syncthreads();
                    if (wave == 0) {
                        const unsigned h0 = s_hist[4 * lane], h1 = s_hist[4 * lane + 1], h2 = s_hist[4 * lane + 2], h3 = s_hist[4 * lane + 3];
                        unsigned v = h0 + h1 + h2 + h3;
#pragma unroll
                        for (int o = 1; o < 64; o <<= 1) { const unsigned tv = __shfl_down(v, o); if (lane + o < 64) v += tv; }
                        unsigned above = __shfl_down(v, 1); if (lane == 63) above = 0u;
                        if (v >= remaining && above < remaining) {
                            unsigned cum = above; int dsel; unsigned rem; unsigned hv;
                            if (cum + h3 >= remaining) { dsel = 3; rem = remaining - cum; hv = h3; }
                            else { cum += h3; if (cum + h2 >= remaining) { dsel = 2; rem = remaining - cum; hv = h2; }
                            else { cum += h2; if (cum + h1 >= remaining) { dsel = 1; rem = remaining - cum; hv = h1; }
                            else { cum += h1; dsel = 0; rem = remaining - cum; hv = h0; } } }
                            s_ctl[0] = (unsigned)(4 * lane + dsel); s_ctl[1] = rem; s_ctl[4] = hv; }
                    }
                    __syncthreads();
                    prefix |= s_ctl[0] << shift; msk |= 255u << shift; remaining = s_ctl[1]; n_eq = s_ctl[4];
                    __syncthreads();
                }
                const unsigned tu = (prefix & 0x80000000u) ? (prefix ^ 0x80000000u) : ~prefix; const float thr = __uint_as_float(tu);
                unsigned idx_cut = 0xFFFFFFFFu;
                if (n_eq > remaining) {
                    if (tid == 0) { unsigned cnt = 0, cut = 0; for (int s = 0; s < N; ++s) if (s_score[s] == thr) { ++cnt; if (cnt == remaining) { cut = (unsigned)s; break; } } s_ctl[3] = cut; }
                    __syncthreads();
                    idx_cut = s_ctl[3];
                }
                for (int i = tid; i < NC * 2; i += NTHR) { const int c = i >> 1, hk = i & 1; unsigned word = 0u;
#pragma unroll
                    for (int sub = 0; sub < 2; ++sub)
#pragma unroll
                        for (int rr = 0; rr < 16; ++rr) { const int key = 64 * c + 32 * sub + crow(rr, hk); const float sc = s_score[key];
                            if (sc > thr || (sc == thr && (unsigned)key <= idx_cut)) word |= 1u << (16 * sub + 15 - rr); }
                    mrow[(size_t)c * 16384 + (q * 2 + hk)] = word; }
                __syncthreads();
            }
#undef IDX_LOADA
        }
    }
}

namespace at {
typedef short s16x4 __attribute__((ext_vector_type(4)));
constexpr int NSLOT = 3, SLOTB = 8192;
constexpr int LDS_K = 0, LDS_V = NSLOT * SLOTB, LDS_WS = 2 * NSLOT * SLOTB, LDS_TB = LDS_WS + 8 * 256, LDS_OST = 53248, LDS_BYTES = LDS_OST + 8 * 4096;
constexpr float LOG2E = 1.4426950408889634f;
__device__ __forceinline__ void glds16(const void* gsrc, unsigned lds_dst) { unsigned keep;
    asm volatile("s_mov_b32 %0, m0\n\ts_mov_b32 m0, %2\n\ts_nop 0\n\tglobal_load_lds_dwordx4 %1, off\n\ts_mov_b32 m0, %0" : "=&s"(keep) : "v"(gsrc), "s"(lds_dst) : "memory"); }
#define AT_WAIT_BAR(N) asm volatile("s_waitcnt vmcnt(" #N ") lgkmcnt(0)\n\ts_barrier" ::: "memory")
__device__ __forceinline__ h16x8 vtr8(const LAS unsigned char* p0, const LAS unsigned char* p1) {
    const s16x4 lo = __builtin_amdgcn_ds_read_tr16_b64_v4i16((LAS s16x4*)p0), hi = __builtin_amdgcn_ds_read_tr16_b64_v4i16((LAS s16x4*)p1);
    typedef short s16x8 __attribute__((ext_vector_type(8)));
    const s16x8 v = {lo[0], lo[1], lo[2], lo[3], hi[0], hi[1], hi[2], hi[3]}; return __builtin_bit_cast(h16x8, v); }
__device__ __forceinline__ h16x8 pack8(const f32x16& p, int b) {
    v4u w; w.x = cvt_pk_h16(p[b], p[b + 1]); w.y = cvt_pk_h16(p[b + 2], p[b + 3]); w.z = cvt_pk_h16(p[b + 4], p[b + 5]); w.w = cvt_pk_h16(p[b + 6], p[b + 7]); return __builtin_bit_cast(h16x8, w); }

__device__ __forceinline__ void attn_unit(int b, int h, int qb, const h16* Q, const h16* K, const h16* V, const unsigned* MASK, const float* relb, h16* O, LAS unsigned char* shm) {
    const int tid = threadIdx.x, lane = tid & 63, r32 = lane & 31, hi = lane >> 5; const int wid = __builtin_amdgcn_readfirstlane(tid >> 6);
    const long rowbase = (long)b * SEQ; const int q0 = qb * 256, qw = q0 + wid * 32, cq = qw >> 6, NT = 4 * qb + 4;
    const h16* Qw = Q + (rowbase + qw) * 512 + h * 64;
    const h16* Kh = K + rowbase * 512 + h * 64; const h16* Vh = V + rowbase * 512 + h * 64;
    const unsigned lds0 = (unsigned)(uintptr_t)shm;
    LAS float* wsf = (LAS float*)(shm + LDS_WS) + wid * 64;
    LAS float* Tb = (LAS float*)(shm + LDS_TB);
    const h16* ksrc = Kh + (long)lane * 512 + wid * 8;
    const h16* vsrc = Vh + (long)(16 * (wid & 3) + (lane >> 2)) * 512 + (wid >> 2) * 32 + (lane & 3) * 8;
    const unsigned kdst = lds0 + LDS_K + wid * 1024, vdst = lds0 + LDS_V + wid * 1024;
#define AT_DMA_K(t, slot) glds16(ksrc + (long)(t) * 64 * 512, (unsigned)__builtin_amdgcn_readfirstlane(kdst + (slot)))
#define AT_DMA_V(t, slot) glds16(vsrc + (long)(t) * 64 * 512, (unsigned)__builtin_amdgcn_readfirstlane(vdst + (slot)))
    AT_DMA_K(0, 0); AT_DMA_V(0, 0); AT_DMA_K(1, SLOTB); AT_DMA_V(1, SLOTB);
    if (tid < 255) Tb[tid] = relb[t5_bucket(tid - 191) * 8 + h] * LOG2E;
    const float b15l = relb[15 * 8 + h] * LOG2E;
    h16x8 qr[4];
#pragma unroll
    for (int d0 = 0; d0 < 4; ++d0) qr[d0] = *(const h16x8*)(Qw + (long)r32 * 512 + d0 * 16 + hi * 8);
    const unsigned* mk = MASK + ((size_t)(b * 128) * 8192 + (qw + r32)) * 2 + hi;
    const LAS unsigned char* kp0 = shm + LDS_K + hi * 1024 + r32 * 16;
    const LAS unsigned char* vp0 = shm + LDS_V + ((lane >> 4) & 1) * 32 + (lane & 3) * 8 + (4 * hi + ((lane & 15) >> 2)) * 64;
    f32x16 o[2]; o[0] = f32x16{}; o[1] = f32x16{};
    float m = -1e30f, l = 0.f;
    int slot = 0, slot2 = 2 * SLOTB;
#pragma unroll 1
    for (int t = 0; t < NT; ++t) {
        if (t + 1 < NT) { AT_WAIT_BAR(2); } else { AT_WAIT_BAR(0); }
        if (t + 2 < NT) { AT_DMA_K(t + 2, slot2); AT_DMA_V(t + 2, slot2); }
        if (t <= cq) {
            const unsigned mw = mk[(size_t)t * 16384];
            const bool nearb = (t >= cq - 2);
            const float c0 = nearb ? 0.f : b15l;
            f32x16 p0, p1;
#pragma unroll
            for (int r = 0; r < 16; ++r) { p0[r] = c0; p1[r] = c0; }
            const LAS unsigned char* kb = kp0 + slot;
#pragma unroll
            for (int d0 = 0; d0 < 4; ++d0) { const h16x8 k0 = *(const LAS h16x8*)(kb + d0 * 2048), k1 = *(const LAS h16x8*)(kb + d0 * 2048 + 512);
                p0 = __builtin_amdgcn_mfma_f32_32x32x16_f16(k0, qr[d0], p0, 0, 0, 0); p1 = __builtin_amdgcn_mfma_f32_32x32x16_f16(k1, qr[d0], p1, 0, 0, 0); }
            if (nearb) { const int ib = 64 * t - (qw + r32) + 191 + 4 * hi;
#pragma unroll
                for (int r = 0; r < 16; ++r) { const int kk = (r & 3) + 8 * (r >> 2); p0[r] += Tb[ib + kk]; p1[r] += Tb[ib + 32 + kk]; } }
#pragma unroll
            for (int r = 0; r < 16; ++r) { p0[r] = ((mw >> (15 - r)) & 1u) ? p0[r] : -INFINITY; p1[r] = ((mw >> (31 - r)) & 1u) ? p1[r] : -INFINITY; }
            float mx = fmaxf(p0[0], p1[0]);
#pragma unroll
            for (int r = 1; r < 16; ++r) mx = fmaxf(mx, fmaxf(p0[r], p1[r]));
            { auto rr = __builtin_amdgcn_permlane32_swap(__float_as_uint(mx), __float_as_uint(mx), false, false); mx = fmaxf(__uint_as_float(rr[0]), __uint_as_float(rr[1])); }
            const float mn = fmaxf(m, mx), alpha = __builtin_amdgcn_exp2f(m - mn); m = mn;
            float ps = 0.f;
#pragma unroll
            for (int r = 0; r < 16; ++r) { p0[r] = __builtin_amdgcn_exp2f(p0[r] - mn); p1[r] = __builtin_amdgcn_exp2f(p1[r] - mn); ps += p0[r] + p1[r]; }
            l = l * alpha + ps;
            if (!__all(alpha == 1.0f)) {
                if (hi == 0) wsf[r32] = alpha;
                LDS_WAIT();
#pragma unroll
                for (int r = 0; r < 16; ++r) { const float f = wsf[crow(r, hi)]; o[0][r] *= f; o[1][r] *= f; }
            }
            const h16x8 pa0 = pack8(p0, 0), pa1 = pack8(p0, 8), pa2 = pack8(p1, 0), pa3 = pack8(p1, 8);
            const LAS unsigned char* vb = vp0 + slot;
#pragma unroll
            for (int d0 = 0; d0 < 2; ++d0) {
                const h16x8 v0 = vtr8(vb + d0 * 4096, vb + d0 * 4096 + 512), v1 = vtr8(vb + d0 * 4096 + 1024, vb + d0 * 4096 + 1024 + 512);
                const h16x8 v2 = vtr8(vb + d0 * 4096 + 2048, vb + d0 * 4096 + 2048 + 512), v3 = vtr8(vb + d0 * 4096 + 3072, vb + d0 * 4096 + 3072 + 512);
                o[d0] = __builtin_amdgcn_mfma_f32_32x32x16_f16(pa0, v0, o[d0], 0, 0, 0); o[d0] = __builtin_amdgcn_mfma_f32_32x32x16_f16(pa1, v1, o[d0], 0, 0, 0);
                o[d0] = __builtin_amdgcn_mfma_f32_32x32x16_f16(pa2, v2, o[d0], 0, 0, 0); o[d0] = __builtin_amdgcn_mfma_f32_32x32x16_f16(pa3, v3, o[d0], 0, 0, 0); }
        }
        slot2 = slot; slot = (slot == (NSLOT - 1) * SLOTB) ? 0 : slot + SLOTB;
    }
    { auto rr = __builtin_amdgcn_permlane32_swap(__float_as_uint(l), __float_as_uint(l), false, false); l = __uint_as_float(rr[0]) + __uint_as_float(rr[1]); }
    if (hi == 0) wsf[32 + r32] = l;
    LDS_WAIT();
    h16* Ow = O + (rowbase + qw) * 512 + h * 64;
    { LAS h16* stg = (LAS h16*)(shm + LDS_OST) + wid * 2048;
#pragma unroll
      for (int r = 0; r < 16; ++r) { const int orow = crow(r, hi); const float rl = 1.0f / wsf[32 + orow];
#pragma unroll
          for (int d0 = 0; d0 < 2; ++d0) stg[orow * 64 + d0 * 32 + r32] = (h16)(o[d0][r] * rl); }
      LDS_WAIT();
#pragma unroll
      for (int i = 0; i < 4; ++i) { const int row = i * 8 + (lane >> 3), ch = lane & 7; const v4u v = *(const LAS v4u*)(stg + row * 64 + ch * 8); *(GAS v4u*)(Ow + (long)row * 512 + ch * 8) = v; } }
    asm volatile("s_waitcnt lgkmcnt(0)\n\ts_barrier" ::: "memory");
#undef AT_DMA_K
#undef AT_DMA_V
}
__device__ __forceinline__ void attn_phase(Frame& F, const Args& A) {
    unsigned char* ws = A.ws;
    for (int v = F.vcu; v < 256; v += F.G) {
        const int bh = v >> 4, s = v & 15;
#pragma unroll 1
        for (int i = 0; i < 2; ++i) attn_unit(bh >> 3, bh & 7, i ? 31 - s : s, (const h16*)(ws + WS_Q), (const h16*)(ws + WS_K), (const h16*)(ws + WS_V), (const unsigned*)(ws + WS_MASK), A.in[12], (h16*)(ws + WS_O), F.lds + RING_OFF);
    }
}
#undef AT_WAIT_BAR
}

__device__ __forceinline__ void attn_norm_phase(Frame& F, const Args& A) {
    unsigned char* ws = A.ws; const h16* O = (const h16*)(ws + WS_O); h16* MERGED = (h16*)(ws + WS_MERGED);
    const f32x4 g0 = *(const f32x4*)(A.in[20] + 8 * F.lane), g1 = *(const f32x4*)(A.in[20] + 8 * F.lane + 4);
    const int gw = F.vcu * NWAVES + F.wave, NGW = F.G * NWAVES;
    for (int row = gw; row < M; row += NGW) {
        const h16x8 v = *(const h16x8*)(O + (size_t)row * 512 + 8 * F.lane); float f[8]; float s = 0.f;
#pragma unroll
        for (int e = 0; e < 8; ++e) { f[e] = (float)v[e]; s += f[e] * f[e]; }
        const float rstd = 1.0f / sqrtf(wave_sum(s) * (1.0f / DATT) + EPS);
        v4u o; o.x = cvt_pk_h16(f[0] * rstd * g0.x, f[1] * rstd * g0.y); o.y = cvt_pk_h16(f[2] * rstd * g0.z, f[3] * rstd * g0.w);
        o.z = cvt_pk_h16(f[4] * rstd * g1.x, f[5] * rstd * g1.y); o.w = cvt_pk_h16(f[6] * rstd * g1.z, f[7] * rstd * g1.w);
        *(GAS v4u*)(MERGED + (size_t)row * 1024 + 8 * F.lane) = o;
    }
}

__global__ void __launch_bounds__(NTHR, 2) fwd_kernel(Args args) {
    extern __shared__ __attribute__((aligned(16))) unsigned char lds[];
    Frame F;
    F.lds = (LAS unsigned char*)lds;
    F.MISC = (volatile LAS unsigned*)(F.lds + MISC_OFF);
    F.tid = threadIdx.x; F.lane = F.tid & 63; F.wave = __builtin_amdgcn_readfirstlane(F.tid >> 6);
    F.G = gridDim.x; { const int bx = blockIdx.x; F.vcu = (F.G % 8 == 0) ? (bx % 8) * (F.G / 8) + bx / 8 : bx; }
    unsigned char* ws = args.ws;
    F.ctl = (gu32*)(ws + WS_CTL);
    for (int u = F.tid; u < (LDS_BYTES - LDSCTL_OFF) / 4; u += NTHR) ((LAS unsigned*)(F.lds + LDSCTL_OFF))[u] = 0u;
    __syncthreads();
    XcdBarrier bar; bar.bar = (unsigned*)(F.ctl + CW_BAR); bar.x = 0; bar.st = nullptr;
    if (N_LAUNCHES == 1) bar = xcd_barrier_post((unsigned*)(F.ctl + CW_BAR), F.MISC + 8);
    const int lo = args.ph_lo, hi = args.ph_hi;
#define IN(k) (lo <= (k) && (k) < hi)
#define SEAM(k) do { if (IN(k) && IN((k) + 1)) xcd_barrier(bar); } while (0)
    const float* mod = (const float*)(ws + WS_MOD);
    h16* H = (h16*)(ws + WS_H); h16* ACT = (h16*)(ws + WS_ACT); float* Y = (float*)(ws + WS_Y);
    const int bx = (int)blockIdx.x;

    if (IN(0)) { p0_prologue(F, args); } SEAM(0);
    if (IN(1)) { thin_phase<false, true>(F, mod, nullptr, nullptr, 0.f, 0, args.in[0], nullptr, args.in[4], 0, 1, H); } SEAM(1);
    if (IN(2)) { pg8::Gemm g{H, (const h16*)(ws + WS_W1GU), M, NGU, D}; pg8::StaticOrder S; S.init(M, NGU, F.G, bx);
        pg8::EpiSwiGLU E{ACT, FF}; pg8::gemm_phase<pg8::EpiSwiGLU, pg8::StaticOrder, true>(F.lds + RING_OFF, g, S, E); } SEAM(2);
    if (IN(3)) { pg8::Gemm g{ACT, (const h16*)(ws + WS_W1D), M, D, FF}; pg8::StaticOrder S; S.init(M, D, F.G, bx);
        pg8::EpiF32 E{Y, D}; pg8::gemm_phase<pg8::EpiF32, pg8::StaticOrder, false>(F.lds + RING_OFF, g, S, E); } SEAM(3);
    if (IN(4)) { thin_phase<true, true>(F, mod, Y, args.in[5], 0.5f, 2, args.in[0], args.out, args.in[9], 3, 4, H); } SEAM(4);
    if (IN(5)) { pg8::Gemm g{H, (const h16*)(ws + WS_WIN), M, NPROJ, D}; pg8::StaticOrder S; S.init(M, NPROJ, F.G, bx);
        pg8::EpiProj E{ws + WS_Q, (size_t)(WS_K - WS_Q), (h16*)(ws + WS_QS), (h16*)(ws + WS_KI), (float*)(ws + WS_WI), (h16*)(ws + WS_LRU)};
        pg8::gemm_phase<pg8::EpiProj, pg8::StaticOrder, true>(F.lds + RING_OFF, g, S, E); } SEAM(5);
    if (IN(6)) { lru_phase<false>(F, args); } if (IN(6) && IN(7)) __syncthreads();
    if (IN(7)) { idx_phase(F, args); } SEAM(7);
    if (IN(8)) { lru_phase<true>(F, args); } if (IN(8) && IN(9)) __syncthreads();
    if (IN(9)) { at::attn_phase(F, args); } SEAM(9);
    if (IN(10)) { attn_norm_phase(F, args); } SEAM(10);
    if (IN(11)) { pg8::Gemm g{(const h16*)(ws + WS_MERGED), (const h16*)(ws + WS_WOUT), M, D, D}; pg8::StaticOrder S; S.init(M, D, F.G, bx);
        pg8::EpiF32 E{Y, D}; pg8::gemm_phase<pg8::EpiF32, pg8::StaticOrder, false>(F.lds + RING_OFF, g, S, E); } SEAM(11);
    if (IN(12)) { thin_phase<true, true>(F, mod, Y, args.in[10], 1.0f, 5, args.out, args.out, args.in[23], 6, 7, H); } SEAM(12);
    if (IN(13)) { pg8::Gemm g{H, (const h16*)(ws + WS_W2GU), M, NGU, D}; pg8::StaticOrder S; S.init(M, NGU, F.G, bx);
        pg8::EpiSwiGLU E{ACT, FF}; pg8::gemm_phase<pg8::EpiSwiGLU, pg8::StaticOrder, true>(F.lds + RING_OFF, g, S, E); } SEAM(13);
    if (IN(14)) { pg8::Gemm g{ACT, (const h16*)(ws + WS_W2D), M, D, FF}; pg8::StaticOrder S; S.init(M, D, F.G, bx);
        pg8::EpiF32 E{Y, D}; pg8::gemm_phase<pg8::EpiF32, pg8::StaticOrder, false>(F.lds + RING_OFF, g, S, E); } SEAM(14);
    if (IN(15)) { thin_phase<true, false>(F, mod, Y, args.in[24], 0.5f, 8, args.out, args.out, nullptr, 0, 0, nullptr); }
#undef IN
#undef SEAM
}

extern "C" void kernel_launch(void* const* d_in, const int* in_sizes, int n_in, void* d_out, int out_size, void* d_ws, size_t ws_size, hipStream_t stream) {
    static int grid = 0;
    if (grid == 0) {
        if (n_in != 28 || in_sizes[0] != M * D || out_size != M * D || ws_size < WS_END) { fprintf(stderr, "kernel_launch: unexpected shapes (n_in %d, in0 %d, out %d, ws %zu); nothing launched\n", n_in, n_in > 0 ? in_sizes[0] : -1, out_size, ws_size); grid = -1; return; }
        int dev = 0, cus = 0, per_cu = 0;
        if (hipGetDevice(&dev) != hipSuccess || hipDeviceGetAttribute(&cus, hipDeviceAttributeMultiprocessorCount, dev) != hipSuccess) { grid = -1; return; }
        if (hipFuncSetAttribute((const void*)fwd_kernel, hipFuncAttributeMaxDynamicSharedMemorySize, LDS_BYTES) != hipSuccess) { fprintf(stderr, "kernel_launch: hipFuncSetAttribute failed\n"); grid = -1; return; }
        if (hipOccupancyMaxActiveBlocksPerMultiprocessor(&per_cu, (const void*)fwd_kernel, NTHR, LDS_BYTES) != hipSuccess || per_cu < 1) { fprintf(stderr, "kernel_launch: occupancy query reports %d\n", per_cu); }
        (void)hipGetLastError();
        grid = cus;
    }
    if (grid < 0) return;
    if (hipMemsetAsync((char*)d_ws + WS_CTL, 0, CTL_ZERO_BYTES, stream) != hipSuccess) return;
    Args a{};
    for (int i = 0; i < 28; ++i) a.in[i] = (const float*)d_in[i];
    a.out = (float*)d_out; a.ws = (unsigned char*)d_ws;
    if (N_LAUNCHES == 1) { a.ph_lo = 0; a.ph_hi = N_PHASES; a.li = 0; hipLaunchKernelGGL(fwd_kernel, dim3(grid), dim3(NTHR), LDS_BYTES, stream, a); }
    else { for (int p = 0; p < N_PHASES; ++p) { a.ph_lo = p; a.ph_hi = p + 1; a.li = p; const int reps = (p == PROBE_PHASE) ? 2 : 1;
        for (int rr = 0; rr < reps; ++rr) hipLaunchKernelGGL(fwd_kernel, dim3(grid), dim3(NTHR), LDS_BYTES, stream, a); } }
}
```

```cpp
#include <hip/hip_runtime.h>
#include <cstdio>
#include <cstdint>

#ifndef PROBE_PHASE
#define PROBE_PHASE -1
#endif
#ifndef MK_N_LAUNCHES
#define MK_N_LAUNCHES 1
#endif

namespace pg8 {
#define PG8_LAS __attribute__((address_space(3)))
typedef _Float16 h16;
typedef _Float16 h16x8 __attribute__((ext_vector_type(8)));
typedef _Float16 h16x2 __attribute__((ext_vector_type(2)));
typedef float f32x4 __attribute__((ext_vector_type(4)));
typedef float f32x2 __attribute__((ext_vector_type(2)));
typedef unsigned u32x4 __attribute__((ext_vector_type(4)));
constexpr int BM = 256, BK = 64, HALF = 128, HTB = HALF * BK * 2, STAGE_BYTES = 8 * HTB, NXCD = 8, WGM = 8;

__host__ __device__ __forceinline__ int lds_byte(int r, int c) { const int st = (r >> 4) * 2 + (c >> 5), rr = r & 15, cc = c & 31, ob = rr * 64 + cc * 2; return st * 1024 + (ob ^ (((ob >> 9) & 1) << 5)); }
__host__ __device__ __forceinline__ void stage_rc(int b, int& R, int& C) { const int st = b / 1024, sb = b % 1024, swz = sb ^ (((sb >> 9) & 1) << 5); R = (st >> 1) * 16 + swz / 64; C = (st & 1) * 32 + (swz % 64) / 2; }
__host__ __device__ __forceinline__ int perm32(int rho) { const int n = rho >> 4, i = rho & 15; return 8 * (i >> 2) + 4 * n + (i & 3); }

struct Unit { int pm, pn; };
struct Gemm { const h16* A; const h16* Bt; int M, N, K; };

struct StaticOrder {
    int nM, nN, nwg, G, c;
    __host__ __device__ void init(int M, int N, int G_, int c_) { nM = M / BM; nN = N / BM; nwg = nM * nN; G = G_; c = c_; }
    __host__ __device__ bool next(int i, Unit& u) const {
        const long L = (long)i * G + c; if (L >= nwg) return false;
        int wgid = (int)L; { const int q = nwg / NXCD, r = nwg % NXCD, xcd = wgid % NXCD, off = wgid / NXCD; wgid = (xcd < r ? xcd * (q + 1) : r * (q + 1) + (xcd - r) * q) + off; }
        const int nig = WGM * nN, gid = wgid / nig, fm = gid * WGM, gsz = (nM - fm) < WGM ? (nM - fm) : WGM;
        u.pm = fm + ((wgid % nig) % gsz); u.pn = (wgid % nig) / gsz; return true;
    }
    __device__ __forceinline__ void a_ready(const Unit&) const {}
    __device__ __forceinline__ void done(const Unit&) const {}
};

__device__ __forceinline__ unsigned cvt_pk_h16(float lo, float hi) { f32x2 v = {lo, hi}; h16x2 h = __builtin_convertvector(v, h16x2); return __builtin_bit_cast(unsigned, h); }

struct EpiF32 {
    static constexpr bool PERM = false, AFTER_DRAIN = false;
    float* C; int ldc;
    __device__ __forceinline__ void operator()(const f32x4 (&acc)[2][2][4][2], const Unit& u, int wr, int wc, int fr, int fq) const {
        const int row0 = u.pm * BM + wr * 64 + fr, col0 = u.pn * BM + wc * 32 + 4 * fq;
#pragma unroll
        for (int ai = 0; ai < 2; ++ai)
#pragma unroll
            for (int m = 0; m < 4; ++m) { float* rowp = C + (size_t)(row0 + ai * HALF + m * 16) * ldc + col0;
#pragma unroll
                for (int bj = 0; bj < 2; ++bj)
#pragma unroll
                    for (int n = 0; n < 2; ++n) *(f32x4*)(rowp + bj * HALF + n * 16) = acc[ai][bj][m][n]; }
    }
};
struct EpiSwiGLU {
    static constexpr bool PERM = true, AFTER_DRAIN = false;
    h16* O; int ldc;
    __device__ __forceinline__ void operator()(const f32x4 (&acc)[2][2][4][2], const Unit& u, int wr, int wc, int fr, int fq) const {
        const int row0 = u.pm * BM + wr * 64 + fr, col0 = u.pn * HALF + wc * 32 + 8 * fq;
#pragma unroll
        for (int ai = 0; ai < 2; ++ai)
#pragma unroll
            for (int m = 0; m < 4; ++m) { h16* rowp = O + (size_t)(row0 + ai * HALF + m * 16) * ldc + col0;
                float v[8];
#pragma unroll
                for (int n = 0; n < 2; ++n)
#pragma unroll
                    for (int i = 0; i < 4; ++i) { const float g = acc[ai][0][m][n][i], up = acc[ai][1][m][n][i];
                        const float e = __builtin_amdgcn_exp2f(-1.4426950408889634f * g); v[4 * n + i] = g * __builtin_amdgcn_rcpf(1.0f + e) * up; }
                u32x4 w; w.x = cvt_pk_h16(v[0], v[1]); w.y = cvt_pk_h16(v[2], v[3]); w.z = cvt_pk_h16(v[4], v[5]); w.w = cvt_pk_h16(v[6], v[7]);
                *(u32x4*)rowp = w; }
    }
};
struct EpiProj {
    static constexpr bool PERM = true, AFTER_DRAIN = false;
    unsigned char* qkv; size_t qkv_stride; h16* QS; h16* KI; float* WI; h16* LRU;
    __device__ __forceinline__ void store_h16(const f32x4 (&acc)[2][2][4][2], h16* base, int ld, int row0, int c0, float sc) const {
#pragma unroll
        for (int ai = 0; ai < 2; ++ai)
#pragma unroll
            for (int m = 0; m < 4; ++m) { h16* rowp = base + (size_t)(row0 + ai * HALF + m * 16) * ld + c0;
#pragma unroll
                for (int bj = 0; bj < 2; ++bj) { const f32x4 v0 = acc[ai][bj][m][0] * sc, v1 = acc[ai][bj][m][1] * sc;
                    u32x4 w; w.x = cvt_pk_h16(v0[0], v0[1]); w.y = cvt_pk_h16(v0[2], v0[3]); w.z = cvt_pk_h16(v1[0], v1[1]); w.w = cvt_pk_h16(v1[2], v1[3]);
                    *(u32x4*)(rowp + bj * HALF) = w; } }
    }
    __device__ __forceinline__ void operator()(const f32x4 (&acc)[2][2][4][2], const Unit& u, int wr, int wc, int fr, int fq) const {
        const int row0 = u.pm * BM + wr * 64 + fr, cw = wc * 32 + 8 * fq; const int pn = u.pn;
        if (pn < 6) { store_h16(acc, (h16*)(qkv + (size_t)(pn >> 1) * qkv_stride), 512, row0, (pn & 1) * 256 + cw, pn < 2 ? 0.125f * 1.4426950408889634f : 1.0f); }
        else if (pn >= 9) { store_h16(acc, LRU, 1024, row0, (pn - 9) * 256 + cw, 1.0f); }
        else if (pn < 8) { store_h16(acc, QS, 512, row0, (pn - 6) * 256 + cw, 0.125f); }
        else {
#pragma unroll
            for (int ai = 0; ai < 2; ++ai)
#pragma unroll
                for (int m = 0; m < 4; ++m) { const size_t row = (size_t)(row0 + ai * HALF + m * 16); const f32x4 v0 = acc[ai][0][m][0], v1 = acc[ai][0][m][1];
                    if (cw < 64) { u32x4 w; w.x = cvt_pk_h16(v0[0], v0[1]); w.y = cvt_pk_h16(v0[2], v0[3]); w.z = cvt_pk_h16(v1[0], v1[1]); w.w = cvt_pk_h16(v1[2], v1[3]); *(u32x4*)(KI + row * 64 + cw) = w; }
                    else if (cw == 64) { const float sc = 0.5f * 0.35355339059327373f; *(f32x4*)(WI + row * 8) = v0 * sc; *(f32x4*)(WI + row * 8 + 4) = v1 * sc; } }
        }
    }
};

template <class Epi, class Sched, bool ALIGN_EPI = false>
__device__ __forceinline__ void gemm_phase(PG8_LAS unsigned char* lds, const Gemm g, const Sched& S, const Epi& E) {
    const int tid = threadIdx.x, wid = __builtin_amdgcn_readfirstlane(tid >> 6), lane = tid & 63, wr = wid >> 2, wc = wid & 3, fr = lane & 15, fq = lane >> 4;
    const int K = g.K, nt = K / BK;
    unsigned voffA[2], voffB[2];
#pragma unroll
    for (int i = 0; i < 2; ++i) { int R, C; stage_rc(tid * 16 + i * 8192, R, C); const int Rb = Epi::PERM ? ((R & ~31) + perm32(R & 31)) : R;
        voffA[i] = (unsigned)(R * K + C) * 2u; voffB[i] = (unsigned)(Rb * K + C) * 2u; }
    const size_t kstep = (size_t)(BK * 2);
    const size_t hstep = (size_t)HALF * K * 2;
    const size_t tstep = 2 * hstep;
    const unsigned ldsw = (unsigned)wid * 1024u;
    const int aoff = lds_byte(wr * 64 + fr, fq * 8), boff = lds_byte(wc * 32 + fr, fq * 8);
#define PG8_SA(b, h) (((b) * 2 + (h)) * HTB)
#define PG8_SB(b, h) ((4 + (b) * 2 + (h)) * HTB)
#define PG8_STAGE(bufoff, gbase, voff) do { _Pragma("unroll") for (int _i = 0; _i < 2; ++_i) \
        __builtin_amdgcn_global_load_lds((const unsigned*)((const char*)(gbase) + (voff)[_i]), (PG8_LAS unsigned*)(lds + (bufoff) + ldsw + _i * 8192), 16, 0, 0); } while (0)
#define PG8_LDA(dst, b, h) do { _Pragma("unroll") for (int m = 0; m < 4; ++m) _Pragma("unroll") for (int k = 0; k < 2; ++k) dst[m][k] = *(const PG8_LAS h16x8*)(lds + PG8_SA(b, h) + aoff + m * 2048 + k * 1024); } while (0)
#define PG8_LDB(dst, b, h) do { _Pragma("unroll") for (int n = 0; n < 2; ++n) _Pragma("unroll") for (int k = 0; k < 2; ++k) dst[n][k] = *(const PG8_LAS h16x8*)(lds + PG8_SB(b, h) + boff + n * 2048 + k * 1024); } while (0)
#define PG8_MMA(ai, bj, At, Bt) do { __builtin_amdgcn_s_setprio(1); _Pragma("unroll") for (int m = 0; m < 4; ++m) _Pragma("unroll") for (int n = 0; n < 2; ++n) _Pragma("unroll") for (int k = 0; k < 2; ++k) \
        acc[ai][bj][m][n] = __builtin_amdgcn_mfma_f32_16x16x32_f16(Bt[n][k], At[m][k], acc[ai][bj][m][n], 0, 0, 0); __builtin_amdgcn_s_setprio(0); } while (0)
#define PG8_WAIT_V(n) asm volatile("s_waitcnt vmcnt(" #n ")" ::: "memory")
#define PG8_WAIT_L(n) asm volatile("s_waitcnt lgkmcnt(" #n ")" ::: "memory")
#define PG8_BAR __builtin_amdgcn_s_barrier()
#define PG8_SCHED __builtin_amdgcn_sched_barrier(0)
    Unit cur, nxt; int ui = 0;
    if (!S.next(0, cur)) return;
    f32x4 acc[2][2][4][2];
#pragma unroll
    for (int a = 0; a < 2; ++a)
#pragma unroll
        for (int b = 0; b < 2; ++b)
#pragma unroll
            for (int m = 0; m < 4; ++m)
#pragma unroll
                for (int n = 0; n < 2; ++n) acc[a][b][m][n] = (f32x4){0.f, 0.f, 0.f, 0.f};
    h16x8 At[4][2], B0[2][2], B1[2][2];
    const char* cA = (const char*)g.A + (size_t)cur.pm * tstep; const char* cB = (const char*)g.Bt + (size_t)cur.pn * tstep;
    S.a_ready(cur);
    PG8_STAGE(PG8_SB(0, 0), cB, voffB); PG8_STAGE(PG8_SB(0, 1), cB + hstep, voffB); PG8_STAGE(PG8_SA(0, 0), cA, voffA); PG8_STAGE(PG8_SA(0, 1), cA + hstep, voffA);
    if (wr == 1) PG8_BAR;
    PG8_WAIT_V(2); PG8_BAR;
    PG8_STAGE(PG8_SB(1, 0), cB + kstep, voffB); PG8_STAGE(PG8_SA(1, 0), cA + kstep, voffA); PG8_STAGE(PG8_SB(1, 1), cB + hstep + kstep, voffB);
    PG8_WAIT_V(6); PG8_BAR;
    for (;;) {
        const bool has_next = S.next(ui + 1, nxt);
        const char* nA = has_next ? (const char*)g.A + (size_t)nxt.pm * tstep : cA; const char* nB = has_next ? (const char*)g.Bt + (size_t)nxt.pn * tstep : cB;
        for (int t = 0; t < nt; t += 2) {
            const bool last = (t == nt - 2);
            const char* a1 = cA + (size_t)(t + 1) * kstep;
            const char* a2 = last ? nA : cA + (size_t)(t + 2) * kstep; const char* b2 = last ? nB : cB + (size_t)(t + 2) * kstep;
            const char* a3 = a2 + kstep; const char* b3 = b2 + kstep;
            if (last && has_next) S.a_ready(nxt);
            PG8_LDB(B0, 0, 0); PG8_LDB(B1, 0, 1); PG8_SCHED; PG8_LDA(At, 0, 0); PG8_STAGE(PG8_SA(1, 1), a1 + hstep, voffA);
            PG8_WAIT_V(8); PG8_WAIT_L(0); PG8_BAR; PG8_MMA(0, 0, At, B0); PG8_MMA(0, 1, At, B1); PG8_BAR; PG8_SCHED;
            PG8_LDA(At, 0, 1); PG8_STAGE(PG8_SB(0, 0), b2, voffB); PG8_STAGE(PG8_SB(0, 1), b2 + hstep, voffB); PG8_STAGE(PG8_SA(0, 0), a2, voffA);
            PG8_WAIT_V(8); PG8_WAIT_L(0); PG8_BAR; PG8_MMA(1, 0, At, B0); PG8_MMA(1, 1, At, B1); PG8_BAR; PG8_SCHED;
            PG8_LDB(B0, 1, 0); PG8_LDB(B1, 1, 1); PG8_SCHED; PG8_LDA(At, 1, 0); PG8_STAGE(PG8_SA(0, 1), a2 + hstep, voffA);
            PG8_WAIT_V(8); PG8_WAIT_L(0); PG8_BAR; PG8_MMA(0, 0, At, B0); PG8_MMA(0, 1, At, B1); PG8_BAR; PG8_SCHED;
            PG8_LDA(At, 1, 1); PG8_STAGE(PG8_SB(1, 0), b3, voffB); PG8_STAGE(PG8_SB(1, 1), b3 + hstep, voffB); PG8_STAGE(PG8_SA(1, 0), a3, voffA);
            PG8_WAIT_V(8); PG8_WAIT_L(0); PG8_BAR; PG8_MMA(1, 0, At, B0); PG8_MMA(1, 1, At, B1); PG8_BAR; PG8_SCHED;
        }
        if constexpr (ALIGN_EPI) { if (wr == 0) PG8_BAR; }
        E(acc, cur, wr, wc, fr, fq); S.done(cur);
        if (!has_next) break;
#pragma unroll
        for (int a = 0; a < 2; ++a)
#pragma unroll
            for (int b = 0; b < 2; ++b)
#pragma unroll
                for (int m = 0; m < 4; ++m)
#pragma unroll
                    for (int n = 0; n < 2; ++n) acc[a][b][m][n] = (f32x4){0.f, 0.f, 0.f, 0.f};
        cur = nxt; cA = nA; cB = nB; ++ui;
        if constexpr (ALIGN_EPI) { if (wr == 1) PG8_BAR; }
    }
    PG8_WAIT_V(0);
    if constexpr (!ALIGN_EPI) { if (wr == 0) PG8_BAR; }
    PG8_BAR;
#undef PG8_SA
#undef PG8_SB
#undef PG8_STAGE
#undef PG8_LDA
#undef PG8_LDB
#undef PG8_MMA
#undef PG8_WAIT_V
#undef PG8_WAIT_L
#undef PG8_BAR
#undef PG8_SCHED
}
}

constexpr int NWAVES = 8, NTHR = NWAVES * 64;
constexpr int N_LAUNCHES = MK_N_LAUNCHES;
constexpr int N_PHASES = 16;
constexpr int BATCH = 2, SEQ = 8192, D = 1024, FF = 2816, M = BATCH * SEQ;
constexpr int NGU = 2 * FF;
constexpr int NPROJ = 3328;
constexpr int DIN = 3144;
constexpr int NH = 8, HD = 64, DATT = 512, DLRU = 512, TOPK = 256, CHUNK = 64;
constexpr int LCH = 32, NLCH = SEQ / LCH;
constexpr float EPS = 1e-6f;

constexpr size_t MiB = 1u << 20;
constexpr size_t WS_CTL = 0, CTL_ZERO_BYTES = 1 * MiB;
constexpr size_t WS_MOD = 1 * MiB;
constexpr size_t WS_LRUW = 2 * MiB;
constexpr size_t WS_LRUS = 246 * MiB;
constexpr size_t WS_W1GU = 3 * MiB, WS_W1D = 14 * MiB, WS_WIN = 20 * MiB, WS_WOUT = 27 * MiB, WS_W2GU = 29 * MiB, WS_W2D = 40 * MiB;
constexpr size_t WS_H = 46 * MiB;
constexpr size_t WS_ACT = 78 * MiB;
constexpr size_t WS_Y = 166 * MiB;
constexpr size_t WS_Q = 78 * MiB, WS_K = 94 * MiB, WS_V = 110 * MiB;
constexpr size_t WS_QS = 126 * MiB;
constexpr size_t WS_O = 142 * MiB;
constexpr size_t WS_KI = 158 * MiB;
constexpr size_t WS_WI = 160 * MiB;
constexpr size_t WS_MASK = 230 * MiB;
constexpr size_t WS_LRU = 166 * MiB;
constexpr size_t WS_MERGED = WS_H;
constexpr size_t WS_END = 248 * MiB;
constexpr int CW_BAR = 4096;

constexpr int RING_OFF = 0, RING_BYTES = 131072;
constexpr int LDSCTL_OFF = RING_BYTES, MISC_OFF = LDSCTL_OFF + 320;
constexpr int LDS_BYTES = 147456;

#define GAS __attribute__((address_space(1)))
#define LAS __attribute__((address_space(3)))
typedef _Float16 h16;
typedef unsigned v4u __attribute__((ext_vector_type(4)));
typedef unsigned v2u __attribute__((ext_vector_type(2)));
typedef float f32x4 __attribute__((ext_vector_type(4)));
typedef _Float16 h16x8 __attribute__((ext_vector_type(8)));
typedef _Float16 h16x4 __attribute__((ext_vector_type(4)));
typedef GAS unsigned gu32;
#define RLX_AGENT __ATOMIC_RELAXED, __HIP_MEMORY_SCOPE_AGENT
#define LDS_WAIT() asm volatile("s_waitcnt lgkmcnt(0)" ::: "memory")
#define VM_WAIT() asm volatile("s_waitcnt vmcnt(0)" ::: "memory")
using pg8::cvt_pk_h16;

#define XB_TMO      128
#define XB_XCNT(j)  (256  + 64 * (j))
#define XB_XSUB(j)  (1280 + 64 * (j))
#define XB_XGEN(j)  (2304 + 64 * (j))
#define XB_TOP      3328
#define XB_TOPGEN   3392
#define XCD_BAR_WORDS 3456
#define XB_SPIN_CAP (1u << 18)
__device__ __forceinline__ unsigned xb_ld(unsigned* p)              { return __hip_atomic_load(p, __ATOMIC_RELAXED, __HIP_MEMORY_SCOPE_AGENT); }
__device__ __forceinline__ unsigned xb_add(unsigned* p, unsigned v) { return __hip_atomic_fetch_add(p, v, __ATOMIC_RELAXED, __HIP_MEMORY_SCOPE_AGENT); }
__device__ __forceinline__ unsigned xb_xcc_id() { return (unsigned)__builtin_amdgcn_s_getreg((3 << 11) | 20) & 0xFu; }
#define XB_SPIN(cond, bar) do { unsigned _sp = 0; while (cond) { __builtin_amdgcn_s_sleep(1); \
    if ((++_sp & 255u) == 0u) { if (xb_ld(&(bar)[XB_TMO])) break; if (_sp > XB_SPIN_CAP) { atomicAdd(&(bar)[XB_TMO], 1u); break; } } } } while (0)
struct XcdBarrier { unsigned* bar; unsigned x; volatile LAS unsigned* st; };
__device__ __forceinline__ XcdBarrier xcd_barrier_post(unsigned* bar, volatile LAS unsigned* st) {
    XcdBarrier b; b.bar = bar; b.x = xb_xcc_id(); b.st = st;
    if (threadIdx.x == 0) (void)xb_add(&bar[XB_XCNT(b.x)], 1u);
    return b;
}
__device__ __forceinline__ void xcd_barrier_complete(unsigned* bar, unsigned x, unsigned& nloc, unsigned& nx) {
    const unsigned G = gridDim.x * gridDim.y * gridDim.z;
    unsigned sum, cnt, mine, sp = 0u;
    for (;;) {
        sum = 0u; cnt = 0u; mine = 0u;
#pragma unroll
        for (unsigned j = 0; j < 16; ++j) { const unsigned c = xb_ld(&bar[XB_XCNT(j)]); sum += c; cnt += (c > 0u) ? 1u : 0u; mine = (j == x) ? c : mine; }
        if (sum == G) break;
        __builtin_amdgcn_s_sleep(1);
        if ((++sp & 255u) == 0u) { if (xb_ld(&bar[XB_TMO])) break; if (sp > XB_SPIN_CAP) { atomicAdd(&bar[XB_TMO], 1u); break; } }
    }
    nloc = mine > 0u ? mine : 1u; nx = cnt > 0u ? cnt : 1u;
}
__device__ __forceinline__ void xcd_barrier(const XcdBarrier& b) {
    asm volatile("s_waitcnt vmcnt(0)" ::: "memory");
    __syncthreads();
    if (threadIdx.x == 0) {
        unsigned* bar = b.bar;
        __builtin_amdgcn_s_waitcnt(0);
        unsigned nloc = b.st[0], nx = b.st[1];
        if (nloc == 0u) { xcd_barrier_complete(bar, b.x, nloc, nx); b.st[0] = nloc; b.st[1] = nx; }
        const unsigned old = xb_add(&bar[XB_XSUB(b.x)], 1u);
        const unsigned gen = old / nloc;
        if (old + 1u == (gen + 1u) * nloc) {
            __builtin_amdgcn_fence(__ATOMIC_RELEASE, "agent");
            asm volatile("s_waitcnt vmcnt(0)" ::: "memory");
            const unsigned og = xb_add(&bar[XB_TOP], 1u);
            const unsigned tg = og / nx;
            if (og + 1u == (tg + 1u) * nx) xb_add(&bar[XB_TOPGEN], 1u);
            else XB_SPIN(xb_ld(&bar[XB_TOPGEN]) == tg, bar);
            __builtin_amdgcn_fence(__ATOMIC_ACQUIRE, "agent");
            xb_add(&bar[XB_XGEN(b.x)], 1u);
            asm volatile("s_waitcnt vmcnt(0)" ::: "memory");
        } else {
            XB_SPIN(xb_ld(&bar[XB_XGEN(b.x)]) == gen, bar);
            __builtin_amdgcn_fence(__ATOMIC_ACQUIRE, "agent");
            asm volatile("s_waitcnt vmcnt(0)" ::: "memory");
        }
    }
    __syncthreads();
}

struct Frame {
    LAS unsigned char* lds;
    volatile LAS unsigned* MISC;
    gu32* ctl;
    int tid, lane, wave;
    int vcu, G;
};
struct Args { const float* in[28]; float* out; unsigned char* ws; int ph_lo, ph_hi, li, pad; };

__device__ __forceinline__ float wave_sum(float v) {
#pragma unroll
    for (int o = 1; o < 64; o <<= 1) v += __shfl_xor(v, o);
    return v;
}
__device__ __forceinline__ float wave_max(float v) {
#pragma unroll
    for (int o = 1; o < 64; o <<= 1) v = fmaxf(v, __shfl_xor(v, o));
    return v;
}

struct MapId { __device__ __forceinline__ int operator()(int n) const { return n; } };
struct MapGU { int half; __device__ __forceinline__ int operator()(int n) const { return (n >> 7) * 256 + half * 128 + (n & 127); } };
struct MapIn { __device__ __forceinline__ int operator()(int n) const { return n < 2120 ? n : n + 184; } };
template <class RowMap>
__device__ __forceinline__ void p0_transpose_item(const float* W, int K, int N, h16* WT, RowMap rm, LAS float* scr, int item, int lane) {
    const int nblk = (N + 31) / 32, kb = item / nblk, nb = item % nblk, k0 = 64 * kb, n0 = 32 * nb;
    const int nl = n0 + (lane & 31);
#pragma unroll 8
    for (int i = 0; i < 32; ++i) { const int kk = 2 * i + (lane >> 5); scr[kk * 33 + (lane & 31)] = (nl < N) ? W[(size_t)(k0 + kk) * N + nl] : 0.f; }
    LDS_WAIT(); asm volatile("" ::: "memory");
    const int c = lane & 7;
#pragma unroll
    for (int j = 0; j < 4; ++j) { const int nn = (lane >> 3) + 8 * j; const LAS float* s = scr + (8 * c) * 33 + nn;
        v4u o; o.x = cvt_pk_h16(s[0 * 33], s[1 * 33]); o.y = cvt_pk_h16(s[2 * 33], s[3 * 33]); o.z = cvt_pk_h16(s[4 * 33], s[5 * 33]); o.w = cvt_pk_h16(s[6 * 33], s[7 * 33]);
        if (n0 + nn < N) *(GAS v4u*)(WT + (size_t)rm(n0 + nn) * K + k0 + 8 * c) = o; }
    LDS_WAIT(); asm volatile("" ::: "memory");
}

__device__ __forceinline__ void p0_prologue(Frame& F, const Args& A) {
    unsigned char* ws = A.ws;
    if (blockIdx.x < 36) {
        LAS float* sc = (LAS float*)(F.lds);
        LAS float* red = (LAS float*)(F.lds + 8192);
        const float* c = A.in[1];
        for (int i = F.tid; i < 2048; i += NTHR) { const float v = c[i]; sc[i] = v / (1.0f + __expf(-v)); }
        __syncthreads();
        const float* wa = A.in[2]; const int col = blockIdx.x * 256 + 4 * F.lane;
        f32x4 a0 = {0.f, 0.f, 0.f, 0.f}, a1 = {0.f, 0.f, 0.f, 0.f};
        const int kb = F.wave * 128;
#pragma unroll 8
        for (int k = 0; k < 128; ++k) { const f32x4 w = *(const f32x4*)(wa + (size_t)(kb + k) * 9216 + col); a0 += w * sc[kb + k]; a1 += w * sc[1024 + kb + k]; }
        *(LAS f32x4*)(red + (F.wave * 2 + 0) * 256 + 4 * F.lane) = a0; *(LAS f32x4*)(red + (F.wave * 2 + 1) * 256 + 4 * F.lane) = a1;
        __syncthreads();
        { const int b = F.tid >> 8, j = F.tid & 255; float s = 0.f;
#pragma unroll
          for (int w = 0; w < 8; ++w) s += red[(w * 2 + b) * 256 + j];
          const int cc = blockIdx.x * 256 + j; ((float*)(ws + WS_MOD))[b * 9216 + cc] = s + A.in[3][cc]; }
        __syncthreads();
    }
    LAS float* scr = (LAS float*)(F.lds + RING_OFF + F.wave * 16384);
    const int gw = F.vcu * NWAVES + F.wave, NGW = F.G * NWAVES;
    constexpr int I_GU = (D / 64) * (FF / 32), I_DN = (FF / 64) * (D / 32), I_IN = (D / 64) * ((DIN + 31) / 32), I_OUT = (D / 64) * (D / 32);
    constexpr int NITEMS = 6 * I_GU + I_IN + I_OUT; static_assert(I_GU == I_DN, "items");
    h16* W1GU = (h16*)(ws + WS_W1GU); h16* W1D = (h16*)(ws + WS_W1D); h16* WIN = (h16*)(ws + WS_WIN); h16* WOUT = (h16*)(ws + WS_WOUT); h16* W2GU = (h16*)(ws + WS_W2GU); h16* W2D = (h16*)(ws + WS_W2D);
    for (int it = gw; it < NITEMS; it += NGW) {
        int r = it;
        if (r < I_GU) { p0_transpose_item(A.in[6], D, FF, W1GU, MapGU{0}, scr, r, F.lane); continue; } r -= I_GU;
        if (r < I_GU) { p0_transpose_item(A.in[7], D, FF, W1GU, MapGU{1}, scr, r, F.lane); continue; } r -= I_GU;
        if (r < I_DN) { p0_transpose_item(A.in[8], FF, D, W1D, MapId{}, scr, r, F.lane); continue; } r -= I_DN;
        if (r < I_IN) { p0_transpose_item(A.in[11], D, DIN, WIN, MapIn{}, scr, r, F.lane); continue; } r -= I_IN;
        if (r < I_OUT) { p0_transpose_item(A.in[22], D, D, WOUT, MapId{}, scr, r, F.lane); continue; } r -= I_OUT;
        if (r < I_GU) { p0_transpose_item(A.in[25], D, FF, W2GU, MapGU{0}, scr, r, F.lane); continue; } r -= I_GU;
        if (r < I_GU) { p0_transpose_item(A.in[26], D, FF, W2GU, MapGU{1}, scr, r, F.lane); continue; } r -= I_GU;
        p0_transpose_item(A.in[27], FF, D, W2D, MapId{}, scr, r, F.lane);
    }
    for (int tk = gw; tk < 128; tk += NGW) { const int s4 = tk & 3, jt = (tk >> 2) & 1, g = (tk >> 3) & 7, gate = tk >> 6; const float* W = A.in[gate ? 17 : 15]; const int r = F.lane & 31, hh = F.lane >> 5;
        float v[8];
#pragma unroll
        for (int e = 0; e < 8; ++e) v[e] = W[(g * 64 + 16 * s4 + 8 * hh + e) * 64 + 32 * jt + r];
        v4u o; o.x = cvt_pk_h16(v[0], v[1]); o.y = cvt_pk_h16(v[2], v[3]); o.z = cvt_pk_h16(v[4], v[5]); o.w = cvt_pk_h16(v[6], v[7]);
        *(GAS v4u*)(ws + WS_LRUW + ((size_t)tk * 64 + F.lane) * 16) = o; }
    for (int i = blockIdx.x * NTHR + F.tid; i < 184 * 128; i += F.G * NTHR) *(GAS v4u*)(WIN + (size_t)2120 * D + (size_t)i * 8) = (v4u){0u, 0u, 0u, 0u};
}

template <bool HAS_Y, bool HAS_H>
__device__ __forceinline__ void thin_phase(Frame& F, const float* mod, const float* yin, const float* gpost, float gscale, int mg,
                                           const float* xin, float* xout, const float* gpre, int msh, int msc, h16* hout) {
    LAS float* TA = (LAS float*)(F.lds); LAS float* TB = TA + 2048; LAS float* TC = TB + 2048;
    for (int i = F.tid; i < 2048; i += NTHR) { const int b = i >> 10, cidx = i & 1023;
        if (HAS_Y) TA[i] = gscale * mod[b * 9216 + mg * 1024 + cidx] * gpost[cidx];
        if (HAS_H) { TB[i] = gpre[cidx] * (1.0f + mod[b * 9216 + msc * 1024 + cidx]); TC[i] = mod[b * 9216 + msh * 1024 + cidx]; } }
    __syncthreads();
    const int gw = F.vcu * NWAVES + F.wave, NGW = F.G * NWAVES;
    for (int row = gw; row < M; row += NGW) {
        const int b = row >> 13;
        const GAS f32x4* xr = (const GAS f32x4*)(xin + (size_t)row * D) + F.lane;
        f32x4 x[4];
#pragma unroll
        for (int j = 0; j < 4; ++j) x[j] = xr[64 * j];
        if (HAS_Y) {
            const GAS f32x4* yr = (const GAS f32x4*)(yin + (size_t)row * D) + F.lane;
            f32x4 y[4]; float s = 0.f;
#pragma unroll
            for (int j = 0; j < 4; ++j) { y[j] = yr[64 * j]; s += (y[j].x * y[j].x + y[j].y * y[j].y) + (y[j].z * y[j].z + y[j].w * y[j].w); }
            const float rstd = 1.0f / sqrtf(wave_sum(s) * (1.0f / D) + EPS);
            GAS f32x4* xo = (GAS f32x4*)(xout + (size_t)row * D) + F.lane;
#pragma unroll
            for (int j = 0; j < 4; ++j) { const f32x4 ta = *(const LAS f32x4*)(TA + b * 1024 + 4 * F.lane + 256 * j); x[j] = x[j] + ta * (y[j] * rstd); xo[64 * j] = x[j]; }
        }
        if (HAS_H) {
            float s = 0.f;
#pragma unroll
            for (int j = 0; j < 4; ++j) s += (x[j].x * x[j].x + x[j].y * x[j].y) + (x[j].z * x[j].z + x[j].w * x[j].w);
            const float rstd = 1.0f / sqrtf(wave_sum(s) * (1.0f / D) + EPS);
            GAS v2u* ho = (GAS v2u*)(hout + (size_t)row * D) + F.lane;
#pragma unroll
            for (int j = 0; j < 4; ++j) { const f32x4 tb = *(const LAS f32x4*)(TB + b * 1024 + 4 * F.lane + 256 * j), tc = *(const LAS f32x4*)(TC + b * 1024 + 4 * F.lane + 256 * j);
                const f32x4 h = (x[j] * rstd) * tb + tc; v2u o; o.x = cvt_pk_h16(h.x, h.y); o.y = cvt_pk_h16(h.z, h.w); ho[64 * j] = o; }
        }
    }
    __syncthreads();
}

__device__ __forceinline__ float gelu_tanh(float x) { const float u = 0.7978845608028654f * (x + 0.044715f * x * x * x); const float e = __builtin_amdgcn_exp2f(2.0f * 1.4426950408889634f * u); const float t = 1.0f - 2.0f * __builtin_amdgcn_rcpf(e + 1.0f); return 0.5f * x * (1.0f + t); }
__device__ __forceinline__ float fast_sigmoid(float z) { return __builtin_amdgcn_rcpf(1.0f + __builtin_amdgcn_exp2f(-1.4426950408889634f * z)); }
__device__ __forceinline__ float lane_partner(float x, int hh) { auto rr = __builtin_amdgcn_permlane32_swap(__float_as_uint(x), __float_as_uint(x), false, false); return __uint_as_float(hh ? rr[0] : rr[1]); }
typedef float f32x16 __attribute__((ext_vector_type(16)));
__device__ __forceinline__ int crow(int r, int hi) { return (r & 3) + 8 * (r >> 2) + 4 * hi; }
constexpr int LL_XC = 0, LL_OUT = 32768, LL_CAR = 131072 + 1024;
template <bool PASS_B>
__device__ __forceinline__ void lru_phase(Frame& F, const Args& A) {
    unsigned char* ws = A.ws;
    const h16* LRU = (const h16*)(ws + WS_LRU); float* SA = (float*)(ws + WS_LRUS); float* SB = SA + BATCH * NLCH * DLRU;
    h16* MERGED = (h16*)(ws + WS_MERGED);
    int tid_o = F.tid; asm volatile("" : "+v"(tid_o));
    const int tid = tid_o, lane = tid & 63, g = F.wave, r = lane & 31, hh = lane >> 5;
    LAS unsigned char* XC = F.lds + LL_XC; LAS float* OUT = (LAS float*)(F.lds + LL_OUT); LAS float* CAR = (LAS float*)(F.lds + LL_CAR);
    const h16x8* LW = (const h16x8*)(ws + WS_LRUW);
    float ba[2], bi[2], sp8[2];
#pragma unroll
    for (int jt = 0; jt < 2; ++jt) { const int ch = g * 64 + 32 * jt + r; ba[jt] = A.in[16][ch]; bi[jt] = A.in[18][ch]; const float lam = A.in[19][ch]; sp8[jt] = 8.0f * ((lam < -15.f) ? -lam : log1pf(__expf(-lam))); }
    for (int p = blockIdx.x; p < 256; p += F.G) {
#pragma unroll 1
        for (int uu = 0; uu < 2; ++uu) {
            const int b = p >> 7, c = uu ? 255 - (p & 127) : (p & 127), t0 = c * LCH;
            const h16* xb = LRU + (size_t)(b * SEQ) * 1024;
            __syncthreads();
            { h16x8 xr[7]; f32x4 cwv[4][2], cbv[2];
              cbv[0] = *(const f32x4*)(A.in[14] + 8 * lane); cbv[1] = *(const f32x4*)(A.in[14] + 8 * lane + 4);
#pragma unroll
              for (int jx = 0; jx < 4; ++jx) { cwv[jx][0] = *(const f32x4*)(A.in[13] + jx * DLRU + 8 * lane); cwv[jx][1] = *(const f32x4*)(A.in[13] + jx * DLRU + 8 * lane + 4); }
#pragma unroll
              for (int k = 0; k < 7; ++k) { const int t = t0 + 4 * g - 3 + k; if (t >= 0) xr[k] = *(const h16x8*)(xb + (size_t)t * 1024 + 8 * lane); else xr[k] = (h16x8){0, 0, 0, 0, 0, 0, 0, 0}; }
#pragma unroll
              for (int tt = 0; tt < 4; ++tt) { float v[8];
#pragma unroll
                  for (int e = 0; e < 8; ++e) v[e] = cbv[e >> 2][e & 3] + (float)xr[tt][e] * cwv[0][e >> 2][e & 3] + (float)xr[tt + 1][e] * cwv[1][e >> 2][e & 3] + (float)xr[tt + 2][e] * cwv[2][e >> 2][e & 3] + (float)xr[tt + 3][e] * cwv[3][e >> 2][e & 3];
                  v4u o; o.x = cvt_pk_h16(v[0], v[1]); o.y = cvt_pk_h16(v[2], v[3]); o.z = cvt_pk_h16(v[4], v[5]); o.w = cvt_pk_h16(v[6], v[7]);
                  const int row = 4 * g + tt; *(LAS v4u*)(XC + row * 1024 + ((lane ^ (row & 7)) << 4)) = o; } }
            if (PASS_B) { float H = 0.f; const float* pa = SA + (size_t)(b * NLCH) * DLRU + tid; const float* pb = SB + (size_t)(b * NLCH) * DLRU + tid;
#pragma unroll 16
                for (int cc = 0; cc < c; ++cc) H = pa[(size_t)cc * DLRU] * H + pb[(size_t)cc * DLRU];
                CAR[tid] = H; }
            __syncthreads();
            h16x8 af[4];
#pragma unroll
            for (int s = 0; s < 4; ++s) af[s] = *(const LAS h16x8*)(XC + r * 1024 + (((g * 8 + 2 * s + hh) ^ (r & 7)) << 4));
#pragma unroll
            for (int jt = 0; jt < 2; ++jt) {
                float gt[16];
                if (PASS_B) {
#pragma unroll
                    for (int i = 0; i < 16; ++i) gt[i] = (float)xb[(size_t)(t0 + crow(i, hh)) * 1024 + 512 + g * 64 + 32 * jt + r]; }
                float av[16], bv[16];
                const int ch = g * 64 + 32 * jt + r;
                {   h16x8 wf[4];
#pragma unroll
                    for (int s = 0; s < 4; ++s) wf[s] = LW[(((0 * 8 + g) * 2 + jt) * 4 + s) * 64 + lane];
                    f32x16 za = {};
#pragma unroll
                    for (int s = 0; s < 4; ++s) za = __builtin_amdgcn_mfma_f32_32x32x16_f16(af[s], wf[s], za, 0, 0, 0);
#pragma unroll
                    for (int i = 0; i < 16; ++i) { const float rg = fast_sigmoid(za[i] + ba[jt]); const float la = -sp8[jt] * rg, y = 2.0f * la;
                        const float em = (y > -0.03f) ? -y * (1.0f + y * (0.5f + y * (0.16666667f + y * 0.041666668f))) : 1.0f - __expf(y);
                        av[i] = __expf(la); bv[i] = __builtin_amdgcn_sqrtf(em); } }
                {   h16x8 wf[4];
#pragma unroll
                    for (int s = 0; s < 4; ++s) wf[s] = LW[(((1 * 8 + g) * 2 + jt) * 4 + s) * 64 + lane];
                    f32x16 zi = {};
#pragma unroll
                    for (int s = 0; s < 4; ++s) zi = __builtin_amdgcn_mfma_f32_32x32x16_f16(af[s], wf[s], zi, 0, 0, 0);
#pragma unroll
                    for (int i = 0; i < 16; ++i) { const int t = crow(i, hh); const float ig = fast_sigmoid(zi[i] + bi[jt]);
                        const float xcv = (float)*(const LAS h16*)(XC + t * 1024 + ((((ch >> 3)) ^ (t & 7)) << 4) + (ch & 7) * 2);
                        bv[i] *= ig * xcv; } }
                float GA[4], GB[4];
#pragma unroll
                for (int k = 0; k < 4; ++k) { float Ak = av[4 * k], Bk = bv[4 * k];
#pragma unroll
                    for (int e = 1; e < 4; ++e) { Bk = av[4 * k + e] * Bk + bv[4 * k + e]; Ak *= av[4 * k + e]; }
                    GA[k] = Ak; GB[k] = Bk; }
                float state = PASS_B ? CAR[ch] : 0.f; float cin[4];
#pragma unroll
                for (int k = 0; k < 4; ++k) { const float out0 = GA[k] * state + GB[k]; const float p0 = lane_partner(out0, hh); const float in1 = hh ? p0 : state; cin[k] = in1;
                    const float out1 = GA[k] * in1 + GB[k]; const float p1 = lane_partner(out1, hh); state = hh ? out1 : p1; }
                if (!PASS_B) { float P = (GA[0] * GA[1]) * (GA[2] * GA[3]); P *= lane_partner(P, hh);
                    if (hh == 0) { SA[(size_t)(b * NLCH + c) * DLRU + ch] = P; SB[(size_t)(b * NLCH + c) * DLRU + ch] = state; } }
                else {
#pragma unroll
                    for (int k = 0; k < 4; ++k) { float h = cin[k];
#pragma unroll
                        for (int e = 0; e < 4; ++e) { const int i = 4 * k + e; h = av[i] * h + bv[i]; OUT[crow(i, hh) * 512 + ch] = h * gelu_tanh(gt[i]); } } }
            }
            if (PASS_B) {
                __syncthreads();
#pragma unroll
                for (int k = 0; k < 4; ++k) { const int tt = 4 * g + k;
                    const f32x4 o0 = *(const LAS f32x4*)(OUT + tt * 512 + 8 * lane), o1 = *(const LAS f32x4*)(OUT + tt * 512 + 8 * lane + 4);
                    const float s = (o0.x * o0.x + o0.y * o0.y) + (o0.z * o0.z + o0.w * o0.w) + (o1.x * o1.x + o1.y * o1.y) + (o1.z * o1.z + o1.w * o1.w);
                    const float rstd = 1.0f / sqrtf(wave_sum(s) * (1.0f / DLRU) + EPS);
                    const f32x4 g0 = *(const f32x4*)(A.in[21] + 8 * lane), g1 = *(const f32x4*)(A.in[21] + 8 * lane + 4);
                    v4u o; o.x = cvt_pk_h16(o0.x * rstd * g0.x, o0.y * rstd * g0.y); o.y = cvt_pk_h16(o0.z * rstd * g0.z, o0.w * rstd * g0.w);
                    o.z = cvt_pk_h16(o1.x * rstd * g1.x, o1.y * rstd * g1.y); o.w = cvt_pk_h16(o1.z * rstd * g1.z, o1.w * rstd * g1.w);
                    *(GAS v4u*)(MERGED + (size_t)(b * SEQ + t0 + tt) * 1024 + 512 + 8 * lane) = o; }
            }
        }
    }
}

constexpr int IDX_CAP = 128;
constexpr int IL_QL = 0, IL_WL = 36864, IL_INFO = 37888, IL_CNT = 38400, IL_PS = 38912, IL_HIST = 65536, IL_CAND = 65536, IL_SCR = 98304;
constexpr int SL_SCORE = 65536, SL_HIST = 98304, SL_CTL = 99328;
__device__ __forceinline__ unsigned ord_key(float f) { const unsigned u = __float_as_uint(f); return u ^ ((u >> 31) ? 0xFFFFFFFFu : 0x80000000u); }
__device__ __forceinline__ int t5_bucket(int rel) {
    const int n = rel < 0 ? -rel : rel; int large;
    if (n < 12) large = 8; else if (n < 16) large = 9; else if (n < 23) large = 10; else if (n < 32) large = 11; else if (n < 46) large = 12; else if (n < 64) large = 13; else if (n < 91) large = 14; else large = 15;
    return (rel > 0 ? 16 : 0) + (n < 8 ? n : large);
}
template <int PART>
__device__ __forceinline__ void idx_scores_part(f32x16 (&S)[2], const h16x8 (&a)[2][4], const LAS unsigned char* ql, int foff, int sw, int hh, const LAS float* wl) {
    if (PART == 0) {   h16x8 qf[4];
#pragma unroll
        for (int s = 0; s < 4; ++s) qf[s] = *(const LAS h16x8*)(ql + 8 * 4096 + foff + (((2 * s + hh) ^ sw) << 4));
#pragma unroll
        for (int sub = 0; sub < 2; ++sub) { f32x16 acc = {};
#pragma unroll
            for (int s = 0; s < 4; ++s) acc = __builtin_amdgcn_mfma_f32_32x32x16_f16(a[sub][s], qf[s], acc, 0, 0, 0);
            S[sub] = acc; } }
#pragma unroll 1
    for (int h = 4 * PART; h < 4 * PART + 4; ++h) {
        h16x8 qf[4]; const float wh = wl[h];
#pragma unroll
        for (int s = 0; s < 4; ++s) qf[s] = *(const LAS h16x8*)(ql + h * 4096 + foff + (((2 * s + hh) ^ sw) << 4));
#pragma unroll
        for (int sub = 0; sub < 2; ++sub) { f32x16 acc = {};
#pragma unroll
            for (int s = 0; s < 4; ++s) acc = __builtin_amdgcn_mfma_f32_32x32x16_f16(a[sub][s], qf[s], acc, 0, 0, 0);
#pragma unroll
            for (int i = 0; i < 16; ++i) S[sub][i] = __builtin_fmaf(__builtin_fabsf(acc[i]), wh, S[sub][i]); }
    }
}
__device__ __forceinline__ void idx_scores(f32x16 (&S)[2], const h16x8 (&a)[2][4], const LAS unsigned char* ql, int foff, int sw, int hh, const LAS float* wl) {
    idx_scores_part<0>(S, a, ql, foff, sw, hh, wl); idx_scores_part<1>(S, a, ql, foff, sw, hh, wl);
}
__device__ __forceinline__ void idx_phase(Frame& F, const Args& A) {
    unsigned char* ws = A.ws;
    const h16* QS = (const h16*)(ws + WS_QS); const h16* KI = (const h16*)(ws + WS_KI); const float* WI = (const float*)(ws + WS_WI);
    unsigned* MASK = (unsigned*)(ws + WS_MASK);
    LAS unsigned char* L = F.lds;
    int tid_o = F.tid; asm volatile("" : "+v"(tid_o));
    const int tid = tid_o, lane = tid & 63, wave = F.wave, r = lane & 31, hh = lane >> 5;
    LAS float* WL = (LAS float*)(L + IL_WL); LAS int* INFO = (LAS int*)(L + IL_INFO); LAS unsigned* CNT = (LAS unsigned*)(L + IL_CNT);
    LAS unsigned* HIST = (LAS unsigned*)(L + IL_HIST);
    for (int p = blockIdx.x; p < 256; p += F.G) {
        const int b = p >> 7, jj = p & 127;
        for (int uu = 0; uu < 2; ++uu) {
            const int j = uu ? 255 - jj : jj;
            const int q0 = 32 * j, rowb = b * SEQ + q0, N = ((j >> 1) + 1) * 64, NC = N >> 6;
            unsigned* mrow = MASK + ((size_t)(b * 128) * 8192 + q0) * 2;
            if (N <= TOPK) {
                for (int i = tid; i < NC * 64; i += NTHR) mrow[(size_t)(i >> 6) * 16384 + (i & 63)] = 0xFFFFFFFFu;
                continue;
            }
            __syncthreads();
#pragma unroll
            for (int i = 0; i < 4; ++i) { const int idx = tid + NTHR * i, q = idx >> 6, cc = idx & 63, head = cc >> 3, c8 = cc & 7;
                const v4u v = *(const GAS v4u*)(QS + (size_t)(rowb + q) * 512 + cc * 8);
                *(LAS v4u*)(L + IL_QL + head * 4096 + q * 128 + ((c8 ^ (q & 7)) << 4)) = v; }
            if (tid < 256) WL[tid] = WI[(size_t)rowb * 8 + tid];
            for (int i = tid; i < 16384; i += NTHR) HIST[i] = 0u;
            if (tid < 32) CNT[tid] = 0u;
            __syncthreads();
            { const int q = tid >> 4, dg = tid & 15, c8 = dg >> 1; float a0 = 0.f, a1 = 0.f, a2 = 0.f, a3 = 0.f;
              const int o = q * 128 + ((c8 ^ (q & 7)) << 4) + (dg & 1) * 8;
#pragma unroll
              for (int h = 0; h < 8; ++h) { const h16x4 v = *(const LAS h16x4*)(L + IL_QL + h * 4096 + o); const float wv = WL[q * 8 + h];
                  a0 += wv * (float)v[0]; a1 += wv * (float)v[1]; a2 += wv * (float)v[2]; a3 += wv * (float)v[3]; }
              v2u pk; pk.x = cvt_pk_h16(a0, a1); pk.y = cvt_pk_h16(a2, a3); *(LAS v2u*)(L + IL_QL + 8 * 4096 + o) = pk; }
            __syncthreads();
            const LAS float* w = WL + r * 8;
            const int foff = r * 128, sw = r & 7;
            const h16* kbase = KI + (size_t)(b * SEQ) * 64 + (size_t)r * 64 + 8 * hh;
            const LAS unsigned char* ql = L + IL_QL;
#define IDX_LOADA(dst, c) do { _Pragma("unroll") for (int sub_ = 0; sub_ < 2; ++sub_) _Pragma("unroll") for (int s_ = 0; s_ < 4; ++s_) \
                dst[sub_][s_] = *(const h16x8*)(kbase + (size_t)(64 * (c) + 32 * sub_) * 64 + 16 * s_); } while (0)
            h16x8 a[2][4]; f32x16 S[2];
            IDX_LOADA(a, 0); idx_scores(S, a, ql, foff, sw, hh, w);
            float s1 = 0.f, s2 = 0.f;
#pragma unroll
            for (int sub = 0; sub < 2; ++sub)
#pragma unroll
                for (int i = 0; i < 16; ++i) { s1 += S[sub][i]; s2 += S[sub][i] * S[sub][i]; }
            s1 += __shfl_xor(s1, 32); s2 += __shfl_xor(s2, 32);
            const float mean = s1 * (1.0f / 64.0f), sd = sqrtf(fmaxf(s2 * (1.0f / 64.0f) - mean * mean, 1e-30f));
            const float inv_w = 510.0f / (8.0f * sd), off = 1.0f - (mean - 3.0f * sd) * inv_w;
            { int c = wave; if (c < NC) IDX_LOADA(a, c);
              for (; c < NC; c += 8) {
                idx_scores(S, a, ql, foff, sw, hh, w);
                if (c + 8 < NC) IDX_LOADA(a, c + 8);
#pragma unroll
                for (int sub = 0; sub < 2; ++sub)
#pragma unroll
                    for (int i = 0; i < 16; ++i) { const float f = floorf(__builtin_fmaf(S[sub][i], inv_w, off)); const int bin = (int)fminf(fmaxf(f, 0.f), 511.f);
                        __hip_atomic_fetch_add(HIST + bin * 32 + r, 1u, __ATOMIC_RELAXED, __HIP_MEMORY_SCOPE_WORKGROUP); }
              } }
            __syncthreads();
            { LAS unsigned* PS = (LAS unsigned*)(L + IL_PS); const int rg = wave * 2 + hh; unsigned sum = 0u;
#pragma unroll
              for (int k = 0; k < 32; ++k) sum += HIST[(rg * 32 + k) * 32 + r];
              PS[rg * 32 + r] = sum;
              __syncthreads();
              if (wave == 0 && hh == 0) { const int q = r; unsigned cum = 0u; int rsel = 0; unsigned ps[16];
#pragma unroll
                  for (int k = 0; k < 16; ++k) ps[k] = PS[k * 32 + q];
                  bool found = false; unsigned above = 0u;
#pragma unroll
                  for (int k = 15; k >= 0; --k) { if (!found) { if (cum + ps[k] >= (unsigned)TOPK) { found = true; rsel = k; above = cum; } else cum += ps[k]; } }
                  int bsel = -1; unsigned cb = 0u, ca = 0u; cum = above;
                  for (int k = 31; k >= 0; --k) { const unsigned cn = HIST[(rsel * 32 + k) * 32 + q]; if (bsel < 0) { if (cum + cn >= (unsigned)TOPK) { bsel = rsel * 32 + k; cb = cn; ca = cum; } else cum += cn; } }
                  int slow = (!found || bsel <= 0 || bsel >= 511 || cb > (unsigned)IDX_CAP) ? 1 : 0;
#ifdef IDX_FORCE_SLOW
                  if (((rowb + q) % 251) == 0) slow = 1;
#endif
                  INFO[q * 4 + 0] = bsel; INFO[q * 4 + 1] = TOPK - (int)ca; INFO[q * 4 + 2] = slow; }
            }
            __syncthreads();
            const float blo = (float)INFO[r * 4 + 0], bhi = blo + 1.0f;
            LAS float* scr = (LAS float*)(L + IL_SCR + wave * 4096);
            LAS unsigned* cand = (LAS unsigned*)(L + IL_CAND);
            { int c = wave; if (c < NC) IDX_LOADA(a, c);
            for (; c < NC; c += 8) {
                idx_scores(S, a, ql, foff, sw, hh, w);
                if (c + 8 < NC) IDX_LOADA(a, c + 8);
                unsigned selw = 0u, cndw = 0u;
#pragma unroll
                for (int sub = 0; sub < 2; ++sub)
#pragma unroll
                    for (int i = 0; i < 16; ++i) { const float f = __builtin_fmaf(S[sub][i], inv_w, off); selw = selw * 2u + (f >= bhi ? 1u : 0u); cndw = cndw * 2u + (f >= blo ? 1u : 0u); }
                selw = (selw >> 16) | (selw << 16); cndw = (cndw >> 16) | (cndw << 16);
                mrow[(size_t)c * 16384 + (r * 2 + hh)] = selw;
                unsigned rem = cndw & ~selw;
                if (__any(rem != 0u)) {
#pragma unroll
                    for (int sub = 0; sub < 2; ++sub) {
                        LDS_WAIT();
#pragma unroll
                        for (int i = 0; i < 16; ++i) scr[i * 64 + lane] = S[sub][i];
                        LDS_WAIT();
                        unsigned bits = (rem >> (16 * sub)) & 0xFFFFu;
                        while (bits) { const int bp = 31 - __clz((int)bits), i = 15 - bp; bits &= ~(1u << bp);
                            const float val = scr[i * 64 + lane]; const unsigned key = (unsigned)(64 * c + 32 * sub + crow(i, hh));
                            const unsigned pos = __hip_atomic_fetch_add(CNT + r, 1u, __ATOMIC_RELAXED, __HIP_MEMORY_SCOPE_WORKGROUP);
                            if (pos < (unsigned)IDX_CAP) { cand[(r * IDX_CAP + pos) * 2] = __float_as_uint(val); cand[(r * IDX_CAP + pos) * 2 + 1] = key; } }
                    }
                }
            } }
            VM_WAIT(); __syncthreads();
#pragma unroll 1
            for (int k = 0; k < 4; ++k) { const int q = 4 * wave + k; const unsigned cc = CNT[q]; const int need = INFO[q * 4 + 1];
                if (cc > (unsigned)IDX_CAP) { if (lane == 0) INFO[q * 4 + 2] = 1; continue; }
                if (INFO[q * 4 + 2]) continue;
                for (unsigned i = lane; i < cc; i += 64) { const float si = __uint_as_float(cand[(q * IDX_CAP + i) * 2]); const unsigned ki = cand[(q * IDX_CAP + i) * 2 + 1]; int rank = 0;
                    for (unsigned jx = 0; jx < cc; ++jx) { const float sj = __uint_as_float(cand[(q * IDX_CAP + jx) * 2]); const unsigned kj = cand[(q * IDX_CAP + jx) * 2 + 1]; rank += (sj > si || (sj == si && kj < ki)) ? 1 : 0; }
                    if (rank < need) { const unsigned c = ki >> 6, sub = (ki >> 5) & 1u, row = ki & 31u, hk = (row >> 2) & 1u, rr = (row & 3u) + 4u * (row >> 3);
                        __hip_atomic_fetch_or(mrow + (size_t)c * 16384 + (q * 2 + hk), 1u << (16u * sub + 15u - rr), __ATOMIC_RELAXED, __HIP_MEMORY_SCOPE_AGENT); } }
            }
            __syncthreads();
#pragma unroll 1
            for (int q = 0; q < 32; ++q) {
                if (!INFO[q * 4 + 2]) continue;
                LAS float* s_score = (LAS float*)(L + SL_SCORE); LAS unsigned* s_hist = (LAS unsigned*)(L + SL_HIST); LAS unsigned* s_ctl = (LAS unsigned*)(L + SL_CTL);
                __syncthreads();
                for (int s = tid; s < N; s += NTHR) {
                    const h16* kr = KI + (size_t)(b * SEQ + s) * 64; float kv[64];
#pragma unroll
                    for (int i = 0; i < 8; ++i) { const h16x8 t8 = *(const h16x8*)(kr + 8 * i);
#pragma unroll
                        for (int e = 0; e < 8; ++e) kv[8 * i + e] = (float)t8[e]; }
                    float sc = 0.f;
#pragma unroll 1
                    for (int h = 0; h < 9; ++h) { float d = 0.f;
#pragma unroll
                        for (int c8 = 0; c8 < 8; ++c8) { const h16x8 qv = *(const LAS h16x8*)(L + IL_QL + h * 4096 + q * 128 + ((c8 ^ (q & 7)) << 4));
#pragma unroll
                            for (int e = 0; e < 8; ++e) d += (float)qv[e] * kv[8 * c8 + e]; }
                        sc += (h == 8) ? d : fabsf(d) * WL[q * 8 + h]; }
                    s_score[s] = sc;
                }
                __syncthreads();
                unsigned prefix = 0u, msk = 0u, remaining = TOPK, n_eq = 0u;
                for (int pass = 0; pass < 4; ++pass) {
                    const int shift = 24 - 8 * pass;
                    if (tid < 256) s_hist[tid] = 0u;
                    __syncthreads();
                    for (int s = tid; s < N; s += NTHR) { const unsigned key = ord_key(s_score[s]); if ((key & msk) == prefix) __hip_atomic_fetch_add(s_hist + ((key >> shift) & 255u), 1u, __ATOMIC_RELAXED, __HIP_MEMORY_SCOPE_WORKGROUP); }
                    __syncthreads();
                    if (wave == 0) {
                        const unsigned h0 = s_hist[4 * lane], h1 = s_hist[4 * lane + 1], h2 = s_hist[4 * lane + 2], h3 = s_hist[4 * lane + 3];
                        unsigned v = h0 + h1 + h2 + h3;
#pragma unroll
                        for (int o = 1; o < 64; o <<= 1) { const unsigned tv = __shfl_down(v, o); if (lane + o < 64) v += tv; }
                        unsigned above = __shfl_down(v, 1); if (lane == 63) above = 0u;
                        if (v >= remaining && above < remaining) {
                            unsigned cum = above; int dsel; unsigned rem; unsigned hv;
                            if (cum + h3 >= remaining) { dsel = 3; rem = remaining - cum; hv = h3; }
                            else { cum += h3; if (cum + h2 >= remaining) { dsel = 2; rem = remaining - cum; hv = h2; }
                            else { cum += h2; if (cum + h1 >= remaining) { dsel = 1; rem = remaining - cum; hv = h1; }
                            else { cum += h1; dsel = 0; rem = remaining - cum; hv = h0; } } }
                            s_ctl[0] = (unsigned)(4 * lane + dsel); s_ctl[1] = rem; s_ctl[4] = hv; }
                    }
                    __syncthreads();
                    prefix |= s_ctl[0] << shift; msk |= 255u << shift; remaining = s_ctl[1]; n_eq = s_ctl[4];
                    __syncthreads();
                }
                const unsigned tu = (prefix & 0x80000000u) ? (prefix ^ 0x80000000u) : ~prefix; const float thr = __uint_as_float(tu);
                unsigned idx_cut = 0xFFFFFFFFu;
                if (n_eq > remaining) {
                    if (tid == 0) { unsigned cnt = 0, cut = 0; for (int s = 0; s < N; ++s) if (s_score[s] == thr) { ++cnt; if (cnt == remaining) { cut = (unsigned)s; break; } } s_ctl[3] = cut; }
                    __syncthreads();
                    idx_cut = s_ctl[3];
                }
                int i0 = tid; asm volatile("" : "+v"(i0));
                for (int i = i0; i < NC * 2; i += NTHR) { const int c = i >> 1, hk = i & 1; unsigned word = 0u;
#pragma unroll
                    for (int sub = 0; sub < 2; ++sub)
#pragma unroll
                        for (int rr = 0; rr < 16; ++rr) { const int key = 64 * c + 32 * sub + crow(rr, hk); const float sc = s_score[key];
                            if (sc > thr || (sc == thr && (unsigned)key <= idx_cut)) word |= 1u << (16 * sub + 15 - rr); }
                    mrow[(size_t)c * 16384 + (q * 2 + hk)] = word; }
                __syncthreads();
            }
#undef IDX_LOADA
        }
    }
}

namespace at {
typedef short s16x4 __attribute__((ext_vector_type(4)));
constexpr int NSLOT = 3, SLOTB = 8192;
constexpr int LDS_K = 0, LDS_V = NSLOT * SLOTB, LDS_WS = 2 * NSLOT * SLOTB, LDS_TB = LDS_WS + 8 * 256, LDS_OST = 53248, LDS_BYTES = LDS_OST + 8 * 4096;
constexpr float LOG2E = 1.4426950408889634f;
__device__ __forceinline__ void glds16(const void* gsrc, unsigned lds_dst) { unsigned keep;
    asm volatile("s_mov_b32 %0, m0\n\ts_mov_b32 m0, %2\n\ts_nop 0\n\tglobal_load_lds_dwordx4 %1, off\n\ts_mov_b32 m0, %0" : "=&s"(keep) : "v"(gsrc), "s"(lds_dst) : "memory"); }
#define AT_WAIT_BAR(N) asm volatile("s_waitcnt vmcnt(" #N ") lgkmcnt(0)\n\ts_barrier" ::: "memory")
__device__ __forceinline__ h16x8 vtr8(const LAS unsigned char* p0, const LAS unsigned char* p1) {
    const s16x4 lo = __builtin_amdgcn_ds_read_tr16_b64_v4i16((LAS s16x4*)p0), hi = __builtin_amdgcn_ds_read_tr16_b64_v4i16((LAS s16x4*)p1);
    typedef short s16x8 __attribute__((ext_vector_type(8)));
    const s16x8 v = {lo[0], lo[1], lo[2], lo[3], hi[0], hi[1], hi[2], hi[3]}; return __builtin_bit_cast(h16x8, v); }
__device__ __forceinline__ h16x8 pack8(const f32x16& p, int b) {
    v4u w; w.x = cvt_pk_h16(p[b], p[b + 1]); w.y = cvt_pk_h16(p[b + 2], p[b + 3]); w.z = cvt_pk_h16(p[b + 4], p[b + 5]); w.w = cvt_pk_h16(p[b + 6], p[b + 7]); return __builtin_bit_cast(h16x8, w); }

__device__ __forceinline__ void attn_unit(int b, int h, int qb, const h16* Q, const h16* K, const h16* V, const unsigned* MASK, const float* relb, h16* O, LAS unsigned char* shm) {
    int tid_o = threadIdx.x; asm volatile("" : "+v"(tid_o));
    const int tid = tid_o, lane = tid & 63, r32 = lane & 31, hi = lane >> 5; const int wid = __builtin_amdgcn_readfirstlane(tid >> 6);
    const long rowbase = (long)b * SEQ; const int q0 = qb * 256, qw = q0 + wid * 32, cq = qw >> 6, NT = 4 * qb + 4;
    const h16* Qw = Q + (rowbase + qw) * 512 + h * 64;
    const h16* Kh = K + rowbase * 512 + h * 64; const h16* Vh = V + rowbase * 512 + h * 64;
    const unsigned lds0 = (unsigned)(uintptr_t)shm;
    LAS float* wsf = (LAS float*)(shm + LDS_WS) + wid * 64;
    LAS float* Tb = (LAS float*)(shm + LDS_TB);
    const h16* ksrc = Kh + (long)lane * 512 + wid * 8;
    const h16* vsrc = Vh + (long)(16 * (wid & 3) + (lane >> 2)) * 512 + (wid >> 2) * 32 + (lane & 3) * 8;
    const unsigned kdst = lds0 + LDS_K + wid * 1024, vdst = lds0 + LDS_V + wid * 1024;
#define AT_DMA_K(t, slot) glds16(ksrc + (long)(t) * 64 * 512, (unsigned)__builtin_amdgcn_readfirstlane(kdst + (slot)))
#define AT_DMA_V(t, slot) glds16(vsrc + (long)(t) * 64 * 512, (unsigned)__builtin_amdgcn_readfirstlane(vdst + (slot)))
    AT_DMA_K(0, 0); AT_DMA_V(0, 0); AT_DMA_K(1, SLOTB); AT_DMA_V(1, SLOTB);
    if (tid < 255) Tb[tid] = relb[t5_bucket(tid - 191) * 8 + h] * LOG2E;
    const float b15l = relb[15 * 8 + h] * LOG2E;
    h16x8 qr[4];
#pragma unroll
    for (int d0 = 0; d0 < 4; ++d0) qr[d0] = *(const h16x8*)(Qw + (long)r32 * 512 + d0 * 16 + hi * 8);
    const unsigned* mk = MASK + ((size_t)(b * 128) * 8192 + (qw + r32)) * 2 + hi;
    const LAS unsigned char* kp0 = shm + LDS_K + hi * 1024 + r32 * 16;
    const LAS unsigned char* vp0 = shm + LDS_V + ((lane >> 4) & 1) * 32 + (lane & 3) * 8 + (4 * hi + ((lane & 15) >> 2)) * 64;
    f32x16 o[2]; o[0] = f32x16{}; o[1] = f32x16{};
    float m = -1e30f, l = 0.f;
    int slot = 0, slot2 = 2 * SLOTB;
#pragma unroll 1
    for (int t = 0; t < NT; ++t) {
        if (t + 1 < NT) { AT_WAIT_BAR(2); } else { AT_WAIT_BAR(0); }
        if (t + 2 < NT) { AT_DMA_K(t + 2, slot2); AT_DMA_V(t + 2, slot2); }
        if (t <= cq) {
            const unsigned mw = mk[(size_t)t * 16384];
            const bool nearb = (t >= cq - 2);
            const float c0 = nearb ? 0.f : b15l;
            f32x16 p0, p1;
#pragma unroll
            for (int r = 0; r < 16; ++r) { p0[r] = c0; p1[r] = c0; }
            const LAS unsigned char* kb = kp0 + slot;
#pragma unroll
            for (int d0 = 0; d0 < 4; ++d0) { const h16x8 k0 = *(const LAS h16x8*)(kb + d0 * 2048), k1 = *(const LAS h16x8*)(kb + d0 * 2048 + 512);
                p0 = __builtin_amdgcn_mfma_f32_32x32x16_f16(k0, qr[d0], p0, 0, 0, 0); p1 = __builtin_amdgcn_mfma_f32_32x32x16_f16(k1, qr[d0], p1, 0, 0, 0); }
            if (nearb) { const int ib = 64 * t - (qw + r32) + 191 + 4 * hi;
#pragma unroll
                for (int r = 0; r < 16; ++r) { const int kk = (r & 3) + 8 * (r >> 2); p0[r] += Tb[ib + kk]; p1[r] += Tb[ib + 32 + kk]; } }
#pragma unroll
            for (int r = 0; r < 16; ++r) { p0[r] = ((mw >> (15 - r)) & 1u) ? p0[r] : -INFINITY; p1[r] = ((mw >> (31 - r)) & 1u) ? p1[r] : -INFINITY; }
            float mx = fmaxf(p0[0], p1[0]);
#pragma unroll
            for (int r = 1; r < 16; ++r) mx = fmaxf(mx, fmaxf(p0[r], p1[r]));
            { auto rr = __builtin_amdgcn_permlane32_swap(__float_as_uint(mx), __float_as_uint(mx), false, false); mx = fmaxf(__uint_as_float(rr[0]), __uint_as_float(rr[1])); }
            const float mn = fmaxf(m, mx), alpha = __builtin_amdgcn_exp2f(m - mn); m = mn;
            float ps = 0.f;
#pragma unroll
            for (int r = 0; r < 16; ++r) { p0[r] = __builtin_amdgcn_exp2f(p0[r] - mn); p1[r] = __builtin_amdgcn_exp2f(p1[r] - mn); ps += p0[r] + p1[r]; }
            l = l * alpha + ps;
            if (!__all(alpha == 1.0f)) {
                if (hi == 0) wsf[r32] = alpha;
                LDS_WAIT();
#pragma unroll
                for (int r = 0; r < 16; ++r) { const float f = wsf[crow(r, hi)]; o[0][r] *= f; o[1][r] *= f; }
            }
            const h16x8 pa0 = pack8(p0, 0), pa1 = pack8(p0, 8), pa2 = pack8(p1, 0), pa3 = pack8(p1, 8);
            const LAS unsigned char* vb = vp0 + slot;
#pragma unroll
            for (int d0 = 0; d0 < 2; ++d0) {
                const h16x8 v0 = vtr8(vb + d0 * 4096, vb + d0 * 4096 + 512), v1 = vtr8(vb + d0 * 4096 + 1024, vb + d0 * 4096 + 1024 + 512);
                const h16x8 v2 = vtr8(vb + d0 * 4096 + 2048, vb + d0 * 4096 + 2048 + 512), v3 = vtr8(vb + d0 * 4096 + 3072, vb + d0 * 4096 + 3072 + 512);
                o[d0] = __builtin_amdgcn_mfma_f32_32x32x16_f16(pa0, v0, o[d0], 0, 0, 0); o[d0] = __builtin_amdgcn_mfma_f32_32x32x16_f16(pa1, v1, o[d0], 0, 0, 0);
                o[d0] = __builtin_amdgcn_mfma_f32_32x32x16_f16(pa2, v2, o[d0], 0, 0, 0); o[d0] = __builtin_amdgcn_mfma_f32_32x32x16_f16(pa3, v3, o[d0], 0, 0, 0); }
        }
        slot2 = slot; slot = (slot == (NSLOT - 1) * SLOTB) ? 0 : slot + SLOTB;
    }
    { auto rr = __builtin_amdgcn_permlane32_swap(__float_as_uint(l), __float_as_uint(l), false, false); l = __uint_as_float(rr[0]) + __uint_as_float(rr[1]); }
    if (hi == 0) wsf[32 + r32] = l;
    LDS_WAIT();
    h16* Ow = O + (rowbase + qw) * 512 + h * 64;
    { LAS h16* stg = (LAS h16*)(shm + LDS_OST) + wid * 2048;
#pragma unroll
      for (int r = 0; r < 16; ++r) { const int orow = crow(r, hi); const float rl = 1.0f / wsf[32 + orow];
#pragma unroll
          for (int d0 = 0; d0 < 2; ++d0) stg[orow * 64 + d0 * 32 + r32] = (h16)(o[d0][r] * rl); }
      LDS_WAIT();
#pragma unroll
      for (int i = 0; i < 4; ++i) { const int row = i * 8 + (lane >> 3), ch = lane & 7; const v4u v = *(const LAS v4u*)(stg + row * 64 + ch * 8); *(GAS v4u*)(Ow + (long)row * 512 + ch * 8) = v; } }
    asm volatile("s_waitcnt lgkmcnt(0)\n\ts_barrier" ::: "memory");
#undef AT_DMA_K
#undef AT_DMA_V
}
__device__ __forceinline__ void attn_phase(Frame& F, const Args& A) {
    unsigned char* ws = A.ws;
    for (int v = F.vcu; v < 256; v += F.G) {
        const int bh = v >> 4, s = v & 15;
#pragma unroll 1
        for (int i = 0; i < 2; ++i) attn_unit(bh >> 3, bh & 7, i ? 31 - s : s, (const h16*)(ws + WS_Q), (const h16*)(ws + WS_K), (const h16*)(ws + WS_V), (const unsigned*)(ws + WS_MASK), A.in[12], (h16*)(ws + WS_O), F.lds + RING_OFF);
    }
}
#undef AT_WAIT_BAR
}

__device__ __forceinline__ void attn_norm_phase(Frame& F, const Args& A) {
    unsigned char* ws = A.ws; const h16* O = (const h16*)(ws + WS_O); h16* MERGED = (h16*)(ws + WS_MERGED);
    const f32x4 g0 = *(const f32x4*)(A.in[20] + 8 * F.lane), g1 = *(const f32x4*)(A.in[20] + 8 * F.lane + 4);
    const int gw = F.vcu * NWAVES + F.wave, NGW = F.G * NWAVES;
    for (int row = gw; row < M; row += NGW) {
        const h16x8 v = *(const h16x8*)(O + (size_t)row * 512 + 8 * F.lane); float f[8]; float s = 0.f;
#pragma unroll
        for (int e = 0; e < 8; ++e) { f[e] = (float)v[e]; s += f[e] * f[e]; }
        const float rstd = 1.0f / sqrtf(wave_sum(s) * (1.0f / DATT) + EPS);
        v4u o; o.x = cvt_pk_h16(f[0] * rstd * g0.x, f[1] * rstd * g0.y); o.y = cvt_pk_h16(f[2] * rstd * g0.z, f[3] * rstd * g0.w);
        o.z = cvt_pk_h16(f[4] * rstd * g1.x, f[5] * rstd * g1.y); o.w = cvt_pk_h16(f[6] * rstd * g1.z, f[7] * rstd * g1.w);
        *(GAS v4u*)(MERGED + (size_t)row * 1024 + 8 * F.lane) = o;
    }
}

__global__ void __launch_bounds__(NTHR, 2) fwd_kernel(Args args) {
    extern __shared__ __attribute__((aligned(16))) unsigned char lds[];
    Frame F;
    F.lds = (LAS unsigned char*)lds;
    F.MISC = (volatile LAS unsigned*)(F.lds + MISC_OFF);
    F.tid = threadIdx.x; F.lane = F.tid & 63; F.wave = __builtin_amdgcn_readfirstlane(F.tid >> 6);
    F.G = gridDim.x; { const int bx = blockIdx.x; F.vcu = (F.G % 8 == 0) ? (bx % 8) * (F.G / 8) + bx / 8 : bx; }
    unsigned char* ws = args.ws;
    F.ctl = (gu32*)(ws + WS_CTL);
    for (int u = F.tid; u < (LDS_BYTES - LDSCTL_OFF) / 4; u += NTHR) ((LAS unsigned*)(F.lds + LDSCTL_OFF))[u] = 0u;
    __syncthreads();
    XcdBarrier bar; bar.bar = (unsigned*)(F.ctl + CW_BAR); bar.x = 0; bar.st = nullptr;
    if (N_LAUNCHES == 1) bar = xcd_barrier_post((unsigned*)(F.ctl + CW_BAR), F.MISC + 8);
    const int lo = args.ph_lo, hi = args.ph_hi;
#define IN(k) (lo <= (k) && (k) < hi)
#define SEAM(k) do { if (IN(k) && IN((k) + 1)) xcd_barrier(bar); } while (0)
    const float* mod = (const float*)(ws + WS_MOD);
    h16* H = (h16*)(ws + WS_H); h16* ACT = (h16*)(ws + WS_ACT); float* Y = (float*)(ws + WS_Y);
    const int bx = (int)blockIdx.x;

    if (IN(0)) { p0_prologue(F, args); } SEAM(0);
    if (IN(1)) { thin_phase<false, true>(F, mod, nullptr, nullptr, 0.f, 0, args.in[0], nullptr, args.in[4], 0, 1, H); } SEAM(1);
    if (IN(2)) { pg8::Gemm g{H, (const h16*)(ws + WS_W1GU), M, NGU, D}; pg8::StaticOrder S; S.init(M, NGU, F.G, bx);
        pg8::EpiSwiGLU E{ACT, FF}; pg8::gemm_phase<pg8::EpiSwiGLU, pg8::StaticOrder, true>(F.lds + RING_OFF, g, S, E); } SEAM(2);
    if (IN(3)) { pg8::Gemm g{ACT, (const h16*)(ws + WS_W1D), M, D, FF}; pg8::StaticOrder S; S.init(M, D, F.G, bx);
        pg8::EpiF32 E{Y, D}; pg8::gemm_phase<pg8::EpiF32, pg8::StaticOrder, false>(F.lds + RING_OFF, g, S, E); } SEAM(3);
    if (IN(4)) { thin_phase<true, true>(F, mod, Y, args.in[5], 0.5f, 2, args.in[0], args.out, args.in[9], 3, 4, H); } SEAM(4);
    if (IN(5)) { pg8::Gemm g{H, (const h16*)(ws + WS_WIN), M, NPROJ, D}; pg8::StaticOrder S; S.init(M, NPROJ, F.G, bx);
        pg8::EpiProj E{ws + WS_Q, (size_t)(WS_K - WS_Q), (h16*)(ws + WS_QS), (h16*)(ws + WS_KI), (float*)(ws + WS_WI), (h16*)(ws + WS_LRU)};
        pg8::gemm_phase<pg8::EpiProj, pg8::StaticOrder, true>(F.lds + RING_OFF, g, S, E); } SEAM(5);
    if (IN(6)) { lru_phase<false>(F, args); } if (IN(6) && IN(7)) __syncthreads();
    if (IN(7)) { idx_phase(F, args); } SEAM(7);
    if (IN(8)) { lru_phase<true>(F, args); } if (IN(8) && IN(9)) __syncthreads();
    if (IN(9)) { at::attn_phase(F, args); } SEAM(9);
    if (IN(10)) { attn_norm_phase(F, args); } SEAM(10);
    if (IN(11)) { pg8::Gemm g{(const h16*)(ws + WS_MERGED), (const h16*)(ws + WS_WOUT), M, D, D}; pg8::StaticOrder S; S.init(M, D, F.G, bx);
        pg8::EpiF32 E{Y, D}; pg8::gemm_phase<pg8::EpiF32, pg8::StaticOrder, false>(F.lds + RING_OFF, g, S, E); } SEAM(11);
    if (IN(12)) { thin_phase<true, true>(F, mod, Y, args.in[10], 1.0f, 5, args.out, args.out, args.in[23], 6, 7, H); } SEAM(12);
    if (IN(13)) { pg8::Gemm g{H, (const h16*)(ws + WS_W2GU), M, NGU, D}; pg8::StaticOrder S; S.init(M, NGU, F.G, bx);
        pg8::EpiSwiGLU E{ACT, FF}; pg8::gemm_phase<pg8::EpiSwiGLU, pg8::StaticOrder, true>(F.lds + RING_OFF, g, S, E); } SEAM(13);
    if (IN(14)) { pg8::Gemm g{ACT, (const h16*)(ws + WS_W2D), M, D, FF}; pg8::StaticOrder S; S.init(M, D, F.G, bx);
        pg8::EpiF32 E{Y, D}; pg8::gemm_phase<pg8::EpiF32, pg8::StaticOrder, false>(F.lds + RING_OFF, g, S, E); } SEAM(14);
    if (IN(15)) { thin_phase<true, false>(F, mod, Y, args.in[24], 0.5f, 8, args.out, args.out, nullptr, 0, 0, nullptr); }
#undef IN
#undef SEAM
}

extern "C" void kernel_launch(void* const* d_in, const int* in_sizes, int n_in, void* d_out, int out_size, void* d_ws, size_t ws_size, hipStream_t stream) {
    static int grid = 0;
    if (grid == 0) {
        if (n_in != 28 || in_sizes[0] != M * D || out_size != M * D || ws_size < WS_END) { fprintf(stderr, "kernel_launch: unexpected shapes (n_in %d, in0 %d, out %d, ws %zu); nothing launched\n", n_in, n_in > 0 ? in_sizes[0] : -1, out_size, ws_size); grid = -1; return; }
        int dev = 0, cus = 0, per_cu = 0;
        if (hipGetDevice(&dev) != hipSuccess || hipDeviceGetAttribute(&cus, hipDeviceAttributeMultiprocessorCount, dev) != hipSuccess) { grid = -1; return; }
        if (hipFuncSetAttribute((const void*)fwd_kernel, hipFuncAttributeMaxDynamicSharedMemorySize, LDS_BYTES) != hipSuccess) { fprintf(stderr, "kernel_launch: hipFuncSetAttribute failed\n"); grid = -1; return; }
        if (hipOccupancyMaxActiveBlocksPerMultiprocessor(&per_cu, (const void*)fwd_kernel, NTHR, LDS_BYTES) != hipSuccess || per_cu < 1) { fprintf(stderr, "kernel_launch: occupancy query reports %d\n", per_cu); }
        (void)hipGetLastError();
        grid = cus;
    }
    if (grid < 0) return;
    if (hipMemsetAsync((char*)d_ws + WS_CTL, 0, CTL_ZERO_BYTES, stream) != hipSuccess) return;
    Args a{};
    for (int i = 0; i < 28; ++i) a.in[i] = (const float*)d_in[i];
    a.out = (float*)d_out; a.ws = (unsigned char*)d_ws;
    if (N_LAUNCHES == 1) { a.ph_lo = 0; a.ph_hi = N_PHASES; a.li = 0; hipLaunchKernelGGL(fwd_kernel, dim3(grid), dim3(NTHR), LDS_BYTES, stream, a); }
    else { for (int p = 0; p < N_PHASES; ++p) { a.ph_lo = p; a.ph_hi = p + 1; a.li = p; const int reps = (p == PROBE_PHASE) ? 2 : 1;
        for (int rr = 0; rr < reps; ++rr) hipLaunchKernelGGL(fwd_kernel, dim3(grid), dim3(NTHR), LDS_BYTES, stream, a); } }
}
```

```cpp
#include <hip/hip_runtime.h>
#include <cstdio>
#include <cstdint>

#ifndef PROBE_PHASE
#define PROBE_PHASE -1
#endif
#ifndef MK_N_LAUNCHES
#define MK_N_LAUNCHES 1
#endif

namespace pg8 {
#define PG8_LAS __attribute__((address_space(3)))
typedef _Float16 h16;
typedef _Float16 h16x8 __attribute__((ext_vector_type(8)));
typedef _Float16 h16x2 __attribute__((ext_vector_type(2)));
typedef float f32x4 __attribute__((ext_vector_type(4)));
typedef float f32x2 __attribute__((ext_vector_type(2)));
typedef unsigned u32x4 __attribute__((ext_vector_type(4)));
constexpr int BM = 256, BK = 64, HALF = 128, HTB = HALF * BK * 2, STAGE_BYTES = 8 * HTB, NXCD = 8, WGM = 8;

__host__ __device__ __forceinline__ int lds_byte(int r, int c) { const int st = (r >> 4) * 2 + (c >> 5), rr = r & 15, cc = c & 31, ob = rr * 64 + cc * 2; return st * 1024 + (ob ^ (((ob >> 9) & 1) << 5)); }
__host__ __device__ __forceinline__ void stage_rc(int b, int& R, int& C) { const int st = b / 1024, sb = b % 1024, swz = sb ^ (((sb >> 9) & 1) << 5); R = (st >> 1) * 16 + swz / 64; C = (st & 1) * 32 + (swz % 64) / 2; }
__host__ __device__ __forceinline__ int perm32(int rho) { const int n = rho >> 4, i = rho & 15; return 8 * (i >> 2) + 4 * n + (i & 3); }

struct Unit { int pm, pn; };
struct Gemm { const h16* A; const h16* Bt; int M, N, K; };

struct StaticOrder {
    int nM, nN, nwg, G, c;
    __host__ __device__ void init(int M, int N, int G_, int c_) { nM = M / BM; nN = N / BM; nwg = nM * nN; G = G_; c = c_; }
    __host__ __device__ bool next(int i, Unit& u) const {
        const long L = (long)i * G + c; if (L >= nwg) return false;
        int wgid = (int)L; { const int q = nwg / NXCD, r = nwg % NXCD, xcd = wgid % NXCD, off = wgid / NXCD; wgid = (xcd < r ? xcd * (q + 1) : r * (q + 1) + (xcd - r) * q) + off; }
        const int nig = WGM * nN, gid = wgid / nig, fm = gid * WGM, gsz = (nM - fm) < WGM ? (nM - fm) : WGM;
        u.pm = fm + ((wgid % nig) % gsz); u.pn = (wgid % nig) / gsz; return true;
    }
    __device__ __forceinline__ void a_ready(const Unit&) const {}
    __device__ __forceinline__ void done(const Unit&) const {}
};

__device__ __forceinline__ unsigned cvt_pk_h16(float lo, float hi) { f32x2 v = {lo, hi}; h16x2 h = __builtin_convertvector(v, h16x2); return __builtin_bit_cast(unsigned, h); }

struct EpiF32 {
    static constexpr bool PERM = false, AFTER_DRAIN = false;
    float* C; int ldc;
    __device__ __forceinline__ void operator()(const f32x4 (&acc)[2][2][4][2], const Unit& u, int wr, int wc, int fr, int fq) const {
        const int row0 = u.pm * BM + wr * 64 + fr, col0 = u.pn * BM + wc * 32 + 4 * fq;
#pragma unroll
        for (int ai = 0; ai < 2; ++ai)
#pragma unroll
            for (int m = 0; m < 4; ++m) { float* rowp = C + (size_t)(row0 + ai * HALF + m * 16) * ldc + col0;
#pragma unroll
                for (int bj = 0; bj < 2; ++bj)
#pragma unroll
                    for (int n = 0; n < 2; ++n) *(f32x4*)(rowp + bj * HALF + n * 16) = acc[ai][bj][m][n]; }
    }
};
struct EpiSwiGLU {
    static constexpr bool PERM = true, AFTER_DRAIN = false;
    h16* O; int ldc;
    __device__ __forceinline__ void operator()(const f32x4 (&acc)[2][2][4][2], const Unit& u, int wr, int wc, int fr, int fq) const {
        const int row0 = u.pm * BM + wr * 64 + fr, col0 = u.pn * HALF + wc * 32 + 8 * fq;
#pragma unroll
        for (int ai = 0; ai < 2; ++ai)
#pragma unroll
            for (int m = 0; m < 4; ++m) { h16* rowp = O + (size_t)(row0 + ai * HALF + m * 16) * ldc + col0;
                float v[8];
#pragma unroll
                for (int n = 0; n < 2; ++n)
#pragma unroll
                    for (int i = 0; i < 4; ++i) { const float g = acc[ai][0][m][n][i], up = acc[ai][1][m][n][i];
                        const float e = __builtin_amdgcn_exp2f(-1.4426950408889634f * g); v[4 * n + i] = g * __builtin_amdgcn_rcpf(1.0f + e) * up; }
                u32x4 w; w.x = cvt_pk_h16(v[0], v[1]); w.y = cvt_pk_h16(v[2], v[3]); w.z = cvt_pk_h16(v[4], v[5]); w.w = cvt_pk_h16(v[6], v[7]);
                *(u32x4*)rowp = w; }
    }
};
struct EpiProj {
    static constexpr bool PERM = true, AFTER_DRAIN = false;
    unsigned char* qkv; size_t qkv_stride; h16* QS; h16* KI; float* WI; h16* LRU;
    __device__ __forceinline__ void store_h16(const f32x4 (&acc)[2][2][4][2], h16* base, int ld, int row0, int c0, float sc) const {
#pragma unroll
        for (int ai = 0; ai < 2; ++ai)
#pragma unroll
            for (int m = 0; m < 4; ++m) { h16* rowp = base + (size_t)(row0 + ai * HALF + m * 16) * ld + c0;
#pragma unroll
                for (int bj = 0; bj < 2; ++bj) { const f32x4 v0 = acc[ai][bj][m][0] * sc, v1 = acc[ai][bj][m][1] * sc;
                    u32x4 w; w.x = cvt_pk_h16(v0[0], v0[1]); w.y = cvt_pk_h16(v0[2], v0[3]); w.z = cvt_pk_h16(v1[0], v1[1]); w.w = cvt_pk_h16(v1[2], v1[3]);
                    *(u32x4*)(rowp + bj * HALF) = w; } }
    }
    __device__ __forceinline__ void operator()(const f32x4 (&acc)[2][2][4][2], const Unit& u, int wr, int wc, int fr, int fq) const {
        const int row0 = u.pm * BM + wr * 64 + fr, cw = wc * 32 + 8 * fq; const int pn = u.pn;
        if (pn < 6) { store_h16(acc, (h16*)(qkv + (size_t)(pn >> 1) * qkv_stride), 512, row0, (pn & 1) * 256 + cw, pn < 2 ? 0.125f * 1.4426950408889634f : 1.0f); }
        else if (pn >= 9) { store_h16(acc, LRU, 1024, row0, (pn - 9) * 256 + cw, 1.0f); }
        else if (pn < 8) { store_h16(acc, QS, 512, row0, (pn - 6) * 256 + cw, 0.125f); }
        else {
#pragma unroll
            for (int ai = 0; ai < 2; ++ai)
#pragma unroll
                for (int m = 0; m < 4; ++m) { const size_t row = (size_t)(row0 + ai * HALF + m * 16); const f32x4 v0 = acc[ai][0][m][0], v1 = acc[ai][0][m][1];
                    if (cw < 64) { u32x4 w; w.x = cvt_pk_h16(v0[0], v0[1]); w.y = cvt_pk_h16(v0[2], v0[3]); w.z = cvt_pk_h16(v1[0], v1[1]); w.w = cvt_pk_h16(v1[2], v1[3]); *(u32x4*)(KI + row * 64 + cw) = w; }
                    else if (cw == 64) { const float sc = 0.5f * 0.35355339059327373f; *(f32x4*)(WI + row * 8) = v0 * sc; *(f32x4*)(WI + row * 8 + 4) = v1 * sc; } }
        }
    }
};

template <class Epi, class Sched, bool ALIGN_EPI = false>
__device__ __forceinline__ void gemm_phase(PG8_LAS unsigned char* lds, const Gemm g, const Sched& S, const Epi& E) {
    const int tid = threadIdx.x, wid = __builtin_amdgcn_readfirstlane(tid >> 6), lane = tid & 63, wr = wid >> 2, wc = wid & 3, fr = lane & 15, fq = lane >> 4;
    const int K = g.K, nt = K / BK;
    unsigned voffA[2], voffB[2];
#pragma unroll
    for (int i = 0; i < 2; ++i) { int R, C; stage_rc(tid * 16 + i * 8192, R, C); const int Rb = Epi::PERM ? ((R & ~31) + perm32(R & 31)) : R;
        voffA[i] = (unsigned)(R * K + C) * 2u; voffB[i] = (unsigned)(Rb * K + C) * 2u; }
    const size_t kstep = (size_t)(BK * 2);
    const size_t hstep = (size_t)HALF * K * 2;
    const size_t tstep = 2 * hstep;
    const unsigned ldsw = (unsigned)wid * 1024u;
    const int aoff = lds_byte(wr * 64 + fr, fq * 8), boff = lds_byte(wc * 32 + fr, fq * 8);
#define PG8_SA(b, h) (((b) * 2 + (h)) * HTB)
#define PG8_SB(b, h) ((4 + (b) * 2 + (h)) * HTB)
#define PG8_STAGE(bufoff, gbase, voff) do { _Pragma("unroll") for (int _i = 0; _i < 2; ++_i) \
        __builtin_amdgcn_global_load_lds((const unsigned*)((const char*)(gbase) + (voff)[_i]), (PG8_LAS unsigned*)(lds + (bufoff) + ldsw + _i * 8192), 16, 0, 0); } while (0)
#define PG8_LDA(dst, b, h) do { _Pragma("unroll") for (int m = 0; m < 4; ++m) _Pragma("unroll") for (int k = 0; k < 2; ++k) dst[m][k] = *(const PG8_LAS h16x8*)(lds + PG8_SA(b, h) + aoff + m * 2048 + k * 1024); } while (0)
#define PG8_LDB(dst, b, h) do { _Pragma("unroll") for (int n = 0; n < 2; ++n) _Pragma("unroll") for (int k = 0; k < 2; ++k) dst[n][k] = *(const PG8_LAS h16x8*)(lds + PG8_SB(b, h) + boff + n * 2048 + k * 1024); } while (0)
#define PG8_MMA(ai, bj, At, Bt) do { __builtin_amdgcn_s_setprio(1); _Pragma("unroll") for (int m = 0; m < 4; ++m) _Pragma("unroll") for (int n = 0; n < 2; ++n) _Pragma("unroll") for (int k = 0; k < 2; ++k) \
        acc[ai][bj][m][n] = __builtin_amdgcn_mfma_f32_16x16x32_f16(Bt[n][k], At[m][k], acc[ai][bj][m][n], 0, 0, 0); __builtin_amdgcn_s_setprio(0); } while (0)
#define PG8_WAIT_V(n) asm volatile("s_waitcnt vmcnt(" #n ")" ::: "memory")
#define PG8_WAIT_L(n) asm volatile("s_waitcnt lgkmcnt(" #n ")" ::: "memory")
#define PG8_BAR __builtin_amdgcn_s_barrier()
#define PG8_SCHED __builtin_amdgcn_sched_barrier(0)
    Unit cur, nxt; int ui = 0;
    if (!S.next(0, cur)) return;
    f32x4 acc[2][2][4][2];
#pragma unroll
    for (int a = 0; a < 2; ++a)
#pragma unroll
        for (int b = 0; b < 2; ++b)
#pragma unroll
            for (int m = 0; m < 4; ++m)
#pragma unroll
                for (int n = 0; n < 2; ++n) acc[a][b][m][n] = (f32x4){0.f, 0.f, 0.f, 0.f};
    h16x8 At[4][2], B0[2][2], B1[2][2];
    const char* cA = (const char*)g.A + (size_t)cur.pm * tstep; const char* cB = (const char*)g.Bt + (size_t)cur.pn * tstep;
    S.a_ready(cur);
    PG8_STAGE(PG8_SB(0, 0), cB, voffB); PG8_STAGE(PG8_SB(0, 1), cB + hstep, voffB); PG8_STAGE(PG8_SA(0, 0), cA, voffA); PG8_STAGE(PG8_SA(0, 1), cA + hstep, voffA);
    if (wr == 1) PG8_BAR;
    PG8_WAIT_V(2); PG8_BAR;
    PG8_STAGE(PG8_SB(1, 0), cB + kstep, voffB); PG8_STAGE(PG8_SA(1, 0), cA + kstep, voffA); PG8_STAGE(PG8_SB(1, 1), cB + hstep + kstep, voffB);
    PG8_WAIT_V(6); PG8_BAR;
    for (;;) {
        const bool has_next = S.next(ui + 1, nxt);
        const char* nA = has_next ? (const char*)g.A + (size_t)nxt.pm * tstep : cA; const char* nB = has_next ? (const char*)g.Bt + (size_t)nxt.pn * tstep : cB;
        for (int t = 0; t < nt; t += 2) {
            const bool last = (t == nt - 2);
            const char* a1 = cA + (size_t)(t + 1) * kstep;
            const char* a2 = last ? nA : cA + (size_t)(t + 2) * kstep; const char* b2 = last ? nB : cB + (size_t)(t + 2) * kstep;
            const char* a3 = a2 + kstep; const char* b3 = b2 + kstep;
            if (last && has_next) S.a_ready(nxt);
            PG8_LDB(B0, 0, 0); PG8_LDB(B1, 0, 1); PG8_SCHED; PG8_LDA(At, 0, 0); PG8_STAGE(PG8_SA(1, 1), a1 + hstep, voffA);
            PG8_WAIT_V(8); PG8_WAIT_L(0); PG8_BAR; PG8_MMA(0, 0, At, B0); PG8_MMA(0, 1, At, B1); PG8_BAR; PG8_SCHED;
            PG8_LDA(At, 0, 1); PG8_STAGE(PG8_SB(0, 0), b2, voffB); PG8_STAGE(PG8_SB(0, 1), b2 + hstep, voffB); PG8_STAGE(PG8_SA(0, 0), a2, voffA);
            PG8_WAIT_V(8); PG8_WAIT_L(0); PG8_BAR; PG8_MMA(1, 0, At, B0); PG8_MMA(1, 1, At, B1); PG8_BAR; PG8_SCHED;
            PG8_LDB(B0, 1, 0); PG8_LDB(B1, 1, 1); PG8_SCHED; PG8_LDA(At, 1, 0); PG8_STAGE(PG8_SA(0, 1), a2 + hstep, voffA);
            PG8_WAIT_V(8); PG8_WAIT_L(0); PG8_BAR; PG8_MMA(0, 0, At, B0); PG8_MMA(0, 1, At, B1); PG8_BAR; PG8_SCHED;
            PG8_LDA(At, 1, 1); PG8_STAGE(PG8_SB(1, 0), b3, voffB); PG8_STAGE(PG8_SB(1, 1), b3 + hstep, voffB); PG8_STAGE(PG8_SA(1, 0), a3, voffA);
            PG8_WAIT_V(8); PG8_WAIT_L(0); PG8_BAR; PG8_MMA(1, 0, At, B0); PG8_MMA(1, 1, At, B1); PG8_BAR; PG8_SCHED;
        }
        if constexpr (ALIGN_EPI) { if (wr == 0) PG8_BAR; }
        E(acc, cur, wr, wc, fr, fq); S.done(cur);
        if (!has_next) break;
#pragma unroll
        for (int a = 0; a < 2; ++a)
#pragma unroll
            for (int b = 0; b < 2; ++b)
#pragma unroll
                for (int m = 0; m < 4; ++m)
#pragma unroll
                    for (int n = 0; n < 2; ++n) acc[a][b][m][n] = (f32x4){0.f, 0.f, 0.f, 0.f};
        cur = nxt; cA = nA; cB = nB; ++ui;
        if constexpr (ALIGN_EPI) { if (wr == 1) PG8_BAR; }
    }
    PG8_WAIT_V(0);
    if constexpr (!ALIGN_EPI) { if (wr == 0) PG8_BAR; }
    PG8_BAR;
#undef PG8_SA
#undef PG8_SB
#undef PG8_STAGE
#undef PG8_LDA
#undef PG8_LDB
#undef PG8_MMA
#undef PG8_WAIT_V
#undef PG8_WAIT_L
#undef PG8_BAR
#undef PG8_SCHED
}
}

constexpr int NWAVES = 8, NTHR = NWAVES * 64;
constexpr int N_LAUNCHES = MK_N_LAUNCHES;
constexpr int N_PHASES = 16;
constexpr int BATCH = 2, SEQ = 8192, D = 1024, FF = 2816, M = BATCH * SEQ;
constexpr int NGU = 2 * FF;
constexpr int NPROJ = 3328;
constexpr int DIN = 3144;
constexpr int NH = 8, HD = 64, DATT = 512, DLRU = 512, TOPK = 256, CHUNK = 64;
constexpr int LCH = 32, NLCH = SEQ / LCH;
constexpr float EPS = 1e-6f;

constexpr size_t MiB = 1u << 20;
constexpr size_t WS_CTL = 0, CTL_ZERO_BYTES = 1 * MiB;
constexpr size_t WS_MOD = 1 * MiB;
constexpr size_t WS_LRUW = 2 * MiB;
constexpr size_t WS_LRUS = 246 * MiB;
constexpr size_t WS_W1GU = 3 * MiB, WS_W1D = 14 * MiB, WS_WIN = 20 * MiB, WS_WOUT = 27 * MiB, WS_W2GU = 29 * MiB, WS_W2D = 40 * MiB;
constexpr size_t WS_H = 46 * MiB;
constexpr size_t WS_ACT = 78 * MiB;
constexpr size_t WS_Y = 166 * MiB;
constexpr size_t WS_Q = 78 * MiB, WS_K = 94 * MiB, WS_V = 110 * MiB;
constexpr size_t WS_QS = 126 * MiB;
constexpr size_t WS_O = 142 * MiB;
constexpr size_t WS_KI = 158 * MiB;
constexpr size_t WS_WI = 160 * MiB;
constexpr size_t WS_MASK = 230 * MiB;
constexpr size_t WS_LRU = 166 * MiB;
constexpr size_t WS_MERGED = WS_H;
constexpr size_t WS_END = 248 * MiB;
constexpr int CW_BAR = 4096;

constexpr int RING_OFF = 0, RING_BYTES = 131072;
constexpr int LDSCTL_OFF = RING_BYTES, MISC_OFF = LDSCTL_OFF + 320;
constexpr int LDS_BYTES = 147456;

#define GAS __attribute__((address_space(1)))
#define LAS __attribute__((address_space(3)))
typedef _Float16 h16;
typedef unsigned v4u __attribute__((ext_vector_type(4)));
typedef unsigned v2u __attribute__((ext_vector_type(2)));
typedef float f32x4 __attribute__((ext_vector_type(4)));
typedef _Float16 h16x8 __attribute__((ext_vector_type(8)));
typedef _Float16 h16x4 __attribute__((ext_vector_type(4)));
typedef GAS unsigned gu32;
#define RLX_AGENT __ATOMIC_RELAXED, __HIP_MEMORY_SCOPE_AGENT
#define LDS_WAIT() asm volatile("s_waitcnt lgkmcnt(0)" ::: "memory")
#define VM_WAIT() asm volatile("s_waitcnt vmcnt(0)" ::: "memory")
using pg8::cvt_pk_h16;

#define XB_TMO      128
#define XB_XCNT(j)  (256  + 64 * (j))
#define XB_XSUB(j)  (1280 + 64 * (j))
#define XB_XGEN(j)  (2304 + 64 * (j))
#define XB_TOP      3328
#define XB_TOPGEN   3392
#define XCD_BAR_WORDS 3456
#define XB_SPIN_CAP (1u << 18)
__device__ __forceinline__ unsigned xb_ld(unsigned* p)              { return __hip_atomic_load(p, __ATOMIC_RELAXED, __HIP_MEMORY_SCOPE_AGENT); }
__device__ __forceinline__ unsigned xb_add(unsigned* p, unsigned v) { return __hip_atomic_fetch_add(p, v, __ATOMIC_RELAXED, __HIP_MEMORY_SCOPE_AGENT); }
__device__ __forceinline__ unsigned xb_xcc_id() { return (unsigned)__builtin_amdgcn_s_getreg((3 << 11) | 20) & 0xFu; }
#define XB_SPIN(cond, bar) do { unsigned _sp = 0; while (cond) { __builtin_amdgcn_s_sleep(1); \
    if ((++_sp & 255u) == 0u) { if (xb_ld(&(bar)[XB_TMO])) break; if (_sp > XB_SPIN_CAP) { atomicAdd(&(bar)[XB_TMO], 1u); break; } } } } while (0)
struct XcdBarrier { unsigned* bar; unsigned x; volatile LAS unsigned* st; };
__device__ __forceinline__ XcdBarrier xcd_barrier_post(unsigned* bar, volatile LAS unsigned* st) {
    XcdBarrier b; b.bar = bar; b.x = xb_xcc_id(); b.st = st;
    if (threadIdx.x == 0) (void)xb_add(&bar[XB_XCNT(b.x)], 1u);
    return b;
}
__device__ __forceinline__ void xcd_barrier_complete(unsigned* bar, unsigned x, unsigned& nloc, unsigned& nx) {
    const unsigned G = gridDim.x * gridDim.y * gridDim.z;
    unsigned sum, cnt, mine, sp = 0u;
    for (;;) {
        sum = 0u; cnt = 0u; mine = 0u;
#pragma unroll
        for (unsigned j = 0; j < 16; ++j) { const unsigned c = xb_ld(&bar[XB_XCNT(j)]); sum += c; cnt += (c > 0u) ? 1u : 0u; mine = (j == x) ? c : mine; }
        if (sum == G) break;
        __builtin_amdgcn_s_sleep(1);
        if ((++sp & 255u) == 0u) { if (xb_ld(&bar[XB_TMO])) break; if (sp > XB_SPIN_CAP) { atomicAdd(&bar[XB_TMO], 1u); break; } }
    }
    nloc = mine > 0u ? mine : 1u; nx = cnt > 0u ? cnt : 1u;
}
__device__ __forceinline__ void xcd_barrier(const XcdBarrier& b) {
    asm volatile("s_waitcnt vmcnt(0)" ::: "memory");
    __syncthreads();
    if (threadIdx.x == 0) {
        unsigned* bar = b.bar;
        __builtin_amdgcn_s_waitcnt(0);
        unsigned nloc = b.st[0], nx = b.st[1];
        if (nloc == 0u) { xcd_barrier_complete(bar, b.x, nloc, nx); b.st[0] = nloc; b.st[1] = nx; }
        const unsigned old = xb_add(&bar[XB_XSUB(b.x)], 1u);
        const unsigned gen = old / nloc;
        if (old + 1u == (gen + 1u) * nloc) {
            __builtin_amdgcn_fence(__ATOMIC_RELEASE, "agent");
            asm volatile("s_waitcnt vmcnt(0)" ::: "memory");
            const unsigned og = xb_add(&bar[XB_TOP], 1u);
            const unsigned tg = og / nx;
            if (og + 1u == (tg + 1u) * nx) xb_add(&bar[XB_TOPGEN], 1u);
            else XB_SPIN(xb_ld(&bar[XB_TOPGEN]) == tg, bar);
            __builtin_amdgcn_fence(__ATOMIC_ACQUIRE, "agent");
            xb_add(&bar[XB_XGEN(b.x)], 1u);
            asm volatile("s_waitcnt vmcnt(0)" ::: "memory");
        } else {
            XB_SPIN(xb_ld(&bar[XB_XGEN(b.x)]) == gen, bar);
            __builtin_amdgcn_fence(__ATOMIC_ACQUIRE, "agent");
            asm volatile("s_waitcnt vmcnt(0)" ::: "memory");
        }
    }
    __syncthreads();
}

struct Frame {
    LAS unsigned char* lds;
    volatile LAS unsigned* MISC;
    gu32* ctl;
    int tid, lane, wave;
    int vcu, G;
};
struct Args { const float* in[28]; float* out; unsigned char* ws; int ph_lo, ph_hi, li, pad; };

__device__ __forceinline__ float wave_sum(float v) {
#pragma unroll
    for (int o = 1; o < 64; o <<= 1) v += __shfl_xor(v, o);
    return v;
}
__device__ __forceinline__ float wave_max(float v) {
#pragma unroll
    for (int o = 1; o < 64; o <<= 1) v = fmaxf(v, __shfl_xor(v, o));
    return v;
}

struct MapId { __device__ __forceinline__ int operator()(int n) const { return n; } };
struct MapGU { int half; __device__ __forceinline__ int operator()(int n) const { return (n >> 7) * 256 + half * 128 + (n & 127); } };
struct MapIn { __device__ __forceinline__ int operator()(int n) const { return n < 2120 ? n : n + 184; } };
template <class RowMap>
__device__ __forceinline__ void p0_transpose_item(const float* W, int K, int N, h16* WT, RowMap rm, LAS float* scr, int item, int lane) {
    const int nblk = (N + 31) / 32, kb = item / nblk, nb = item % nblk, k0 = 64 * kb, n0 = 32 * nb;
    const int nl = n0 + (lane & 31);
#pragma unroll 8
    for (int i = 0; i < 32; ++i) { const int kk = 2 * i + (lane >> 5); scr[kk * 33 + (lane & 31)] = (nl < N) ? W[(size_t)(k0 + kk) * N + nl] : 0.f; }
    LDS_WAIT(); asm volatile("" ::: "memory");
    const int c = lane & 7;
#pragma unroll
    for (int j = 0; j < 4; ++j) { const int nn = (lane >> 3) + 8 * j; const LAS float* s = scr + (8 * c) * 33 + nn;
        v4u o; o.x = cvt_pk_h16(s[0 * 33], s[1 * 33]); o.y = cvt_pk_h16(s[2 * 33], s[3 * 33]); o.z = cvt_pk_h16(s[4 * 33], s[5 * 33]); o.w = cvt_pk_h16(s[6 * 33], s[7 * 33]);
        if (n0 + nn < N) *(GAS v4u*)(WT + (size_t)rm(n0 + nn) * K + k0 + 8 * c) = o; }
    LDS_WAIT(); asm volatile("" ::: "memory");
}

__device__ __forceinline__ void p0_prologue(Frame& F, const Args& A) {
    unsigned char* ws = A.ws;
    if (blockIdx.x < 36) {
        LAS float* sc = (LAS float*)(F.lds);
        LAS float* red = (LAS float*)(F.lds + 8192);
        const float* c = A.in[1];
        for (int i = F.tid; i < 2048; i += NTHR) { const float v = c[i]; sc[i] = v / (1.0f + __expf(-v)); }
        __syncthreads();
        const float* wa = A.in[2]; const int col = blockIdx.x * 256 + 4 * F.lane;
        f32x4 a0 = {0.f, 0.f, 0.f, 0.f}, a1 = {0.f, 0.f, 0.f, 0.f};
        const int kb = F.wave * 128;
#pragma unroll 8
        for (int k = 0; k < 128; ++k) { const f32x4 w = *(const f32x4*)(wa + (size_t)(kb + k) * 9216 + col); a0 += w * sc[kb + k]; a1 += w * sc[1024 + kb + k]; }
        *(LAS f32x4*)(red + (F.wave * 2 + 0) * 256 + 4 * F.lane) = a0; *(LAS f32x4*)(red + (F.wave * 2 + 1) * 256 + 4 * F.lane) = a1;
        __syncthreads();
        { const int b = F.tid >> 8, j = F.tid & 255; float s = 0.f;
#pragma unroll
          for (int w = 0; w < 8; ++w) s += red[(w * 2 + b) * 256 + j];
          const int cc = blockIdx.x * 256 + j; ((float*)(ws + WS_MOD))[b * 9216 + cc] = s + A.in[3][cc]; }
        __syncthreads();
    }
    LAS float* scr = (LAS float*)(F.lds + RING_OFF + F.wave * 16384);
    const int gw = F.vcu * NWAVES + F.wave, NGW = F.G * NWAVES;
    constexpr int I_GU = (D / 64) * (FF / 32), I_DN = (FF / 64) * (D / 32), I_IN = (D / 64) * ((DIN + 31) / 32), I_OUT = (D / 64) * (D / 32);
    constexpr int NITEMS = 6 * I_GU + I_IN + I_OUT; static_assert(I_GU == I_DN, "items");
    h16* W1GU = (h16*)(ws + WS_W1GU); h16* W1D = (h16*)(ws + WS_W1D); h16* WIN = (h16*)(ws + WS_WIN); h16* WOUT = (h16*)(ws + WS_WOUT); h16* W2GU = (h16*)(ws + WS_W2GU); h16* W2D = (h16*)(ws + WS_W2D);
    for (int it = gw; it < NITEMS; it += NGW) {
        int r = it;
        if (r < I_GU) { p0_transpose_item(A.in[6], D, FF, W1GU, MapGU{0}, scr, r, F.lane); continue; } r -= I_GU;
        if (r < I_GU) { p0_transpose_item(A.in[7], D, FF, W1GU, MapGU{1}, scr, r, F.lane); continue; } r -= I_GU;
        if (r < I_DN) { p0_transpose_item(A.in[8], FF, D, W1D, MapId{}, scr, r, F.lane); continue; } r -= I_DN;
        if (r < I_IN) { p0_transpose_item(A.in[11], D, DIN, WIN, MapIn{}, scr, r, F.lane); continue; } r -= I_IN;
        if (r < I_OUT) { p0_transpose_item(A.in[22], D, D, WOUT, MapId{}, scr, r, F.lane); continue; } r -= I_OUT;
        if (r < I_GU) { p0_transpose_item(A.in[25], D, FF, W2GU, MapGU{0}, scr, r, F.lane); continue; } r -= I_GU;
        if (r < I_GU) { p0_transpose_item(A.in[26], D, FF, W2GU, MapGU{1}, scr, r, F.lane); continue; } r -= I_GU;
        p0_transpose_item(A.in[27], FF, D, W2D, MapId{}, scr, r, F.lane);
    }
    for (int tk = gw; tk < 128; tk += NGW) { const int s4 = tk & 3, jt = (tk >> 2) & 1, g = (tk >> 3) & 7, gate = tk >> 6; const float* W = A.in[gate ? 17 : 15]; const int r = F.lane & 31, hh = F.lane >> 5;
        float v[8];
#pragma unroll
        for (int e = 0; e < 8; ++e) v[e] = W[(g * 64 + 16 * s4 + 8 * hh + e) * 64 + 32 * jt + r];
        v4u o; o.x = cvt_pk_h16(v[0], v[1]); o.y = cvt_pk_h16(v[2], v[3]); o.z = cvt_pk_h16(v[4], v[5]); o.w = cvt_pk_h16(v[6], v[7]);
        *(GAS v4u*)(ws + WS_LRUW + ((size_t)tk * 64 + F.lane) * 16) = o; }
    for (int i = blockIdx.x * NTHR + F.tid; i < 184 * 128; i += F.G * NTHR) *(GAS v4u*)(WIN + (size_t)2120 * D + (size_t)i * 8) = (v4u){0u, 0u, 0u, 0u};
}

template <bool HAS_Y, bool HAS_H>
__device__ __forceinline__ void thin_phase(Frame& F, const float* mod, const float* yin, const float* gpost, float gscale, int mg,
                                           const float* xin, float* xout, const float* gpre, int msh, int msc, h16* hout) {
    LAS float* TA = (LAS float*)(F.lds); LAS float* TB = TA + 2048; LAS float* TC = TB + 2048;
    for (int i = F.tid; i < 2048; i += NTHR) { const int b = i >> 10, cidx = i & 1023;
        if (HAS_Y) TA[i] = gscale * mod[b * 9216 + mg * 1024 + cidx] * gpost[cidx];
        if (HAS_H) { TB[i] = gpre[cidx] * (1.0f + mod[b * 9216 + msc * 1024 + cidx]); TC[i] = mod[b * 9216 + msh * 1024 + cidx]; } }
    __syncthreads();
    const int gw = F.vcu * NWAVES + F.wave, NGW = F.G * NWAVES;
    for (int row = gw; row < M; row += NGW) {
        const int b = row >> 13;
        const GAS f32x4* xr = (const GAS f32x4*)(xin + (size_t)row * D) + F.lane;
        f32x4 x[4];
#pragma unroll
        for (int j = 0; j < 4; ++j) x[j] = xr[64 * j];
        if (HAS_Y) {
            const GAS f32x4* yr = (const GAS f32x4*)(yin + (size_t)row * D) + F.lane;
            f32x4 y[4]; float s = 0.f;
#pragma unroll
            for (int j = 0; j < 4; ++j) { y[j] = yr[64 * j]; s += (y[j].x * y[j].x + y[j].y * y[j].y) + (y[j].z * y[j].z + y[j].w * y[j].w); }
            const float rstd = 1.0f / sqrtf(wave_sum(s) * (1.0f / D) + EPS);
            GAS f32x4* xo = (GAS f32x4*)(xout + (size_t)row * D) + F.lane;
#pragma unroll
            for (int j = 0; j < 4; ++j) { const f32x4 ta = *(const LAS f32x4*)(TA + b * 1024 + 4 * F.lane + 256 * j); x[j] = x[j] + ta * (y[j] * rstd); xo[64 * j] = x[j]; }
        }
        if (HAS_H) {
            float s = 0.f;
#pragma unroll
            for (int j = 0; j < 4; ++j) s += (x[j].x * x[j].x + x[j].y * x[j].y) + (x[j].z * x[j].z + x[j].w * x[j].w);
            const float rstd = 1.0f / sqrtf(wave_sum(s) * (1.0f / D) + EPS);
            GAS v2u* ho = (GAS v2u*)(hout + (size_t)row * D) + F.lane;
#pragma unroll
            for (int j = 0; j < 4; ++j) { const f32x4 tb = *(const LAS f32x4*)(TB + b * 1024 + 4 * F.lane + 256 * j), tc = *(const LAS f32x4*)(TC + b * 1024 + 4 * F.lane + 256 * j);
                const f32x4 h = (x[j] * rstd) * tb + tc; v2u o; o.x = cvt_pk_h16(h.x, h.y); o.y = cvt_pk_h16(h.z, h.w); ho[64 * j] = o; }
        }
    }
    __syncthreads();
}

__device__ __forceinline__ float gelu_tanh(float x) { const float u = 0.7978845608028654f * (x + 0.044715f * x * x * x); const float e = __builtin_amdgcn_exp2f(2.0f * 1.4426950408889634f * u); const float t = 1.0f - 2.0f * __builtin_amdgcn_rcpf(e + 1.0f); return 0.5f * x * (1.0f + t); }
__device__ __forceinline__ float fast_sigmoid(float z) { return __builtin_amdgcn_rcpf(1.0f + __builtin_amdgcn_exp2f(-1.4426950408889634f * z)); }
__device__ __forceinline__ float lane_partner(float x, int hh) { auto rr = __builtin_amdgcn_permlane32_swap(__float_as_uint(x), __float_as_uint(x), false, false); return __uint_as_float(hh ? rr[0] : rr[1]); }
typedef float f32x16 __attribute__((ext_vector_type(16)));
__device__ __forceinline__ int crow(int r, int hi) { return (r & 3) + 8 * (r >> 2) + 4 * hi; }
constexpr int LL_XC = 0, LL_OUT = 32768, LL_CAR = 131072 + 1024;
template <bool PASS_B>
__device__ __forceinline__ void lru_phase(Frame& F, const Args& A) {
    unsigned char* ws = A.ws;
    const h16* LRU = (const h16*)(ws + WS_LRU); float* SA = (float*)(ws + WS_LRUS); float* SB = SA + BATCH * NLCH * DLRU;
    h16* MERGED = (h16*)(ws + WS_MERGED);
    int tid_o = F.tid; asm volatile("" : "+v"(tid_o));
    const int tid = tid_o, lane = tid & 63, g = F.wave, r = lane & 31, hh = lane >> 5;
    LAS unsigned char* XC = F.lds + LL_XC; LAS float* OUT = (LAS float*)(F.lds + LL_OUT); LAS float* CAR = (LAS float*)(F.lds + LL_CAR);
    const h16x8* LW = (const h16x8*)(ws + WS_LRUW);
    float ba[2], bi[2], sp8[2];
#pragma unroll
    for (int jt = 0; jt < 2; ++jt) { const int ch = g * 64 + 32 * jt + r; ba[jt] = A.in[16][ch]; bi[jt] = A.in[18][ch]; const float lam = A.in[19][ch]; sp8[jt] = 8.0f * ((lam < -15.f) ? -lam : log1pf(__expf(-lam))); }
    for (int p = blockIdx.x; p < 256; p += F.G) {
#pragma unroll 1
        for (int uu = 0; uu < 2; ++uu) {
            const int b = p >> 7, c = uu ? 255 - (p & 127) : (p & 127), t0 = c * LCH;
            const h16* xb = LRU + (size_t)(b * SEQ) * 1024;
            __syncthreads();
            { h16x8 xr[7]; f32x4 cwv[4][2], cbv[2];
              cbv[0] = *(const f32x4*)(A.in[14] + 8 * lane); cbv[1] = *(const f32x4*)(A.in[14] + 8 * lane + 4);
#pragma unroll
              for (int jx = 0; jx < 4; ++jx) { cwv[jx][0] = *(const f32x4*)(A.in[13] + jx * DLRU + 8 * lane); cwv[jx][1] = *(const f32x4*)(A.in[13] + jx * DLRU + 8 * lane + 4); }
#pragma unroll
              for (int k = 0; k < 7; ++k) { const int t = t0 + 4 * g - 3 + k; if (t >= 0) xr[k] = *(const h16x8*)(xb + (size_t)t * 1024 + 8 * lane); else xr[k] = (h16x8){0, 0, 0, 0, 0, 0, 0, 0}; }
#pragma unroll
              for (int tt = 0; tt < 4; ++tt) { float v[8];
#pragma unroll
                  for (int e = 0; e < 8; ++e) v[e] = cbv[e >> 2][e & 3] + (float)xr[tt][e] * cwv[0][e >> 2][e & 3] + (float)xr[tt + 1][e] * cwv[1][e >> 2][e & 3] + (float)xr[tt + 2][e] * cwv[2][e >> 2][e & 3] + (float)xr[tt + 3][e] * cwv[3][e >> 2][e & 3];
                  v4u o; o.x = cvt_pk_h16(v[0], v[1]); o.y = cvt_pk_h16(v[2], v[3]); o.z = cvt_pk_h16(v[4], v[5]); o.w = cvt_pk_h16(v[6], v[7]);
                  const int row = 4 * g + tt; *(LAS v4u*)(XC + row * 1024 + ((lane ^ (row & 7)) << 4)) = o; } }
            if (PASS_B) { float H = 0.f; const float* pa = SA + (size_t)(b * NLCH) * DLRU + tid; const float* pb = SB + (size_t)(b * NLCH) * DLRU + tid;
#pragma unroll 16
                for (int cc = 0; cc < c; ++cc) H = pa[(size_t)cc * DLRU] * H + pb[(size_t)cc * DLRU];
                CAR[tid] = H; }
            __syncthreads();
            h16x8 af[4];
#pragma unroll
            for (int s = 0; s < 4; ++s) af[s] = *(const LAS h16x8*)(XC + r * 1024 + (((g * 8 + 2 * s + hh) ^ (r & 7)) << 4));
#pragma unroll
            for (int jt = 0; jt < 2; ++jt) {
                float gt[16];
                if (PASS_B) {
#pragma unroll
                    for (int i = 0; i < 16; ++i) gt[i] = (float)xb[(size_t)(t0 + crow(i, hh)) * 1024 + 512 + g * 64 + 32 * jt + r]; }
                float av[16], bv[16];
                const int ch = g * 64 + 32 * jt + r;
                {   h16x8 wf[4];
#pragma unroll
                    for (int s = 0; s < 4; ++s) wf[s] = LW[(((0 * 8 + g) * 2 + jt) * 4 + s) * 64 + lane];
                    f32x16 za = {};
#pragma unroll
                    for (int s = 0; s < 4; ++s) za = __builtin_amdgcn_mfma_f32_32x32x16_f16(af[s], wf[s], za, 0, 0, 0);
#pragma unroll
                    for (int i = 0; i < 16; ++i) { const float rg = fast_sigmoid(za[i] + ba[jt]); const float la = -sp8[jt] * rg, y = 2.0f * la;
                        const float em = (y > -0.03f) ? -y * (1.0f + y * (0.5f + y * (0.16666667f + y * 0.041666668f))) : 1.0f - __expf(y);
                        av[i] = __expf(la); bv[i] = __builtin_amdgcn_sqrtf(em); } }
                {   h16x8 wf[4];
#pragma unroll
                    for (int s = 0; s < 4; ++s) wf[s] = LW[(((1 * 8 + g) * 2 + jt) * 4 + s) * 64 + lane];
                    f32x16 zi = {};
#pragma unroll
                    for (int s = 0; s < 4; ++s) zi = __builtin_amdgcn_mfma_f32_32x32x16_f16(af[s], wf[s], zi, 0, 0, 0);
#pragma unroll
                    for (int i = 0; i < 16; ++i) { const int t = crow(i, hh); const float ig = fast_sigmoid(zi[i] + bi[jt]);
                        const float xcv = (float)*(const LAS h16*)(XC + t * 1024 + ((((ch >> 3)) ^ (t & 7)) << 4) + (ch & 7) * 2);
                        bv[i] *= ig * xcv; } }
                float GA[4], GB[4];
#pragma unroll
                for (int k = 0; k < 4; ++k) { float Ak = av[4 * k], Bk = bv[4 * k];
#pragma unroll
                    for (int e = 1; e < 4; ++e) { Bk = av[4 * k + e] * Bk + bv[4 * k + e]; Ak *= av[4 * k + e]; }
                    GA[k] = Ak; GB[k] = Bk; }
                float state = PASS_B ? CAR[ch] : 0.f; float cin[4];
#pragma unroll
                for (int k = 0; k < 4; ++k) { const float out0 = GA[k] * state + GB[k]; const float p0 = lane_partner(out0, hh); const float in1 = hh ? p0 : state; cin[k] = in1;
                    const float out1 = GA[k] * in1 + GB[k]; const float p1 = lane_partner(out1, hh); state = hh ? out1 : p1; }
                if (!PASS_B) { float P = (GA[0] * GA[1]) * (GA[2] * GA[3]); P *= lane_partner(P, hh);
                    if (hh == 0) { SA[(size_t)(b * NLCH + c) * DLRU + ch] = P; SB[(size_t)(b * NLCH + c) * DLRU + ch] = state; } }
                else {
#pragma unroll
                    for (int k = 0; k < 4; ++k) { float h = cin[k];
#pragma unroll
                        for (int e = 0; e < 4; ++e) { const int i = 4 * k + e; h = av[i] * h + bv[i]; OUT[crow(i, hh) * 512 + ch] = h * gelu_tanh(gt[i]); } } }
            }
            if (PASS_B) {
                __syncthreads();
#pragma unroll
                for (int k = 0; k < 4; ++k) { const int tt = 4 * g + k;
                    const f32x4 o0 = *(const LAS f32x4*)(OUT + tt * 512 + 8 * lane), o1 = *(const LAS f32x4*)(OUT + tt * 512 + 8 * lane + 4);
                    const float s = (o0.x * o0.x + o0.y * o0.y) + (o0.z * o0.z + o0.w * o0.w) + (o1.x * o1.x + o1.y * o1.y) + (o1.z * o1.z + o1.w * o1.w);
                    const float rstd = 1.0f / sqrtf(wave_sum(s) * (1.0f / DLRU) + EPS);
                    const f32x4 g0 = *(const f32x4*)(A.in[21] + 8 * lane), g1 = *(const f32x4*)(A.in[21] + 8 * lane + 4);
                    v4u o; o.x = cvt_pk_h16(o0.x * rstd * g0.x, o0.y * rstd * g0.y); o.y = cvt_pk_h16(o0.z * rstd * g0.z, o0.w * rstd * g0.w);
                    o.z = cvt_pk_h16(o1.x * rstd * g1.x, o1.y * rstd * g1.y); o.w = cvt_pk_h16(o1.z * rstd * g1.z, o1.w * rstd * g1.w);
                    *(GAS v4u*)(MERGED + (size_t)(b * SEQ + t0 + tt) * 1024 + 512 + 8 * lane) = o; }
            }
        }
    }
}

constexpr int IDX_CAP = 128;
constexpr int IL_QL = 0, IL_WL = 36864, IL_INFO = 37888, IL_CNT = 38400, IL_PS = 38912, IL_HIST = 65536, IL_CAND = 65536, IL_SCR = 98304;
constexpr int SL_SCORE = 65536, SL_HIST = 98304, SL_CTL = 99328;
__device__ __forceinline__ unsigned ord_key(float f) { const unsigned u = __float_as_uint(f); return u ^ ((u >> 31) ? 0xFFFFFFFFu : 0x80000000u); }
__device__ __forceinline__ int t5_bucket(int rel) {
    const int n = rel < 0 ? -rel : rel; int large;
    if (n < 12) large = 8; else if (n < 16) large = 9; else if (n < 23) large = 10; else if (n < 32) large = 11; else if (n < 46) large = 12; else if (n < 64) large = 13; else if (n < 91) large = 14; else large = 15;
    return (rel > 0 ? 16 : 0) + (n < 8 ? n : large);
}
#define IDX_FMA_ABS(s_, x_, w_) asm("v_fma_f32 %0, |%1|, %2, %0" : "+v"(s_) : "v"(x_), "v"(w_))
__device__ __forceinline__ void idx_scores(f32x16 (&S)[2], const h16x8 (&a)[2][4], const LAS unsigned char* ql, int foff, int sw, int hh, const LAS float* wl) {
    {   h16x8 qf[4];
#pragma unroll
        for (int s = 0; s < 4; ++s) qf[s] = *(const LAS h16x8*)(ql + 8 * 4096 + foff + (((2 * s + hh) ^ sw) << 4));
#pragma unroll
        for (int sub = 0; sub < 2; ++sub) { f32x16 acc = {};
#pragma unroll
            for (int s = 0; s < 4; ++s) acc = __builtin_amdgcn_mfma_f32_32x32x16_f16(a[sub][s], qf[s], acc, 0, 0, 0);
            S[sub] = acc; } }
#pragma unroll 1
    for (int h = 0; h < 8; ++h) {
        h16x8 qf[4]; const float wh = wl[h];
#pragma unroll
        for (int s = 0; s < 4; ++s) qf[s] = *(const LAS h16x8*)(ql + h * 4096 + foff + (((2 * s + hh) ^ sw) << 4));
        f32x16 acc0 = {}, acc1 = {};
#pragma unroll
        for (int s = 0; s < 4; ++s) acc0 = __builtin_amdgcn_mfma_f32_32x32x16_f16(a[0][s], qf[s], acc0, 0, 0, 0);
#pragma unroll
        for (int s = 0; s < 4; ++s) acc1 = __builtin_amdgcn_mfma_f32_32x32x16_f16(a[1][s], qf[s], acc1, 0, 0, 0);
        asm volatile("s_nop 15" : "+v"(acc0), "+v"(S[0]));
#pragma unroll
        for (int i = 0; i < 16; ++i) IDX_FMA_ABS(S[0][i], acc0[i], wh);
        asm volatile("s_nop 15" : "+v"(acc1), "+v"(S[1]));
#pragma unroll
        for (int i = 0; i < 16; ++i) IDX_FMA_ABS(S[1][i], acc1[i], wh);
    }
    asm volatile("s_nop 1" : "+v"(S[0]), "+v"(S[1]));
}
__device__ __forceinline__ void idx_phase(Frame& F, const Args& A) {
    unsigned char* ws = A.ws;
    const h16* QS = (const h16*)(ws + WS_QS); const h16* KI = (const h16*)(ws + WS_KI); const float* WI = (const float*)(ws + WS_WI);
    unsigned* MASK = (unsigned*)(ws + WS_MASK);
    LAS unsigned char* L = F.lds;
    int tid_o = F.tid; asm volatile("" : "+v"(tid_o));
    const int tid = tid_o, lane = tid & 63, wave = F.wave, r = lane & 31, hh = lane >> 5;
    LAS float* WL = (LAS float*)(L + IL_WL); LAS int* INFO = (LAS int*)(L + IL_INFO); LAS unsigned* CNT = (LAS unsigned*)(L + IL_CNT);
    LAS unsigned* HIST = (LAS unsigned*)(L + IL_HIST);
    for (int p = blockIdx.x; p < 256; p += F.G) {
        const int b = p >> 7, jj = p & 127;
        for (int uu = 0; uu < 2; ++uu) {
            const int j = uu ? 255 - jj : jj;
            const int q0 = 32 * j, rowb = b * SEQ + q0, N = ((j >> 1) + 1) * 64, NC = N >> 6;
            unsigned* mrow = MASK + ((size_t)(b * 128) * 8192 + q0) * 2;
            if (N <= TOPK) {
                for (int i = tid; i < NC * 64; i += NTHR) mrow[(size_t)(i >> 6) * 16384 + (i & 63)] = 0xFFFFFFFFu;
                continue;
            }
            __syncthreads();
#pragma unroll
            for (int i = 0; i < 4; ++i) { const int idx = tid + NTHR * i, q = idx >> 6, cc = idx & 63, head = cc >> 3, c8 = cc & 7;
                const v4u v = *(const GAS v4u*)(QS + (size_t)(rowb + q) * 512 + cc * 8);
                *(LAS v4u*)(L + IL_QL + head * 4096 + q * 128 + ((c8 ^ (q & 7)) << 4)) = v; }
            if (tid < 256) WL[tid] = WI[(size_t)rowb * 8 + tid];
            for (int i = tid; i < 16384; i += NTHR) HIST[i] = 0u;
            if (tid < 32) CNT[tid] = 0u;
            __syncthreads();
            { const int q = tid >> 4, dg = tid & 15, c8 = dg >> 1; float a0 = 0.f, a1 = 0.f, a2 = 0.f, a3 = 0.f;
              const int o = q * 128 + ((c8 ^ (q & 7)) << 4) + (dg & 1) * 8;
#pragma unroll
              for (int h = 0; h < 8; ++h) { const h16x4 v = *(const LAS h16x4*)(L + IL_QL + h * 4096 + o); const float wv = WL[q * 8 + h];
                  a0 += wv * (float)v[0]; a1 += wv * (float)v[1]; a2 += wv * (float)v[2]; a3 += wv * (float)v[3]; }
              v2u pk; pk.x = cvt_pk_h16(a0, a1); pk.y = cvt_pk_h16(a2, a3); *(LAS v2u*)(L + IL_QL + 8 * 4096 + o) = pk; }
            __syncthreads();
            const LAS float* w = WL + r * 8;
            const int foff = r * 128, sw = r & 7;
            const h16* kbase = KI + (size_t)(b * SEQ) * 64 + (size_t)r * 64 + 8 * hh;
            const LAS unsigned char* ql = L + IL_QL;
#define IDX_LOADA(dst, c) do { _Pragma("unroll") for (int sub_ = 0; sub_ < 2; ++sub_) _Pragma("unroll") for (int s_ = 0; s_ < 4; ++s_) \
                dst[sub_][s_] = *(const h16x8*)(kbase + (size_t)(64 * (c) + 32 * sub_) * 64 + 16 * s_); } while (0)
            h16x8 a[2][4]; f32x16 S[2];
            IDX_LOADA(a, 0); idx_scores(S, a, ql, foff, sw, hh, w);
            float s1 = 0.f, s2 = 0.f;
#pragma unroll
            for (int sub = 0; sub < 2; ++sub)
#pragma unroll
                for (int i = 0; i < 16; ++i) { s1 += S[sub][i]; s2 += S[sub][i] * S[sub][i]; }
            s1 += __shfl_xor(s1, 32); s2 += __shfl_xor(s2, 32);
            const float mean = s1 * (1.0f / 64.0f), sd = sqrtf(fmaxf(s2 * (1.0f / 64.0f) - mean * mean, 1e-30f));
            const float inv_w = 510.0f / (8.0f * sd), off = 1.0f - (mean - 3.0f * sd) * inv_w;
            { int c = wave; if (c < NC) IDX_LOADA(a, c);
              for (; c < NC; c += 8) {
                idx_scores(S, a, ql, foff, sw, hh, w);
                if (c + 8 < NC) IDX_LOADA(a, c + 8);
#pragma unroll
                for (int sub = 0; sub < 2; ++sub)
#pragma unroll
                    for (int i = 0; i < 16; ++i) { const float f = floorf(__builtin_fmaf(S[sub][i], inv_w, off)); const int bin = (int)fminf(fmaxf(f, 0.f), 511.f);
                        __hip_atomic_fetch_add(HIST + bin * 32 + r, 1u, __ATOMIC_RELAXED, __HIP_MEMORY_SCOPE_WORKGROUP); }
              } }
            __syncthreads();
            { LAS unsigned* PS = (LAS unsigned*)(L + IL_PS); const int rg = wave * 2 + hh; unsigned sum = 0u;
#pragma unroll
              for (int k = 0; k < 32; ++k) sum += HIST[(rg * 32 + k) * 32 + r];
              PS[rg * 32 + r] = sum;
              __syncthreads();
              if (wave == 0 && hh == 0) { const int q = r; unsigned cum = 0u; int rsel = 0; unsigned ps[16];
#pragma unroll
                  for (int k = 0; k < 16; ++k) ps[k] = PS[k * 32 + q];
                  bool found = false; unsigned above = 0u;
#pragma unroll
                  for (int k = 15; k >= 0; --k) { if (!found) { if (cum + ps[k] >= (unsigned)TOPK) { found = true; rsel = k; above = cum; } else cum += ps[k]; } }
                  int bsel = -1; unsigned cb = 0u, ca = 0u; cum = above;
                  for (int k = 31; k >= 0; --k) { const unsigned cn = HIST[(rsel * 32 + k) * 32 + q]; if (bsel < 0) { if (cum + cn >= (unsigned)TOPK) { bsel = rsel * 32 + k; cb = cn; ca = cum; } else cum += cn; } }
                  int slow = (!found || bsel <= 0 || bsel >= 511 || cb > (unsigned)IDX_CAP) ? 1 : 0;
#ifdef IDX_FORCE_SLOW
                  if (((rowb + q) % 251) == 0) slow = 1;
#endif
                  INFO[q * 4 + 0] = bsel; INFO[q * 4 + 1] = TOPK - (int)ca; INFO[q * 4 + 2] = slow; }
            }
            __syncthreads();
            const float blo = (float)INFO[r * 4 + 0], bhi = blo + 1.0f;
            LAS float* scr = (LAS float*)(L + IL_SCR + wave * 4096);
            LAS unsigned* cand = (LAS unsigned*)(L + IL_CAND);
            { int c = wave; if (c < NC) IDX_LOADA(a, c);
            for (; c < NC; c += 8) {
                idx_scores(S, a, ql, foff, sw, hh, w);
                if (c + 8 < NC) IDX_LOADA(a, c + 8);
                unsigned selw = 0u, cndw = 0u;
#pragma unroll
                for (int sub = 0; sub < 2; ++sub)
#pragma unroll
                    for (int i = 0; i < 16; ++i) { const float f = __builtin_fmaf(S[sub][i], inv_w, off); selw = selw * 2u + (f >= bhi ? 1u : 0u); cndw = cndw * 2u + (f >= blo ? 1u : 0u); }
                selw = (selw >> 16) | (selw << 16); cndw = (cndw >> 16) | (cndw << 16);
                mrow[(size_t)c * 16384 + (r * 2 + hh)] = selw;
                unsigned rem = cndw & ~selw;
                if (__any(rem != 0u)) {
#pragma unroll
                    for (int sub = 0; sub < 2; ++sub) {
                        LDS_WAIT();
#pragma unroll
                        for (int i = 0; i < 16; ++i) scr[i * 64 + lane] = S[sub][i];
                        LDS_WAIT();
                        unsigned bits = (rem >> (16 * sub)) & 0xFFFFu;
                        while (bits) { const int bp = 31 - __clz((int)bits), i = 15 - bp; bits &= ~(1u << bp);
                            const float val = scr[i * 64 + lane]; const unsigned key = (unsigned)(64 * c + 32 * sub + crow(i, hh));
                            const unsigned pos = __hip_atomic_fetch_add(CNT + r, 1u, __ATOMIC_RELAXED, __HIP_MEMORY_SCOPE_WORKGROUP);
                            if (pos < (unsigned)IDX_CAP) { cand[(r * IDX_CAP + pos) * 2] = __float_as_uint(val); cand[(r * IDX_CAP + pos) * 2 + 1] = key; } }
                    }
                }
            } }
            VM_WAIT(); __syncthreads();
#pragma unroll 1
            for (int k = 0; k < 4; ++k) { const int q = 4 * wave + k; const unsigned cc = CNT[q]; const int need = INFO[q * 4 + 1];
                if (cc > (unsigned)IDX_CAP) { if (lane == 0) INFO[q * 4 + 2] = 1; continue; }
                if (INFO[q * 4 + 2]) continue;
                for (unsigned i = lane; i < cc; i += 64) { const float si = __uint_as_float(cand[(q * IDX_CAP + i) * 2]); const unsigned ki = cand[(q * IDX_CAP + i) * 2 + 1]; int rank = 0;
                    for (unsigned jx = 0; jx < cc; ++jx) { const float sj = __uint_as_float(cand[(q * IDX_CAP + jx) * 2]); const unsigned kj = cand[(q * IDX_CAP + jx) * 2 + 1]; rank += (sj > si || (sj == si && kj < ki)) ? 1 : 0; }
                    if (rank < need) { const unsigned c = ki >> 6, sub = (ki >> 5) & 1u, row = ki & 31u, hk = (row >> 2) & 1u, rr = (row & 3u) + 4u * (row >> 3);
                        __hip_atomic_fetch_or(mrow + (size_t)c * 16384 + (q * 2 + hk), 1u << (16u * sub + 15u - rr), __ATOMIC_RELAXED, __HIP_MEMORY_SCOPE_AGENT); } }
            }
            __syncthreads();
#pragma unroll 1
            for (int q = 0; q < 32; ++q) {
                if (!INFO[q * 4 + 2]) continue;
                LAS float* s_score = (LAS float*)(L + SL_SCORE); LAS unsigned* s_hist = (LAS unsigned*)(L + SL_HIST); LAS unsigned* s_ctl = (LAS unsigned*)(L + SL_CTL);
                __syncthreads();
                for (int s = tid; s < N; s += NTHR) {
                    const h16* kr = KI + (size_t)(b * SEQ + s) * 64; float kv[64];
#pragma unroll
                    for (int i = 0; i < 8; ++i) { const h16x8 t8 = *(const h16x8*)(kr + 8 * i);
#pragma unroll
                        for (int e = 0; e < 8; ++e) kv[8 * i + e] = (float)t8[e]; }
                    float sc = 0.f;
#pragma unroll 1
                    for (int h = 0; h < 9; ++h) { float d = 0.f;
#pragma unroll
                        for (int c8 = 0; c8 < 8; ++c8) { const h16x8 qv = *(const LAS h16x8*)(L + IL_QL + h * 4096 + q * 128 + ((c8 ^ (q & 7)) << 4));
#pragma unroll
                            for (int e = 0; e < 8; ++e) d += (float)qv[e] * kv[8 * c8 + e]; }
                        sc += (h == 8) ? d : fabsf(d) * WL[q * 8 + h]; }
                    s_score[s] = sc;
                }
                __syncthreads();
                unsigned prefix = 0u, msk = 0u, remaining = TOPK, n_eq = 0u;
                for (int pass = 0; pass < 4; ++pass) {
                    const int shift = 24 - 8 * pass;
                    if (tid < 256) s_hist[tid] = 0u;
                    __syncthreads();
                    for (int s = tid; s < N; s += NTHR) { const unsigned key = ord_key(s_score[s]); if ((key & msk) == prefix) __hip_atomic_fetch_add(s_hist + ((key >> shift) & 255u), 1u, __ATOMIC_RELAXED, __HIP_MEMORY_SCOPE_WORKGROUP); }
                    __syncthreads();
                    if (wave == 0) {
                        const unsigned h0 = s_hist[4 * lane], h1 = s_hist[4 * lane + 1], h2 = s_hist[4 * lane + 2], h3 = s_hist[4 * lane + 3];
                        unsigned v = h0 + h1 + h2 + h3;
#pragma unroll
                        for (int o = 1; o < 64; o <<= 1) { const unsigned tv = __shfl_down(v, o); if (lane + o < 64) v += tv; }
                        unsigned above = __shfl_down(v, 1); if (lane == 63) above = 0u;
                        if (v >= remaining && above < remaining) {
                            unsigned cum = above; int dsel; unsigned rem; unsigned hv;
                            if (cum + h3 >= remaining) { dsel = 3; rem = remaining - cum; hv = h3; }
                            else { cum += h3; if (cum + h2 >= remaining) { dsel = 2; rem = remaining - cum; hv = h2; }
                            else { cum += h2; if (cum + h1 >= remaining) { dsel = 1; rem = remaining - cum; hv = h1; }
                            else { cum += h1; dsel = 0; rem = remaining - cum; hv = h0; } } }
                            s_ctl[0] = (unsigned)(4 * lane + dsel); s_ctl[1] = rem; s_ctl[4] = hv; }
                    }
                    __syncthreads();
                    prefix |= s_ctl[0] << shift; msk |= 255u << shift; remaining = s_ctl[1]; n_eq = s_ctl[4];
                    __syncthreads();
                }
                const unsigned tu = (prefix & 0x80000000u) ? (prefix ^ 0x80000000u) : ~prefix; const float thr = __uint_as_float(tu);
                unsigned idx_cut = 0xFFFFFFFFu;
                if (n_eq > remaining) {
                    if (tid == 0) { unsigned cnt = 0, cut = 0; for (int s = 0; s < N; ++s) if (s_score[s] == thr) { ++cnt; if (cnt == remaining) { cut = (unsigned)s; break; } } s_ctl[3] = cut; }
                    __syncthreads();
                    idx_cut = s_ctl[3];
                }
                int i0 = tid; asm volatile("" : "+v"(i0));
                for (int i = i0; i < NC * 2; i += NTHR) { const int c = i >> 1, hk = i & 1; unsigned word = 0u;
#pragma unroll
                    for (int sub = 0; sub < 2; ++sub)
#pragma unroll
                        for (int rr = 0; rr < 16; ++rr) { const int key = 64 * c + 32 * sub + crow(rr, hk); const float sc = s_score[key];
                            if (sc > thr || (sc == thr && (unsigned)key <= idx_cut)) word |= 1u << (16 * sub + 15 - rr); }
                    mrow[(size_t)c * 16384 + (q * 2 + hk)] = word; }
                __syncthreads();
            }
#undef IDX_LOADA
        }
    }
}

namespace at {
typedef short s16x4 __attribute__((ext_vector_type(4)));
constexpr int NSLOT = 3, SLOTB = 8192;
constexpr int LDS_K = 0, LDS_V = NSLOT * SLOTB, LDS_WS = 2 * NSLOT * SLOTB, LDS_TB = LDS_WS + 8 * 256, LDS_OST = 53248, LDS_BYTES = LDS_OST + 8 * 4096;
constexpr float LOG2E = 1.4426950408889634f;
__device__ __forceinline__ void glds16(const void* gsrc, unsigned lds_dst) { unsigned keep;
    asm volatile("s_mov_b32 %0, m0\n\ts_mov_b32 m0, %2\n\ts_nop 0\n\tglobal_load_lds_dwordx4 %1, off\n\ts_mov_b32 m0, %0" : "=&s"(keep) : "v"(gsrc), "s"(lds_dst) : "memory"); }
#define AT_WAIT_BAR(N) asm volatile("s_waitcnt vmcnt(" #N ") lgkmcnt(0)\n\ts_barrier" ::: "memory")
__device__ __forceinline__ h16x8 vtr8(const LAS unsigned char* p0, const LAS unsigned char* p1) {
    const s16x4 lo = __builtin_amdgcn_ds_read_tr16_b64_v4i16((LAS s16x4*)p0), hi = __builtin_amdgcn_ds_read_tr16_b64_v4i16((LAS s16x4*)p1);
    typedef short s16x8 __attribute__((ext_vector_type(8)));
    const s16x8 v = {lo[0], lo[1], lo[2], lo[3], hi[0], hi[1], hi[2], hi[3]}; return __builtin_bit_cast(h16x8, v); }
__device__ __forceinline__ h16x8 pack8(const f32x16& p, int b) {
    v4u w; w.x = cvt_pk_h16(p[b], p[b + 1]); w.y = cvt_pk_h16(p[b + 2], p[b + 3]); w.z = cvt_pk_h16(p[b + 4], p[b + 5]); w.w = cvt_pk_h16(p[b + 6], p[b + 7]); return __builtin_bit_cast(h16x8, w); }

__device__ __forceinline__ void attn_unit(int b, int h, int qb, const h16* Q, const h16* K, const h16* V, const unsigned* MASK, const float* relb, h16* O, LAS unsigned char* shm) {
    int tid_o = threadIdx.x; asm volatile("" : "+v"(tid_o));
    const int tid = tid_o, lane = tid & 63, r32 = lane & 31, hi = lane >> 5; const int wid = __builtin_amdgcn_readfirstlane(tid >> 6);
    const long rowbase = (long)b * SEQ; const int q0 = qb * 256, qw = q0 + wid * 32, cq = qw >> 6, NT = 4 * qb + 4;
    const h16* Qw = Q + (rowbase + qw) * 512 + h * 64;
    const h16* Kh = K + rowbase * 512 + h * 64; const h16* Vh = V + rowbase * 512 + h * 64;
    const unsigned lds0 = (unsigned)(uintptr_t)shm;
    LAS float* wsf = (LAS float*)(shm + LDS_WS) + wid * 64;
    LAS float* Tb = (LAS float*)(shm + LDS_TB);
    const h16* ksrc = Kh + (long)lane * 512 + wid * 8;
    const h16* vsrc = Vh + (long)(16 * (wid & 3) + (lane >> 2)) * 512 + (wid >> 2) * 32 + (lane & 3) * 8;
    const unsigned kdst = lds0 + LDS_K + wid * 1024, vdst = lds0 + LDS_V + wid * 1024;
#define AT_DMA_K(t, slot) glds16(ksrc + (long)(t) * 64 * 512, (unsigned)__builtin_amdgcn_readfirstlane(kdst + (slot)))
#define AT_DMA_V(t, slot) glds16(vsrc + (long)(t) * 64 * 512, (unsigned)__builtin_amdgcn_readfirstlane(vdst + (slot)))
    AT_DMA_K(0, 0); AT_DMA_V(0, 0); AT_DMA_K(1, SLOTB); AT_DMA_V(1, SLOTB);
    if (tid < 255) Tb[tid] = relb[t5_bucket(tid - 191) * 8 + h] * LOG2E;
    const float b15l = relb[15 * 8 + h] * LOG2E;
    h16x8 qr[4];
#pragma unroll
    for (int d0 = 0; d0 < 4; ++d0) qr[d0] = *(const h16x8*)(Qw + (long)r32 * 512 + d0 * 16 + hi * 8);
    const unsigned* mk = MASK + ((size_t)(b * 128) * 8192 + (qw + r32)) * 2 + hi;
    const LAS unsigned char* kp0 = shm + LDS_K + hi * 1024 + r32 * 16;
    const LAS unsigned char* vp0 = shm + LDS_V + ((lane >> 4) & 1) * 32 + (lane & 3) * 8 + (4 * hi + ((lane & 15) >> 2)) * 64;
    f32x16 o[2]; o[0] = f32x16{}; o[1] = f32x16{};
    float m = -1e30f, l = 0.f;
    int slot = 0, slot2 = 2 * SLOTB;
#pragma unroll 1
    for (int t = 0; t < NT; ++t) {
        if (t + 1 < NT) { AT_WAIT_BAR(2); } else { AT_WAIT_BAR(0); }
        if (t + 2 < NT) { AT_DMA_K(t + 2, slot2); AT_DMA_V(t + 2, slot2); }
        if (t <= cq) {
            const unsigned mw = mk[(size_t)t * 16384];
            const bool nearb = (t >= cq - 2);
            const float c0 = nearb ? 0.f : b15l;
            f32x16 p0, p1;
#pragma unroll
            for (int r = 0; r < 16; ++r) { p0[r] = c0; p1[r] = c0; }
            const LAS unsigned char* kb = kp0 + slot;
#pragma unroll
            for (int d0 = 0; d0 < 4; ++d0) { const h16x8 k0 = *(const LAS h16x8*)(kb + d0 * 2048), k1 = *(const LAS h16x8*)(kb + d0 * 2048 + 512);
                p0 = __builtin_amdgcn_mfma_f32_32x32x16_f16(k0, qr[d0], p0, 0, 0, 0); p1 = __builtin_amdgcn_mfma_f32_32x32x16_f16(k1, qr[d0], p1, 0, 0, 0); }
            if (nearb) { const int ib = 64 * t - (qw + r32) + 191 + 4 * hi;
#pragma unroll
                for (int r = 0; r < 16; ++r) { const int kk = (r & 3) + 8 * (r >> 2); p0[r] += Tb[ib + kk]; p1[r] += Tb[ib + 32 + kk]; } }
#pragma unroll
            for (int r = 0; r < 16; ++r) { p0[r] = ((mw >> (15 - r)) & 1u) ? p0[r] : -INFINITY; p1[r] = ((mw >> (31 - r)) & 1u) ? p1[r] : -INFINITY; }
            float mx = fmaxf(p0[0], p1[0]);
#pragma unroll
            for (int r = 1; r < 16; ++r) mx = fmaxf(mx, fmaxf(p0[r], p1[r]));
            { auto rr = __builtin_amdgcn_permlane32_swap(__float_as_uint(mx), __float_as_uint(mx), false, false); mx = fmaxf(__uint_as_float(rr[0]), __uint_as_float(rr[1])); }
            const float mn = fmaxf(m, mx), alpha = __builtin_amdgcn_exp2f(m - mn); m = mn;
            float ps = 0.f;
#pragma unroll
            for (int r = 0; r < 16; ++r) { p0[r] = __builtin_amdgcn_exp2f(p0[r] - mn); p1[r] = __builtin_amdgcn_exp2f(p1[r] - mn); ps += p0[r] + p1[r]; }
            l = l * alpha + ps;
            if (!__all(alpha == 1.0f)) {
                if (hi == 0) wsf[r32] = alpha;
                LDS_WAIT();
#pragma unroll
                for (int r = 0; r < 16; ++r) { const float f = wsf[crow(r, hi)]; o[0][r] *= f; o[1][r] *= f; }
            }
            const h16x8 pa0 = pack8(p0, 0), pa1 = pack8(p0, 8), pa2 = pack8(p1, 0), pa3 = pack8(p1, 8);
            const LAS unsigned char* vb = vp0 + slot;
#pragma unroll
            for (int d0 = 0; d0 < 2; ++d0) {
                const h16x8 v0 = vtr8(vb + d0 * 4096, vb + d0 * 4096 + 512), v1 = vtr8(vb + d0 * 4096 + 1024, vb + d0 * 4096 + 1024 + 512);
                const h16x8 v2 = vtr8(vb + d0 * 4096 + 2048, vb + d0 * 4096 + 2048 + 512), v3 = vtr8(vb + d0 * 4096 + 3072, vb + d0 * 4096 + 3072 + 512);
                o[d0] = __builtin_amdgcn_mfma_f32_32x32x16_f16(pa0, v0, o[d0], 0, 0, 0); o[d0] = __builtin_amdgcn_mfma_f32_32x32x16_f16(pa1, v1, o[d0], 0, 0, 0);
                o[d0] = __builtin_amdgcn_mfma_f32_32x32x16_f16(pa2, v2, o[d0], 0, 0, 0); o[d0] = __builtin_amdgcn_mfma_f32_32x32x16_f16(pa3, v3, o[d0], 0, 0, 0); }
        }
        slot2 = slot; slot = (slot == (NSLOT - 1) * SLOTB) ? 0 : slot + SLOTB;
    }
    { auto rr = __builtin_amdgcn_permlane32_swap(__float_as_uint(l), __float_as_uint(l), false, false); l = __uint_as_float(rr[0]) + __uint_as_float(rr[1]); }
    if (hi == 0) wsf[32 + r32] = l;
    LDS_WAIT();
    h16* Ow = O + (rowbase + qw) * 512 + h * 64;
    { LAS h16* stg = (LAS h16*)(shm + LDS_OST) + wid * 2048;
#pragma unroll
      for (int r = 0; r < 16; ++r) { const int orow = crow(r, hi); const float rl = 1.0f / wsf[32 + orow];
#pragma unroll
          for (int d0 = 0; d0 < 2; ++d0) stg[orow * 64 + d0 * 32 + r32] = (h16)(o[d0][r] * rl); }
      LDS_WAIT();
#pragma unroll
      for (int i = 0; i < 4; ++i) { const int row = i * 8 + (lane >> 3), ch = lane & 7; const v4u v = *(const LAS v4u*)(stg + row * 64 + ch * 8); *(GAS v4u*)(Ow + (long)row * 512 + ch * 8) = v; } }
    asm volatile("s_waitcnt lgkmcnt(0)\n\ts_barrier" ::: "memory");
#undef AT_DMA_K
#undef AT_DMA_V
}
__device__ __forceinline__ void attn_phase(Frame& F, const Args& A) {
    unsigned char* ws = A.ws;
    for (int v = F.vcu; v < 256; v += F.G) {
        const int bh = v >> 4, s = v & 15;
#pragma unroll 1
        for (int i = 0; i < 2; ++i) attn_unit(bh >> 3, bh & 7, i ? 31 - s : s, (const h16*)(ws + WS_Q), (const h16*)(ws + WS_K), (const h16*)(ws + WS_V), (const unsigned*)(ws + WS_MASK), A.in[12], (h16*)(ws + WS_O), F.lds + RING_OFF);
    }
}
#undef AT_WAIT_BAR
}

__device__ __forceinline__ void attn_norm_phase(Frame& F, const Args& A) {
    unsigned char* ws = A.ws; const h16* O = (const h16*)(ws + WS_O); h16* MERGED = (h16*)(ws + WS_MERGED);
    const f32x4 g0 = *(const f32x4*)(A.in[20] + 8 * F.lane), g1 = *(const f32x4*)(A.in[20] + 8 * F.lane + 4);
    const int gw = F.vcu * NWAVES + F.wave, NGW = F.G * NWAVES;
    for (int row = gw; row < M; row += NGW) {
        const h16x8 v = *(const h16x8*)(O + (size_t)row * 512 + 8 * F.lane); float f[8]; float s = 0.f;
#pragma unroll
        for (int e = 0; e < 8; ++e) { f[e] = (float)v[e]; s += f[e] * f[e]; }
        const float rstd = 1.0f / sqrtf(wave_sum(s) * (1.0f / DATT) + EPS);
        v4u o; o.x = cvt_pk_h16(f[0] * rstd * g0.x, f[1] * rstd * g0.y); o.y = cvt_pk_h16(f[2] * rstd * g0.z, f[3] * rstd * g0.w);
        o.z = cvt_pk_h16(f[4] * rstd * g1.x, f[5] * rstd * g1.y); o.w = cvt_pk_h16(f[6] * rstd * g1.z, f[7] * rstd * g1.w);
        *(GAS v4u*)(MERGED + (size_t)row * 1024 + 8 * F.lane) = o;
    }
}

__global__ void __launch_bounds__(NTHR, 2) fwd_kernel(Args args) {
    extern __shared__ __attribute__((aligned(16))) unsigned char lds[];
    Frame F;
    F.lds = (LAS unsigned char*)lds;
    F.MISC = (volatile LAS unsigned*)(F.lds + MISC_OFF);
    F.tid = threadIdx.x; F.lane = F.tid & 63; F.wave = __builtin_amdgcn_readfirstlane(F.tid >> 6);
    F.G = gridDim.x; { const int bx = blockIdx.x; F.vcu = (F.G % 8 == 0) ? (bx % 8) * (F.G / 8) + bx / 8 : bx; }
    unsigned char* ws = args.ws;
    F.ctl = (gu32*)(ws + WS_CTL);
    for (int u = F.tid; u < (LDS_BYTES - LDSCTL_OFF) / 4; u += NTHR) ((LAS unsigned*)(F.lds + LDSCTL_OFF))[u] = 0u;
    __syncthreads();
    XcdBarrier bar; bar.bar = (unsigned*)(F.ctl + CW_BAR); bar.x = 0; bar.st = nullptr;
    if (N_LAUNCHES == 1) bar = xcd_barrier_post((unsigned*)(F.ctl + CW_BAR), F.MISC + 8);
    const int lo = args.ph_lo, hi = args.ph_hi;
#define IN(k) (lo <= (k) && (k) < hi)
#define SEAM(k) do { if (IN(k) && IN((k) + 1)) xcd_barrier(bar); } while (0)
    const float* mod = (const float*)(ws + WS_MOD);
    h16* H = (h16*)(ws + WS_H); h16* ACT = (h16*)(ws + WS_ACT); float* Y = (float*)(ws + WS_Y);
    const int bx = (int)blockIdx.x;

    if (IN(0)) { p0_prologue(F, args); } SEAM(0);
    if (IN(1)) { thin_phase<false, true>(F, mod, nullptr, nullptr, 0.f, 0, args.in[0], nullptr, args.in[4], 0, 1, H); } SEAM(1);
    if (IN(2)) { pg8::Gemm g{H, (const h16*)(ws + WS_W1GU), M, NGU, D}; pg8::StaticOrder S; S.init(M, NGU, F.G, bx);
        pg8::EpiSwiGLU E{ACT, FF}; pg8::gemm_phase<pg8::EpiSwiGLU, pg8::StaticOrder, true>(F.lds + RING_OFF, g, S, E); } SEAM(2);
    if (IN(3)) { pg8::Gemm g{ACT, (const h16*)(ws + WS_W1D), M, D, FF}; pg8::StaticOrder S; S.init(M, D, F.G, bx);
        pg8::EpiF32 E{Y, D}; pg8::gemm_phase<pg8::EpiF32, pg8::StaticOrder, false>(F.lds + RING_OFF, g, S, E); } SEAM(3);
    if (IN(4)) { thin_phase<true, true>(F, mod, Y, args.in[5], 0.5f, 2, args.in[0], args.out, args.in[9], 3, 4, H); } SEAM(4);
    if (IN(5)) { pg8::Gemm g{H, (const h16*)(ws + WS_WIN), M, NPROJ, D}; pg8::StaticOrder S; S.init(M, NPROJ, F.G, bx);
        pg8::EpiProj E{ws + WS_Q, (size_t)(WS_K - WS_Q), (h16*)(ws + WS_QS), (h16*)(ws + WS_KI), (float*)(ws + WS_WI), (h16*)(ws + WS_LRU)};
        pg8::gemm_phase<pg8::EpiProj, pg8::StaticOrder, true>(F.lds + RING_OFF, g, S, E); } SEAM(5);
    if (IN(6)) { lru_phase<false>(F, args); } if (IN(6) && IN(7)) __syncthreads();
    if (IN(7)) { idx_phase(F, args); } SEAM(7);
    if (IN(8)) { lru_phase<true>(F, args); } if (IN(8) && IN(9)) __syncthreads();
    if (IN(9)) { at::attn_phase(F, args); } SEAM(9);
    if (IN(10)) { attn_norm_phase(F, args); } SEAM(10);
    if (IN(11)) { pg8::Gemm g{(const h16*)(ws + WS_MERGED), (const h16*)(ws + WS_WOUT), M, D, D}; pg8::StaticOrder S; S.init(M, D, F.G, bx);
        pg8::EpiF32 E{Y, D}; pg8::gemm_phase<pg8::EpiF32, pg8::StaticOrder, false>(F.lds + RING_OFF, g, S, E); } SEAM(11);
    if (IN(12)) { thin_phase<true, true>(F, mod, Y, args.in[10], 1.0f, 5, args.out, args.out, args.in[23], 6, 7, H); } SEAM(12);
    if (IN(13)) { pg8::Gemm g{H, (const h16*)(ws + WS_W2GU), M, NGU, D}; pg8::StaticOrder S; S.init(M, NGU, F.G, bx);
        pg8::EpiSwiGLU E{ACT, FF}; pg8::gemm_phase<pg8::EpiSwiGLU, pg8::StaticOrder, true>(F.lds + RING_OFF, g, S, E); } SEAM(13);
    if (IN(14)) { pg8::Gemm g{ACT, (const h16*)(ws + WS_W2D), M, D, FF}; pg8::StaticOrder S; S.init(M, D, F.G, bx);
        pg8::EpiF32 E{Y, D}; pg8::gemm_phase<pg8::EpiF32, pg8::StaticOrder, false>(F.lds + RING_OFF, g, S, E); } SEAM(14);
    if (IN(15)) { thin_phase<true, false>(F, mod, Y, args.in[24], 0.5f, 8, args.out, args.out, nullptr, 0, 0, nullptr); }
#undef IN
#undef SEAM
}

extern "C" void kernel_launch(void* const* d_in, const int* in_sizes, int n_in, void* d_out, int out_size, void* d_ws, size_t ws_size, hipStream_t stream) {
    static int grid = 0;
    if (grid == 0) {
        if (n_in != 28 || in_sizes[0] != M * D || out_size != M * D || ws_size < WS_END) { fprintf(stderr, "kernel_launch: unexpected shapes (n_in %d, in0 %d, out %d, ws %zu); nothing launched\n", n_in, n_in > 0 ? in_sizes[0] : -1, out_size, ws_size); grid = -1; return; }
        int dev = 0, cus = 0, per_cu = 0;
        if (hipGetDevice(&dev) != hipSuccess || hipDeviceGetAttribute(&cus, hipDeviceAttributeMultiprocessorCount, dev) != hipSuccess) { grid = -1; return; }
        if (hipFuncSetAttribute((const void*)fwd_kernel, hipFuncAttributeMaxDynamicSharedMemorySize, LDS_BYTES) != hipSuccess) { fprintf(stderr, "kernel_launch: hipFuncSetAttribute failed\n"); grid = -1; return; }
        if (hipOccupancyMaxActiveBlocksPerMultiprocessor(&per_cu, (const void*)fwd_kernel, NTHR, LDS_BYTES) != hipSuccess || per_cu < 1) { fprintf(stderr, "kernel_launch: occupancy query reports %d\n", per_cu); }
        (void)hipGetLastError();
        grid = cus;
    }
    if (grid < 0) return;
    if (hipMemsetAsync((char*)d_ws + WS_CTL, 0, CTL_ZERO_BYTES, stream) != hipSuccess) return;
    Args a{};
    for (int i = 0; i < 28; ++i) a.in[i] = (const float*)d_in[i];
    a.out = (float*)d_out; a.ws = (unsigned char*)d_ws;
    if (N_LAUNCHES == 1) { a.ph_lo = 0; a.ph_hi = N_PHASES; a.li = 0; hipLaunchKernelGGL(fwd_kernel, dim3(grid), dim3(NTHR), LDS_BYTES, stream, a); }
    else { for (int p = 0; p < N_PHASES; ++p) { a.ph_lo = p; a.ph_hi = p + 1; a.li = p; const int reps = (p == PROBE_PHASE) ? 2 : 1;
        for (int rr = 0; rr < reps; ++rr) hipLaunchKernelGGL(fwd_kernel, dim3(grid), dim3(NTHR), LDS_BYTES, stream, a); } }
}
```

```cpp
#include <hip/hip_runtime.h>
#include <cstdio>
#include <cstdint>

#ifndef PROBE_PHASE
#define PROBE_PHASE -1
#endif
#ifndef MK_N_LAUNCHES
#define MK_N_LAUNCHES 1
#endif

namespace pg8 {
#define PG8_LAS __attribute__((address_space(3)))
typedef _Float16 h16;
typedef _Float16 h16x8 __attribute__((ext_vector_type(8)));
typedef _Float16 h16x2 __attribute__((ext_vector_type(2)));
typedef float f32x4 __attribute__((ext_vector_type(4)));
typedef float f32x2 __attribute__((ext_vector_type(2)));
typedef unsigned u32x4 __attribute__((ext_vector_type(4)));
constexpr int BM = 256, BK = 64, HALF = 128, HTB = HALF * BK * 2, STAGE_BYTES = 8 * HTB, NXCD = 8, WGM = 8;

__host__ __device__ __forceinline__ int lds_byte(int r, int c) { const int st = (r >> 4) * 2 + (c >> 5), rr = r & 15, cc = c & 31, ob = rr * 64 + cc * 2; return st * 1024 + (ob ^ (((ob >> 9) & 1) << 5)); }
__host__ __device__ __forceinline__ void stage_rc(int b, int& R, int& C) { const int st = b / 1024, sb = b % 1024, swz = sb ^ (((sb >> 9) & 1) << 5); R = (st >> 1) * 16 + swz / 64; C = (st & 1) * 32 + (swz % 64) / 2; }
__host__ __device__ __forceinline__ int perm32(int rho) { const int n = rho >> 4, i = rho & 15; return 8 * (i >> 2) + 4 * n + (i & 3); }

struct Unit { int pm, pn; };
struct Gemm { const h16* A; const h16* Bt; int M, N, K; };

struct StaticOrder {
    int nM, nN, nwg, G, c;
    __host__ __device__ void init(int M, int N, int G_, int c_) { nM = M / BM; nN = N / BM; nwg = nM * nN; G = G_; c = c_; }
    __host__ __device__ bool next(int i, Unit& u) const {
        const long L = (long)i * G + c; if (L >= nwg) return false;
        int wgid = (int)L; { const int q = nwg / NXCD, r = nwg % NXCD, xcd = wgid % NXCD, off = wgid / NXCD; wgid = (xcd < r ? xcd * (q + 1) : r * (q + 1) + (xcd - r) * q) + off; }
        const int nig = WGM * nN, gid = wgid / nig, fm = gid * WGM, gsz = (nM - fm) < WGM ? (nM - fm) : WGM;
        u.pm = fm + ((wgid % nig) % gsz); u.pn = (wgid % nig) / gsz; return true;
    }
    __device__ __forceinline__ void a_ready(const Unit&) const {}
    __device__ __forceinline__ void done(const Unit&) const {}
};

__device__ __forceinline__ unsigned cvt_pk_h16(float lo, float hi) { f32x2 v = {lo, hi}; h16x2 h = __builtin_convertvector(v, h16x2); return __builtin_bit_cast(unsigned, h); }

struct EpiF32 {
    static constexpr bool PERM = false, AFTER_DRAIN = false;
    float* C; int ldc;
    __device__ __forceinline__ void operator()(const f32x4 (&acc)[2][2][4][2], const Unit& u, int wr, int wc, int fr, int fq) const {
        const int row0 = u.pm * BM + wr * 64 + fr, col0 = u.pn * BM + wc * 32 + 4 * fq;
#pragma unroll
        for (int ai = 0; ai < 2; ++ai)
#pragma unroll
            for (int m = 0; m < 4; ++m) { float* rowp = C + (size_t)(row0 + ai * HALF + m * 16) * ldc + col0;
#pragma unroll
                for (int bj = 0; bj < 2; ++bj)
#pragma unroll
                    for (int n = 0; n < 2; ++n) *(f32x4*)(rowp + bj * HALF + n * 16) = acc[ai][bj][m][n]; }
    }
};
struct EpiSwiGLU {
    static constexpr bool PERM = true, AFTER_DRAIN = false;
    h16* O; int ldc;
    __device__ __forceinline__ void operator()(const f32x4 (&acc)[2][2][4][2], const Unit& u, int wr, int wc, int fr, int fq) const {
        const int row0 = u.pm * BM + wr * 64 + fr, col0 = u.pn * HALF + wc * 32 + 8 * fq;
#pragma unroll
        for (int ai = 0; ai < 2; ++ai)
#pragma unroll
            for (int m = 0; m < 4; ++m) { h16* rowp = O + (size_t)(row0 + ai * HALF + m * 16) * ldc + col0;
                float v[8];
#pragma unroll
                for (int n = 0; n < 2; ++n)
#pragma unroll
                    for (int i = 0; i < 4; ++i) { const float g = acc[ai][0][m][n][i], up = acc[ai][1][m][n][i];
                        const float e = __builtin_amdgcn_exp2f(-1.4426950408889634f * g); v[4 * n + i] = g * __builtin_amdgcn_rcpf(1.0f + e) * up; }
                u32x4 w; w.x = cvt_pk_h16(v[0], v[1]); w.y = cvt_pk_h16(v[2], v[3]); w.z = cvt_pk_h16(v[4], v[5]); w.w = cvt_pk_h16(v[6], v[7]);
                *(u32x4*)rowp = w; }
    }
};
struct EpiProj {
    static constexpr bool PERM = true, AFTER_DRAIN = false;
    unsigned char* qkv; size_t qkv_stride; h16* QS; h16* KI; float* WI; h16* LRU;
    __device__ __forceinline__ void store_h16(const f32x4 (&acc)[2][2][4][2], h16* base, int ld, int row0, int c0, float sc) const {
#pragma unroll
        for (int ai = 0; ai < 2; ++ai)
#pragma unroll
            for (int m = 0; m < 4; ++m) { h16* rowp = base + (size_t)(row0 + ai * HALF + m * 16) * ld + c0;
#pragma unroll
                for (int bj = 0; bj < 2; ++bj) { const f32x4 v0 = acc[ai][bj][m][0] * sc, v1 = acc[ai][bj][m][1] * sc;
                    u32x4 w; w.x = cvt_pk_h16(v0[0], v0[1]); w.y = cvt_pk_h16(v0[2], v0[3]); w.z = cvt_pk_h16(v1[0], v1[1]); w.w = cvt_pk_h16(v1[2], v1[3]);
                    *(u32x4*)(rowp + bj * HALF) = w; } }
    }
    __device__ __forceinline__ void operator()(const f32x4 (&acc)[2][2][4][2], const Unit& u, int wr, int wc, int fr, int fq) const {
        const int row0 = u.pm * BM + wr * 64 + fr, cw = wc * 32 + 8 * fq; const int pn = u.pn;
        if (pn < 6) { store_h16(acc, (h16*)(qkv + (size_t)(pn >> 1) * qkv_stride), 512, row0, (pn & 1) * 256 + cw, pn < 2 ? 0.125f * 1.4426950408889634f : 1.0f); }
        else if (pn >= 9) { store_h16(acc, LRU, 1024, row0, (pn - 9) * 256 + cw, 1.0f); }
        else if (pn < 8) { store_h16(acc, QS, 512, row0, (pn - 6) * 256 + cw, 0.125f); }
        else {
#pragma unroll
            for (int ai = 0; ai < 2; ++ai)
#pragma unroll
                for (int m = 0; m < 4; ++m) { const size_t row = (size_t)(row0 + ai * HALF + m * 16); const f32x4 v0 = acc[ai][0][m][0], v1 = acc[ai][0][m][1];
                    if (cw < 64) { u32x4 w; w.x = cvt_pk_h16(v0[0], v0[1]); w.y = cvt_pk_h16(v0[2], v0[3]); w.z = cvt_pk_h16(v1[0], v1[1]); w.w = cvt_pk_h16(v1[2], v1[3]); *(u32x4*)(KI + row * 64 + cw) = w; }
                    else if (cw == 64) { const float sc = 0.5f * 0.35355339059327373f; *(f32x4*)(WI + row * 8) = v0 * sc; *(f32x4*)(WI + row * 8 + 4) = v1 * sc; } }
        }
    }
};

template <class Epi, class Sched, bool ALIGN_EPI = false>
__device__ __forceinline__ void gemm_phase(PG8_LAS unsigned char* lds, const Gemm g, const Sched& S, const Epi& E) {
    const int tid = threadIdx.x, wid = __builtin_amdgcn_readfirstlane(tid >> 6), lane = tid & 63, wr = wid >> 2, wc = wid & 3, fr = lane & 15, fq = lane >> 4;
    const int K = g.K, nt = K / BK;
    unsigned voffA[2], voffB[2];
#pragma unroll
    for (int i = 0; i < 2; ++i) { int R, C; stage_rc(tid * 16 + i * 8192, R, C); const int Rb = Epi::PERM ? ((R & ~31) + perm32(R & 31)) : R;
        voffA[i] = (unsigned)(R * K + C) * 2u; voffB[i] = (unsigned)(Rb * K + C) * 2u; }
    const size_t kstep = (size_t)(BK * 2);
    const size_t hstep = (size_t)HALF * K * 2;
    const size_t tstep = 2 * hstep;
    const unsigned ldsw = (unsigned)wid * 1024u;
    const int aoff = lds_byte(wr * 64 + fr, fq * 8), boff = lds_byte(wc * 32 + fr, fq * 8);
#define PG8_SA(b, h) (((b) * 2 + (h)) * HTB)
#define PG8_SB(b, h) ((4 + (b) * 2 + (h)) * HTB)
#define PG8_STAGE(bufoff, gbase, voff) do { _Pragma("unroll") for (int _i = 0; _i < 2; ++_i) \
        __builtin_amdgcn_global_load_lds((const unsigned*)((const char*)(gbase) + (voff)[_i]), (PG8_LAS unsigned*)(lds + (bufoff) + ldsw + _i * 8192), 16, 0, 0); } while (0)
#define PG8_LDA(dst, b, h) do { _Pragma("unroll") for (int m = 0; m < 4; ++m) _Pragma("unroll") for (int k = 0; k < 2; ++k) dst[m][k] = *(const PG8_LAS h16x8*)(lds + PG8_SA(b, h) + aoff + m * 2048 + k * 1024); } while (0)
#define PG8_LDB(dst, b, h) do { _Pragma("unroll") for (int n = 0; n < 2; ++n) _Pragma("unroll") for (int k = 0; k < 2; ++k) dst[n][k] = *(const PG8_LAS h16x8*)(lds + PG8_SB(b, h) + boff + n * 2048 + k * 1024); } while (0)
#define PG8_MMA(ai, bj, At, Bt) do { __builtin_amdgcn_s_setprio(1); _Pragma("unroll") for (int m = 0; m < 4; ++m) _Pragma("unroll") for (int n = 0; n < 2; ++n) _Pragma("unroll") for (int k = 0; k < 2; ++k) \
        acc[ai][bj][m][n] = __builtin_amdgcn_mfma_f32_16x16x32_f16(Bt[n][k], At[m][k], acc[ai][bj][m][n], 0, 0, 0); __builtin_amdgcn_s_setprio(0); } while (0)
#define PG8_WAIT_V(n) asm volatile("s_waitcnt vmcnt(" #n ")" ::: "memory")
#define PG8_WAIT_L(n) asm volatile("s_waitcnt lgkmcnt(" #n ")" ::: "memory")
#define PG8_BAR __builtin_amdgcn_s_barrier()
#define PG8_SCHED __builtin_amdgcn_sched_barrier(0)
    Unit cur, nxt; int ui = 0;
    if (!S.next(0, cur)) return;
    f32x4 acc[2][2][4][2];
#pragma unroll
    for (int a = 0; a < 2; ++a)
#pragma unroll
        for (int b = 0; b < 2; ++b)
#pragma unroll
            for (int m = 0; m < 4; ++m)
#pragma unroll
                for (int n = 0; n < 2; ++n) acc[a][b][m][n] = (f32x4){0.f, 0.f, 0.f, 0.f};
    h16x8 At[4][2], B0[2][2], B1[2][2];
    const char* cA = (const char*)g.A + (size_t)cur.pm * tstep; const char* cB = (const char*)g.Bt + (size_t)cur.pn * tstep;
    S.a_ready(cur);
    PG8_STAGE(PG8_SB(0, 0), cB, voffB); PG8_STAGE(PG8_SB(0, 1), cB + hstep, voffB); PG8_STAGE(PG8_SA(0, 0), cA, voffA); PG8_STAGE(PG8_SA(0, 1), cA + hstep, voffA);
    if (wr == 1) PG8_BAR;
    PG8_WAIT_V(2); PG8_BAR;
    PG8_STAGE(PG8_SB(1, 0), cB + kstep, voffB); PG8_STAGE(PG8_SA(1, 0), cA + kstep, voffA); PG8_STAGE(PG8_SB(1, 1), cB + hstep + kstep, voffB);
    PG8_WAIT_V(6); PG8_BAR;
    for (;;) {
        const bool has_next = S.next(ui + 1, nxt);
        const char* nA = has_next ? (const char*)g.A + (size_t)nxt.pm * tstep : cA; const char* nB = has_next ? (const char*)g.Bt + (size_t)nxt.pn * tstep : cB;
        for (int t = 0; t < nt; t += 2) {
            const bool last = (t == nt - 2);
            const char* a1 = cA + (size_t)(t + 1) * kstep;
            const char* a2 = last ? nA : cA + (size_t)(t + 2) * kstep; const char* b2 = last ? nB : cB + (size_t)(t + 2) * kstep;
            const char* a3 = a2 + kstep; const char* b3 = b2 + kstep;
            if (last && has_next) S.a_ready(nxt);
            PG8_LDB(B0, 0, 0); PG8_LDB(B1, 0, 1); PG8_SCHED; PG8_LDA(At, 0, 0); PG8_STAGE(PG8_SA(1, 1), a1 + hstep, voffA);
            PG8_WAIT_V(8); PG8_WAIT_L(0); PG8_BAR; PG8_MMA(0, 0, At, B0); PG8_MMA(0, 1, At, B1); PG8_BAR; PG8_SCHED;
            PG8_LDA(At, 0, 1); PG8_STAGE(PG8_SB(0, 0), b2, voffB); PG8_STAGE(PG8_SB(0, 1), b2 + hstep, voffB); PG8_STAGE(PG8_SA(0, 0), a2, voffA);
            PG8_WAIT_V(8); PG8_WAIT_L(0); PG8_BAR; PG8_MMA(1, 0, At, B0); PG8_MMA(1, 1, At, B1); PG8_BAR; PG8_SCHED;
            PG8_LDB(B0, 1, 0); PG8_LDB(B1, 1, 1); PG8_SCHED; PG8_LDA(At, 1, 0); PG8_STAGE(PG8_SA(0, 1), a2 + hstep, voffA);
            PG8_WAIT_V(8); PG8_WAIT_L(0); PG8_BAR; PG8_MMA(0, 0, At, B0); PG8_MMA(0, 1, At, B1); PG8_BAR; PG8_SCHED;
            PG8_LDA(At, 1, 1); PG8_STAGE(PG8_SB(1, 0), b3, voffB); PG8_STAGE(PG8_SB(1, 1), b3 + hstep, voffB); PG8_STAGE(PG8_SA(1, 0), a3, voffA);
            PG8_WAIT_V(8); PG8_WAIT_L(0); PG8_BAR; PG8_MMA(1, 0, At, B0); PG8_MMA(1, 1, At, B1); PG8_BAR; PG8_SCHED;
        }
        if constexpr (ALIGN_EPI) { if (wr == 0) PG8_BAR; }
        E(acc, cur, wr, wc, fr, fq); S.done(cur);
        if (!has_next) break;
#pragma unroll
        for (int a = 0; a < 2; ++a)
#pragma unroll
            for (int b = 0; b < 2; ++b)
#pragma unroll
                for (int m = 0; m < 4; ++m)
#pragma unroll
                    for (int n = 0; n < 2; ++n) acc[a][b][m][n] = (f32x4){0.f, 0.f, 0.f, 0.f};
        cur = nxt; cA = nA; cB = nB; ++ui;
        if constexpr (ALIGN_EPI) { if (wr == 1) PG8_BAR; }
    }
    PG8_WAIT_V(0);
    if constexpr (!ALIGN_EPI) { if (wr == 0) PG8_BAR; }
    PG8_BAR;
#undef PG8_SA
#undef PG8_SB
#undef PG8_STAGE
#undef PG8_LDA
#undef PG8_LDB
#undef PG8_MMA
#undef PG8_WAIT_V
#undef PG8_WAIT_L
#undef PG8_BAR
#undef PG8_SCHED
}
}

constexpr int NWAVES = 8, NTHR = NWAVES * 64;
constexpr int N_LAUNCHES = MK_N_LAUNCHES;
constexpr int N_PHASES = 16;
constexpr int BATCH = 2, SEQ = 8192, D = 1024, FF = 2816, M = BATCH * SEQ;
constexpr int NGU = 2 * FF;
constexpr int NPROJ = 3328;
constexpr int DIN = 3144;
constexpr int NH = 8, HD = 64, DATT = 512, DLRU = 512, TOPK = 256, CHUNK = 64;
constexpr int LCH = 32, NLCH = SEQ / LCH;
constexpr float EPS = 1e-6f;

constexpr size_t MiB = 1u << 20;
constexpr size_t WS_CTL = 0, CTL_ZERO_BYTES = 1 * MiB;
constexpr size_t WS_MOD = 1 * MiB;
constexpr size_t WS_LRUW = 2 * MiB;
constexpr size_t WS_LRUS = 246 * MiB;
constexpr size_t WS_W1GU = 3 * MiB, WS_W1D = 14 * MiB, WS_WIN = 20 * MiB, WS_WOUT = 27 * MiB, WS_W2GU = 29 * MiB, WS_W2D = 40 * MiB;
constexpr size_t WS_H = 46 * MiB;
constexpr size_t WS_ACT = 78 * MiB;
constexpr size_t WS_Y = 166 * MiB;
constexpr size_t WS_Q = 78 * MiB, WS_K = 94 * MiB, WS_V = 110 * MiB;
constexpr size_t WS_QS = 126 * MiB;
constexpr size_t WS_O = 142 * MiB;
constexpr size_t WS_KI = 158 * MiB;
constexpr size_t WS_WI = 160 * MiB;
constexpr size_t WS_MASK = 230 * MiB;
constexpr size_t WS_LRU = 166 * MiB;
constexpr size_t WS_MERGED = WS_H;
constexpr size_t WS_END = 248 * MiB;
constexpr int CW_BAR = 4096;

constexpr int RING_OFF = 0, RING_BYTES = 131072;
constexpr int LDSCTL_OFF = RING_BYTES, MISC_OFF = LDSCTL_OFF + 320;
constexpr int LDS_BYTES = 147456;

#define GAS __attribute__((address_space(1)))
#define LAS __attribute__((address_space(3)))
typedef _Float16 h16;
typedef unsigned v4u __attribute__((ext_vector_type(4)));
typedef unsigned v2u __attribute__((ext_vector_type(2)));
typedef float f32x4 __attribute__((ext_vector_type(4)));
typedef _Float16 h16x8 __attribute__((ext_vector_type(8)));
typedef _Float16 h16x4 __attribute__((ext_vector_type(4)));
typedef GAS unsigned gu32;
#define RLX_AGENT __ATOMIC_RELAXED, __HIP_MEMORY_SCOPE_AGENT
#define LDS_WAIT() asm volatile("s_waitcnt lgkmcnt(0)" ::: "memory")
#define VM_WAIT() asm volatile("s_waitcnt vmcnt(0)" ::: "memory")
using pg8::cvt_pk_h16;

#define XB_TMO      128
#define XB_XCNT(j)  (256  + 64 * (j))
#define XB_XSUB(j)  (1280 + 64 * (j))
#define XB_XGEN(j)  (2304 + 64 * (j))
#define XB_TOP      3328
#define XB_TOPGEN   3392
#define XCD_BAR_WORDS 3456
#define XB_SPIN_CAP (1u << 18)
__device__ __forceinline__ unsigned xb_ld(unsigned* p)              { return __hip_atomic_load(p, __ATOMIC_RELAXED, __HIP_MEMORY_SCOPE_AGENT); }
__device__ __forceinline__ unsigned xb_add(unsigned* p, unsigned v) { return __hip_atomic_fetch_add(p, v, __ATOMIC_RELAXED, __HIP_MEMORY_SCOPE_AGENT); }
__device__ __forceinline__ unsigned xb_xcc_id() { return (unsigned)__builtin_amdgcn_s_getreg((3 << 11) | 20) & 0xFu; }
#define XB_SPIN(cond, bar) do { unsigned _sp = 0; while (cond) { __builtin_amdgcn_s_sleep(1); \
    if ((++_sp & 255u) == 0u) { if (xb_ld(&(bar)[XB_TMO])) break; if (_sp > XB_SPIN_CAP) { atomicAdd(&(bar)[XB_TMO], 1u); break; } } } } while (0)
struct XcdBarrier { unsigned* bar; unsigned x; volatile LAS unsigned* st; };
__device__ __forceinline__ XcdBarrier xcd_barrier_post(unsigned* bar, volatile LAS unsigned* st) {
    XcdBarrier b; b.bar = bar; b.x = xb_xcc_id(); b.st = st;
    if (threadIdx.x == 0) (void)xb_add(&bar[XB_XCNT(b.x)], 1u);
    return b;
}
__device__ __forceinline__ void xcd_barrier_complete(unsigned* bar, unsigned x, unsigned& nloc, unsigned& nx) {
    const unsigned G = gridDim.x * gridDim.y * gridDim.z;
    unsigned sum, cnt, mine, sp = 0u;
    for (;;) {
        sum = 0u; cnt = 0u; mine = 0u;
#pragma unroll
        for (unsigned j = 0; j < 16; ++j) { const unsigned c = xb_ld(&bar[XB_XCNT(j)]); sum += c; cnt += (c > 0u) ? 1u : 0u; mine = (j == x) ? c : mine; }
        if (sum == G) break;
        __builtin_amdgcn_s_sleep(1);
        if ((++sp & 255u) == 0u) { if (xb_ld(&bar[XB_TMO])) break; if (sp > XB_SPIN_CAP) { atomicAdd(&bar[XB_TMO], 1u); break; } }
    }
    nloc = mine > 0u ? mine : 1u; nx = cnt > 0u ? cnt : 1u;
}
__device__ __forceinline__ void xcd_barrier(const XcdBarrier& b) {
    asm volatile("s_waitcnt vmcnt(0)" ::: "memory");
    __syncthreads();
    if (threadIdx.x == 0) {
        unsigned* bar = b.bar;
        __builtin_amdgcn_s_waitcnt(0);
        unsigned nloc = b.st[0], nx = b.st[1];
        if (nloc == 0u) { xcd_barrier_complete(bar, b.x, nloc, nx); b.st[0] = nloc; b.st[1] = nx; }
        const unsigned old = xb_add(&bar[XB_XSUB(b.x)], 1u);
        const unsigned gen = old / nloc;
        if (old + 1u == (gen + 1u) * nloc) {
            __builtin_amdgcn_fence(__ATOMIC_RELEASE, "agent");
            asm volatile("s_waitcnt vmcnt(0)" ::: "memory");
            const unsigned og = xb_add(&bar[XB_TOP], 1u);
            const unsigned tg = og / nx;
            if (og + 1u == (tg + 1u) * nx) xb_add(&bar[XB_TOPGEN], 1u);
            else XB_SPIN(xb_ld(&bar[XB_TOPGEN]) == tg, bar);
            __builtin_amdgcn_fence(__ATOMIC_ACQUIRE, "agent");
            xb_add(&bar[XB_XGEN(b.x)], 1u);
            asm volatile("s_waitcnt vmcnt(0)" ::: "memory");
        } else {
            XB_SPIN(xb_ld(&bar[XB_XGEN(b.x)]) == gen, bar);
            __builtin_amdgcn_fence(__ATOMIC_ACQUIRE, "agent");
            asm volatile("s_waitcnt vmcnt(0)" ::: "memory");
        }
    }
    __syncthreads();
}

struct Frame {
    LAS unsigned char* lds;
    volatile LAS unsigned* MISC;
    gu32* ctl;
    int tid, lane, wave;
    int vcu, G;
};
struct Args { const float* in[28]; float* out; unsigned char* ws; int ph_lo, ph_hi, li, pad; };

__device__ __forceinline__ float wave_sum(float v) {
#pragma unroll
    for (int o = 1; o < 64; o <<= 1) v += __shfl_xor(v, o);
    return v;
}
__device__ __forceinline__ float wave_max(float v) {
#pragma unroll
    for (int o = 1; o < 64; o <<= 1) v = fmaxf(v, __shfl_xor(v, o));
    return v;
}

struct MapId { __device__ __forceinline__ int operator()(int n) const { return n; } };
struct MapGU { int half; __device__ __forceinline__ int operator()(int n) const { return (n >> 7) * 256 + half * 128 + (n & 127); } };
struct MapIn { __device__ __forceinline__ int operator()(int n) const { return n < 2120 ? n : n + 184; } };
template <class RowMap>
__device__ __forceinline__ void p0_transpose_item(const float* W, int K, int N, h16* WT, RowMap rm, LAS float* scr, int item, int lane) {
    const int nblk = (N + 31) / 32, kb = item / nblk, nb = item % nblk, k0 = 64 * kb, n0 = 32 * nb;
    const int nl = n0 + (lane & 31);
#pragma unroll 8
    for (int i = 0; i < 32; ++i) { const int kk = 2 * i + (lane >> 5); scr[kk * 33 + (lane & 31)] = (nl < N) ? W[(size_t)(k0 + kk) * N + nl] : 0.f; }
    LDS_WAIT(); asm volatile("" ::: "memory");
    const int c = lane & 7;
#pragma unroll
    for (int j = 0; j < 4; ++j) { const int nn = (lane >> 3) + 8 * j; const LAS float* s = scr + (8 * c) * 33 + nn;
        v4u o; o.x = cvt_pk_h16(s[0 * 33], s[1 * 33]); o.y = cvt_pk_h16(s[2 * 33], s[3 * 33]); o.z = cvt_pk_h16(s[4 * 33], s[5 * 33]); o.w = cvt_pk_h16(s[6 * 33], s[7 * 33]);
        if (n0 + nn < N) *(GAS v4u*)(WT + (size_t)rm(n0 + nn) * K + k0 + 8 * c) = o; }
    LDS_WAIT(); asm volatile("" ::: "memory");
}

__device__ __forceinline__ void p0_prologue(Frame& F, const Args& A) {
    unsigned char* ws = A.ws;
    if (blockIdx.x < 36) {
        LAS float* sc = (LAS float*)(F.lds);
        LAS float* red = (LAS float*)(F.lds + 8192);
        const float* c = A.in[1];
        for (int i = F.tid; i < 2048; i += NTHR) { const float v = c[i]; sc[i] = v / (1.0f + __expf(-v)); }
        __syncthreads();
        const float* wa = A.in[2]; const int col = blockIdx.x * 256 + 4 * F.lane;
        f32x4 a0 = {0.f, 0.f, 0.f, 0.f}, a1 = {0.f, 0.f, 0.f, 0.f};
        const int kb = F.wave * 128;
#pragma unroll 8
        for (int k = 0; k < 128; ++k) { const f32x4 w = *(const f32x4*)(wa + (size_t)(kb + k) * 9216 + col); a0 += w * sc[kb + k]; a1 += w * sc[1024 + kb + k]; }
        *(LAS f32x4*)(red + (F.wave * 2 + 0) * 256 + 4 * F.lane) = a0; *(LAS f32x4*)(red + (F.wave * 2 + 1) * 256 + 4 * F.lane) = a1;
        __syncthreads();
        { const int b = F.tid >> 8, j = F.tid & 255; float s = 0.f;
#pragma unroll
          for (int w = 0; w < 8; ++w) s += red[(w * 2 + b) * 256 + j];
          const int cc = blockIdx.x * 256 + j; ((float*)(ws + WS_MOD))[b * 9216 + cc] = s + A.in[3][cc]; }
        __syncthreads();
    }
    LAS float* scr = (LAS float*)(F.lds + RING_OFF + F.wave * 16384);
    const int gw = F.vcu * NWAVES + F.wave, NGW = F.G * NWAVES;
    constexpr int I_GU = (D / 64) * (FF / 32), I_DN = (FF / 64) * (D / 32), I_IN = (D / 64) * ((DIN + 31) / 32), I_OUT = (D / 64) * (D / 32);
    constexpr int NITEMS = 6 * I_GU + I_IN + I_OUT; static_assert(I_GU == I_DN, "items");
    h16* W1GU = (h16*)(ws + WS_W1GU); h16* W1D = (h16*)(ws + WS_W1D); h16* WIN = (h16*)(ws + WS_WIN); h16* WOUT = (h16*)(ws + WS_WOUT); h16* W2GU = (h16*)(ws + WS_W2GU); h16* W2D = (h16*)(ws + WS_W2D);
    for (int it = gw; it < NITEMS; it += NGW) {
        int r = it;
        if (r < I_GU) { p0_transpose_item(A.in[6], D, FF, W1GU, MapGU{0}, scr, r, F.lane); continue; } r -= I_GU;
        if (r < I_GU) { p0_transpose_item(A.in[7], D, FF, W1GU, MapGU{1}, scr, r, F.lane); continue; } r -= I_GU;
        if (r < I_DN) { p0_transpose_item(A.in[8], FF, D, W1D, MapId{}, scr, r, F.lane); continue; } r -= I_DN;
        if (r < I_IN) { p0_transpose_item(A.in[11], D, DIN, WIN, MapIn{}, scr, r, F.lane); continue; } r -= I_IN;
        if (r < I_OUT) { p0_transpose_item(A.in[22], D, D, WOUT, MapId{}, scr, r, F.lane); continue; } r -= I_OUT;
        if (r < I_GU) { p0_transpose_item(A.in[25], D, FF, W2GU, MapGU{0}, scr, r, F.lane); continue; } r -= I_GU;
        if (r < I_GU) { p0_transpose_item(A.in[26], D, FF, W2GU, MapGU{1}, scr, r, F.lane); continue; } r -= I_GU;
        p0_transpose_item(A.in[27], FF, D, W2D, MapId{}, scr, r, F.lane);
    }
    for (int tk = gw; tk < 128; tk += NGW) { const int s4 = tk & 3, jt = (tk >> 2) & 1, g = (tk >> 3) & 7, gate = tk >> 6; const float* W = A.in[gate ? 17 : 15]; const int r = F.lane & 31, hh = F.lane >> 5;
        float v[8];
#pragma unroll
        for (int e = 0; e < 8; ++e) v[e] = W[(g * 64 + 16 * s4 + 8 * hh + e) * 64 + 32 * jt + r];
        v4u o; o.x = cvt_pk_h16(v[0], v[1]); o.y = cvt_pk_h16(v[2], v[3]); o.z = cvt_pk_h16(v[4], v[5]); o.w = cvt_pk_h16(v[6], v[7]);
        *(GAS v4u*)(ws + WS_LRUW + ((size_t)tk * 64 + F.lane) * 16) = o; }
    for (int i = blockIdx.x * NTHR + F.tid; i < 184 * 128; i += F.G * NTHR) *(GAS v4u*)(WIN + (size_t)2120 * D + (size_t)i * 8) = (v4u){0u, 0u, 0u, 0u};
}

template <bool HAS_Y, bool HAS_H>
__device__ __forceinline__ void thin_phase(Frame& F, const float* mod, const float* yin, const float* gpost, float gscale, int mg,
                                           const float* xin, float* xout, const float* gpre, int msh, int msc, h16* hout) {
    LAS float* TA = (LAS float*)(F.lds); LAS float* TB = TA + 2048; LAS float* TC = TB + 2048;
    for (int i = F.tid; i < 2048; i += NTHR) { const int b = i >> 10, cidx = i & 1023;
        if (HAS_Y) TA[i] = gscale * mod[b * 9216 + mg * 1024 + cidx] * gpost[cidx];
        if (HAS_H) { TB[i] = gpre[cidx] * (1.0f + mod[b * 9216 + msc * 1024 + cidx]); TC[i] = mod[b * 9216 + msh * 1024 + cidx]; } }
    __syncthreads();
    const int gw = F.vcu * NWAVES + F.wave, NGW = F.G * NWAVES;
    for (int row = gw; row < M; row += NGW) {
        const int b = row >> 13;
        const GAS f32x4* xr = (const GAS f32x4*)(xin + (size_t)row * D) + F.lane;
        f32x4 x[4];
#pragma unroll
        for (int j = 0; j < 4; ++j) x[j] = xr[64 * j];
        if (HAS_Y) {
            const GAS f32x4* yr = (const GAS f32x4*)(yin + (size_t)row * D) + F.lane;
            f32x4 y[4]; float s = 0.f;
#pragma unroll
            for (int j = 0; j < 4; ++j) { y[j] = yr[64 * j]; s += (y[j].x * y[j].x + y[j].y * y[j].y) + (y[j].z * y[j].z + y[j].w * y[j].w); }
            const float rstd = 1.0f / sqrtf(wave_sum(s) * (1.0f / D) + EPS);
            GAS f32x4* xo = (GAS f32x4*)(xout + (size_t)row * D) + F.lane;
#pragma unroll
            for (int j = 0; j < 4; ++j) { const f32x4 ta = *(const LAS f32x4*)(TA + b * 1024 + 4 * F.lane + 256 * j); x[j] = x[j] + ta * (y[j] * rstd); xo[64 * j] = x[j]; }
        }
        if (HAS_H) {
            float s = 0.f;
#pragma unroll
            for (int j = 0; j < 4; ++j) s += (x[j].x * x[j].x + x[j].y * x[j].y) + (x[j].z * x[j].z + x[j].w * x[j].w);
            const float rstd = 1.0f / sqrtf(wave_sum(s) * (1.0f / D) + EPS);
            GAS v2u* ho = (GAS v2u*)(hout + (size_t)row * D) + F.lane;
#pragma unroll
            for (int j = 0; j < 4; ++j) { const f32x4 tb = *(const LAS f32x4*)(TB + b * 1024 + 4 * F.lane + 256 * j), tc = *(const LAS f32x4*)(TC + b * 1024 + 4 * F.lane + 256 * j);
                const f32x4 h = (x[j] * rstd) * tb + tc; v2u o; o.x = cvt_pk_h16(h.x, h.y); o.y = cvt_pk_h16(h.z, h.w); ho[64 * j] = o; }
        }
    }
    __syncthreads();
}

__device__ __forceinline__ float gelu_tanh(float x) { const float u = 0.7978845608028654f * (x + 0.044715f * x * x * x); const float e = __builtin_amdgcn_exp2f(2.0f * 1.4426950408889634f * u); const float t = 1.0f - 2.0f * __builtin_amdgcn_rcpf(e + 1.0f); return 0.5f * x * (1.0f + t); }
__device__ __forceinline__ float fast_sigmoid(float z) { return __builtin_amdgcn_rcpf(1.0f + __builtin_amdgcn_exp2f(-1.4426950408889634f * z)); }
__device__ __forceinline__ float lane_partner(float x, int hh) { auto rr = __builtin_amdgcn_permlane32_swap(__float_as_uint(x), __float_as_uint(x), false, false); return __uint_as_float(hh ? rr[0] : rr[1]); }
typedef float f32x16 __attribute__((ext_vector_type(16)));
__device__ __forceinline__ int crow(int r, int hi) { return (r & 3) + 8 * (r >> 2) + 4 * hi; }
constexpr int LL_XC = 0, LL_OUT = 32768, LL_CAR = 131072 + 1024;
template <bool PASS_B>
__device__ __forceinline__ void lru_phase(Frame& F, const Args& A) {
    unsigned char* ws = A.ws;
    const h16* LRU = (const h16*)(ws + WS_LRU); float* SA = (float*)(ws + WS_LRUS); float* SB = SA + BATCH * NLCH * DLRU;
    h16* MERGED = (h16*)(ws + WS_MERGED);
    int tid_o = F.tid; asm volatile("" : "+v"(tid_o));
    const int tid = tid_o, lane = tid & 63, g = F.wave, r = lane & 31, hh = lane >> 5;
    LAS unsigned char* XC = F.lds + LL_XC; LAS float* OUT = (LAS float*)(F.lds + LL_OUT); LAS float* CAR = (LAS float*)(F.lds + LL_CAR);
    const h16x8* LW = (const h16x8*)(ws + WS_LRUW);
    float ba[2], bi[2], sp8[2];
#pragma unroll
    for (int jt = 0; jt < 2; ++jt) { const int ch = g * 64 + 32 * jt + r; ba[jt] = A.in[16][ch]; bi[jt] = A.in[18][ch]; const float lam = A.in[19][ch]; sp8[jt] = 8.0f * ((lam < -15.f) ? -lam : log1pf(__expf(-lam))); }
    for (int p = blockIdx.x; p < 256; p += F.G) {
#pragma unroll 1
        for (int uu = 0; uu < 2; ++uu) {
            const int b = p >> 7, c = uu ? 255 - (p & 127) : (p & 127), t0 = c * LCH;
            const h16* xb = LRU + (size_t)(b * SEQ) * 1024;
            __syncthreads();
            { h16x8 xr[7]; f32x4 cwv[4][2], cbv[2];
              cbv[0] = *(const f32x4*)(A.in[14] + 8 * lane); cbv[1] = *(const f32x4*)(A.in[14] + 8 * lane + 4);
#pragma unroll
              for (int jx = 0; jx < 4; ++jx) { cwv[jx][0] = *(const f32x4*)(A.in[13] + jx * DLRU + 8 * lane); cwv[jx][1] = *(const f32x4*)(A.in[13] + jx * DLRU + 8 * lane + 4); }
#pragma unroll
              for (int k = 0; k < 7; ++k) { const int t = t0 + 4 * g - 3 + k; if (t >= 0) xr[k] = *(const h16x8*)(xb + (size_t)t * 1024 + 8 * lane); else xr[k] = (h16x8){0, 0, 0, 0, 0, 0, 0, 0}; }
#pragma unroll
              for (int tt = 0; tt < 4; ++tt) { float v[8];
#pragma unroll
                  for (int e = 0; e < 8; ++e) v[e] = cbv[e >> 2][e & 3] + (float)xr[tt][e] * cwv[0][e >> 2][e & 3] + (float)xr[tt + 1][e] * cwv[1][e >> 2][e & 3] + (float)xr[tt + 2][e] * cwv[2][e >> 2][e & 3] + (float)xr[tt + 3][e] * cwv[3][e >> 2][e & 3];
                  v4u o; o.x = cvt_pk_h16(v[0], v[1]); o.y = cvt_pk_h16(v[2], v[3]); o.z = cvt_pk_h16(v[4], v[5]); o.w = cvt_pk_h16(v[6], v[7]);
                  const int row = 4 * g + tt; *(LAS v4u*)(XC + row * 1024 + ((lane ^ (row & 7)) << 4)) = o; } }
            if (PASS_B) { float H = 0.f; const float* pa = SA + (size_t)(b * NLCH) * DLRU + tid; const float* pb = SB + (size_t)(b * NLCH) * DLRU + tid;
#pragma unroll 16
                for (int cc = 0; cc < c; ++cc) H = pa[(size_t)cc * DLRU] * H + pb[(size_t)cc * DLRU];
                CAR[tid] = H; }
            __syncthreads();
            h16x8 af[4];
#pragma unroll
            for (int s = 0; s < 4; ++s) af[s] = *(const LAS h16x8*)(XC + r * 1024 + (((g * 8 + 2 * s + hh) ^ (r & 7)) << 4));
#pragma unroll
            for (int jt = 0; jt < 2; ++jt) {
                float gt[16];
                if (PASS_B) {
#pragma unroll
                    for (int i = 0; i < 16; ++i) gt[i] = (float)xb[(size_t)(t0 + crow(i, hh)) * 1024 + 512 + g * 64 + 32 * jt + r]; }
                float av[16], bv[16];
                const int ch = g * 64 + 32 * jt + r;
                {   h16x8 wf[4];
#pragma unroll
                    for (int s = 0; s < 4; ++s) wf[s] = LW[(((0 * 8 + g) * 2 + jt) * 4 + s) * 64 + lane];
                    f32x16 za = {};
#pragma unroll
                    for (int s = 0; s < 4; ++s) za = __builtin_amdgcn_mfma_f32_32x32x16_f16(af[s], wf[s], za, 0, 0, 0);
#pragma unroll
                    for (int i = 0; i < 16; ++i) { const float rg = fast_sigmoid(za[i] + ba[jt]); const float la = -sp8[jt] * rg, y = 2.0f * la;
                        const float em = (y > -0.03f) ? -y * (1.0f + y * (0.5f + y * (0.16666667f + y * 0.041666668f))) : 1.0f - __expf(y);
                        av[i] = __expf(la); bv[i] = __builtin_amdgcn_sqrtf(em); } }
                {   h16x8 wf[4];
#pragma unroll
                    for (int s = 0; s < 4; ++s) wf[s] = LW[(((1 * 8 + g) * 2 + jt) * 4 + s) * 64 + lane];
                    f32x16 zi = {};
#pragma unroll
                    for (int s = 0; s < 4; ++s) zi = __builtin_amdgcn_mfma_f32_32x32x16_f16(af[s], wf[s], zi, 0, 0, 0);
#pragma unroll
                    for (int i = 0; i < 16; ++i) { const int t = crow(i, hh); const float ig = fast_sigmoid(zi[i] + bi[jt]);
                        const float xcv = (float)*(const LAS h16*)(XC + t * 1024 + ((((ch >> 3)) ^ (t & 7)) << 4) + (ch & 7) * 2);
                        bv[i] *= ig * xcv; } }
                float GA[4], GB[4];
#pragma unroll
                for (int k = 0; k < 4; ++k) { float Ak = av[4 * k], Bk = bv[4 * k];
#pragma unroll
                    for (int e = 1; e < 4; ++e) { Bk = av[4 * k + e] * Bk + bv[4 * k + e]; Ak *= av[4 * k + e]; }
                    GA[k] = Ak; GB[k] = Bk; }
                float state = PASS_B ? CAR[ch] : 0.f; float cin[4];
#pragma unroll
                for (int k = 0; k < 4; ++k) { const float out0 = GA[k] * state + GB[k]; const float p0 = lane_partner(out0, hh); const float in1 = hh ? p0 : state; cin[k] = in1;
                    const float out1 = GA[k] * in1 + GB[k]; const float p1 = lane_partner(out1, hh); state = hh ? out1 : p1; }
                if (!PASS_B) { float P = (GA[0] * GA[1]) * (GA[2] * GA[3]); P *= lane_partner(P, hh);
                    if (hh == 0) { SA[(size_t)(b * NLCH + c) * DLRU + ch] = P; SB[(size_t)(b * NLCH + c) * DLRU + ch] = state; } }
                else {
#pragma unroll
                    for (int k = 0; k < 4; ++k) { float h = cin[k];
#pragma unroll
                        for (int e = 0; e < 4; ++e) { const int i = 4 * k + e; h = av[i] * h + bv[i]; OUT[crow(i, hh) * 512 + ch] = h * gelu_tanh(gt[i]); } } }
            }
            if (PASS_B) {
                __syncthreads();
#pragma unroll
                for (int k = 0; k < 4; ++k) { const int tt = 4 * g + k;
                    const f32x4 o0 = *(const LAS f32x4*)(OUT + tt * 512 + 8 * lane), o1 = *(const LAS f32x4*)(OUT + tt * 512 + 8 * lane + 4);
                    const float s = (o0.x * o0.x + o0.y * o0.y) + (o0.z * o0.z + o0.w * o0.w) + (o1.x * o1.x + o1.y * o1.y) + (o1.z * o1.z + o1.w * o1.w);
                    const float rstd = 1.0f / sqrtf(wave_sum(s) * (1.0f / DLRU) + EPS);
                    const f32x4 g0 = *(const f32x4*)(A.in[21] + 8 * lane), g1 = *(const f32x4*)(A.in[21] + 8 * lane + 4);
                    v4u o; o.x = cvt_pk_h16(o0.x * rstd * g0.x, o0.y * rstd * g0.y); o.y = cvt_pk_h16(o0.z * rstd * g0.z, o0.w * rstd * g0.w);
                    o.z = cvt_pk_h16(o1.x * rstd * g1.x, o1.y * rstd * g1.y); o.w = cvt_pk_h16(o1.z * rstd * g1.z, o1.w * rstd * g1.w);
                    *(GAS v4u*)(MERGED + (size_t)(b * SEQ + t0 + tt) * 1024 + 512 + 8 * lane) = o; }
            }
        }
    }
}

constexpr int IDX_CAP = 128;
constexpr int IL_QL = 0, IL_WL = 36864, IL_INFO = 37888, IL_CNT = 38400, IL_PS = 38912, IL_HIST = 65536, IL_CAND = 65536, IL_SCR = 98304;
constexpr int SL_SCORE = 65536, SL_HIST = 98304, SL_CTL = 99328;
__device__ __forceinline__ unsigned ord_key(float f) { const unsigned u = __float_as_uint(f); return u ^ ((u >> 31) ? 0xFFFFFFFFu : 0x80000000u); }
__device__ __forceinline__ int t5_bucket(int rel) {
    const int n = rel < 0 ? -rel : rel; int large;
    if (n < 12) large = 8; else if (n < 16) large = 9; else if (n < 23) large = 10; else if (n < 32) large = 11; else if (n < 46) large = 12; else if (n < 64) large = 13; else if (n < 91) large = 14; else large = 15;
    return (rel > 0 ? 16 : 0) + (n < 8 ? n : large);
}
#define IDX_FMA_ABS(s_, x_, w_) asm("v_fma_f32 %0, |%1|, %2, %0" : "+v"(s_) : "v"(x_), "v"(w_))
__device__ __forceinline__ void idx_scores(f32x16 (&S)[2], const h16x8 (&a)[2][4], const LAS unsigned char* ql, int foff, int sw, int hh, const LAS float* wl) {
    {   h16x8 qf[4];
#pragma unroll
        for (int s = 0; s < 4; ++s) qf[s] = *(const LAS h16x8*)(ql + 8 * 4096 + foff + (((2 * s + hh) ^ sw) << 4));
#pragma unroll
        for (int sub = 0; sub < 2; ++sub) { f32x16 acc = {};
#pragma unroll
            for (int s = 0; s < 4; ++s) acc = __builtin_amdgcn_mfma_f32_32x32x16_f16(a[sub][s], qf[s], acc, 0, 0, 0);
            S[sub] = acc; } }
#pragma unroll 1
    for (int h = 0; h < 8; ++h) {
        h16x8 qf[4]; const float wh = wl[h];
#pragma unroll
        for (int s = 0; s < 4; ++s) qf[s] = *(const LAS h16x8*)(ql + h * 4096 + foff + (((2 * s + hh) ^ sw) << 4));
        f32x16 acc0 = {}, acc1 = {};
#pragma unroll
        for (int s = 0; s < 4; ++s) acc0 = __builtin_amdgcn_mfma_f32_32x32x16_f16(a[0][s], qf[s], acc0, 0, 0, 0);
#pragma unroll
        for (int s = 0; s < 4; ++s) acc1 = __builtin_amdgcn_mfma_f32_32x32x16_f16(a[1][s], qf[s], acc1, 0, 0, 0);
        asm volatile("s_nop 15" : "+v"(acc0), "+v"(S[0]));
#pragma unroll
        for (int i = 0; i < 16; ++i) IDX_FMA_ABS(S[0][i], acc0[i], wh);
        asm volatile("s_nop 15" : "+v"(acc1), "+v"(S[1]));
#pragma unroll
        for (int i = 0; i < 16; ++i) IDX_FMA_ABS(S[1][i], acc1[i], wh);
    }
    asm volatile("s_nop 1" : "+v"(S[0]), "+v"(S[1]));
}
__device__ __forceinline__ void idx_phase(Frame& F, const Args& A) {
    unsigned char* ws = A.ws;
    const h16* QS = (const h16*)(ws + WS_QS); const h16* KI = (const h16*)(ws + WS_KI); const float* WI = (const float*)(ws + WS_WI);
    unsigned* MASK = (unsigned*)(ws + WS_MASK);
    LAS unsigned char* L = F.lds;
    int tid_o = F.tid; asm volatile("" : "+v"(tid_o));
    const int tid = tid_o, lane = tid & 63, wave = F.wave, r = lane & 31, hh = lane >> 5;
    LAS float* WL = (LAS float*)(L + IL_WL); LAS int* INFO = (LAS int*)(L + IL_INFO); LAS unsigned* CNT = (LAS unsigned*)(L + IL_CNT);
    LAS unsigned* HIST = (LAS unsigned*)(L + IL_HIST);
    for (int p = blockIdx.x; p < 256; p += F.G) {
        const int b = p >> 7, jj = p & 127;
        for (int uu = 0; uu < 2; ++uu) {
            const int j = uu ? 255 - jj : jj;
            const int q0 = 32 * j, rowb = b * SEQ + q0, N = ((j >> 1) + 1) * 64, NC = N >> 6;
            unsigned* mrow = MASK + ((size_t)(b * 128) * 8192 + q0) * 2;
            if (N <= TOPK) {
                for (int i = tid; i < NC * 64; i += NTHR) mrow[(size_t)(i >> 6) * 16384 + (i & 63)] = 0xFFFFFFFFu;
                continue;
            }
            __syncthreads();
#pragma unroll
            for (int i = 0; i < 4; ++i) { const int idx = tid + NTHR * i, q = idx >> 6, cc = idx & 63, head = cc >> 3, c8 = cc & 7;
                const v4u v = *(const GAS v4u*)(QS + (size_t)(rowb + q) * 512 + cc * 8);
                *(LAS v4u*)(L + IL_QL + head * 4096 + q * 128 + ((c8 ^ (q & 7)) << 4)) = v; }
            if (tid < 256) WL[tid] = WI[(size_t)rowb * 8 + tid];
            for (int i = tid; i < 16384; i += NTHR) HIST[i] = 0u;
            if (tid < 32) CNT[tid] = 0u;
            __syncthreads();
            { const int q = tid >> 4, dg = tid & 15, c8 = dg >> 1; float a0 = 0.f, a1 = 0.f, a2 = 0.f, a3 = 0.f;
              const int o = q * 128 + ((c8 ^ (q & 7)) << 4) + (dg & 1) * 8;
#pragma unroll
              for (int h = 0; h < 8; ++h) { const h16x4 v = *(const LAS h16x4*)(L + IL_QL + h * 4096 + o); const float wv = WL[q * 8 + h];
                  a0 += wv * (float)v[0]; a1 += wv * (float)v[1]; a2 += wv * (float)v[2]; a3 += wv * (float)v[3]; }
              v2u pk; pk.x = cvt_pk_h16(a0, a1); pk.y = cvt_pk_h16(a2, a3); *(LAS v2u*)(L + IL_QL + 8 * 4096 + o) = pk; }
            __syncthreads();
            const LAS float* w = WL + r * 8;
            const int foff = r * 128, sw = r & 7;
            const h16* kbase = KI + (size_t)(b * SEQ) * 64 + (size_t)r * 64 + 8 * hh;
            const LAS unsigned char* ql = L + IL_QL;
#define IDX_LOADA(dst, c) do { _Pragma("unroll") for (int sub_ = 0; sub_ < 2; ++sub_) _Pragma("unroll") for (int s_ = 0; s_ < 4; ++s_) \
                dst[sub_][s_] = *(const h16x8*)(kbase + (size_t)(64 * (c) + 32 * sub_) * 64 + 16 * s_); } while (0)
            h16x8 a[2][4]; f32x16 S[2];
            IDX_LOADA(a, 0); idx_scores(S, a, ql, foff, sw, hh, w);
            float s1 = 0.f, s2 = 0.f;
#pragma unroll
            for (int sub = 0; sub < 2; ++sub)
#pragma unroll
                for (int i = 0; i < 16; ++i) { s1 += S[sub][i]; s2 += S[sub][i] * S[sub][i]; }
            s1 += __shfl_xor(s1, 32); s2 += __shfl_xor(s2, 32);
            const float mean = s1 * (1.0f / 64.0f), sd = sqrtf(fmaxf(s2 * (1.0f / 64.0f) - mean * mean, 1e-30f));
            const float inv_w = 510.0f / (8.0f * sd), off = 1.0f - (mean - 3.0f * sd) * inv_w;
            { int c = wave; if (c < NC) IDX_LOADA(a, c);
              for (; c < NC; c += 8) {
                idx_scores(S, a, ql, foff, sw, hh, w);
                if (c + 8 < NC) IDX_LOADA(a, c + 8);
#pragma unroll
                for (int sub = 0; sub < 2; ++sub)
#pragma unroll
                    for (int i = 0; i < 16; ++i) { const float f = floorf(__builtin_fmaf(S[sub][i], inv_w, off)); const int bin = (int)fminf(fmaxf(f, 0.f), 511.f);
                        __hip_atomic_fetch_add(HIST + bin * 32 + r, 1u, __ATOMIC_RELAXED, __HIP_MEMORY_SCOPE_WORKGROUP); }
              } }
            __syncthreads();
            { LAS unsigned* PS = (LAS unsigned*)(L + IL_PS); const int rg = wave * 2 + hh; unsigned sum = 0u;
#pragma unroll
              for (int k = 0; k < 32; ++k) sum += HIST[(rg * 32 + k) * 32 + r];
              PS[rg * 32 + r] = sum;
              __syncthreads();
              if (wave == 0 && hh == 0) { const int q = r; unsigned cum = 0u; int rsel = 0; unsigned ps[16];
#pragma unroll
                  for (int k = 0; k < 16; ++k) ps[k] = PS[k * 32 + q];
                  bool found = false; unsigned above = 0u;
#pragma unroll
                  for (int k = 15; k >= 0; --k) { if (!found) { if (cum + ps[k] >= (unsigned)TOPK) { found = true; rsel = k; above = cum; } else cum += ps[k]; } }
                  int bsel = -1; unsigned cb = 0u, ca = 0u; cum = above;
                  for (int k = 31; k >= 0; --k) { const unsigned cn = HIST[(rsel * 32 + k) * 32 + q]; if (bsel < 0) { if (cum + cn >= (unsigned)TOPK) { bsel = rsel * 32 + k; cb = cn; ca = cum; } else cum += cn; } }
                  int slow = (!found || bsel <= 0 || bsel >= 511 || cb > (unsigned)IDX_CAP) ? 1 : 0;
#ifdef IDX_FORCE_SLOW
                  if (((rowb + q) % 251) == 0) slow = 1;
#endif
                  INFO[q * 4 + 0] = bsel; INFO[q * 4 + 1] = TOPK - (int)ca; INFO[q * 4 + 2] = slow; }
            }
            __syncthreads();
            const float blo = (float)INFO[r * 4 + 0], bhi = blo + 1.0f;
            LAS float* scr = (LAS float*)(L + IL_SCR + wave * 4096);
            LAS unsigned* cand = (LAS unsigned*)(L + IL_CAND);
            { int c = wave; if (c < NC) IDX_LOADA(a, c);
            for (; c < NC; c += 8) {
                idx_scores(S, a, ql, foff, sw, hh, w);
                if (c + 8 < NC) IDX_LOADA(a, c + 8);
                unsigned selw = 0u, cndw = 0u;
#pragma unroll
                for (int sub = 0; sub < 2; ++sub)
#pragma unroll
                    for (int i = 0; i < 16; ++i) { const float f = __builtin_fmaf(S[sub][i], inv_w, off); selw = selw * 2u + (f >= bhi ? 1u : 0u); cndw = cndw * 2u + (f >= blo ? 1u : 0u); }
                selw = (selw >> 16) | (selw << 16); cndw = (cndw >> 16) | (cndw << 16);
                mrow[(size_t)c * 16384 + (r * 2 + hh)] = selw;
                unsigned rem = cndw & ~selw;
                if (__any(rem != 0u)) {
#pragma unroll
                    for (int sub = 0; sub < 2; ++sub) {
                        LDS_WAIT();
#pragma unroll
                        for (int i = 0; i < 16; ++i) scr[i * 64 + lane] = S[sub][i];
                        LDS_WAIT();
                        unsigned bits = (rem >> (16 * sub)) & 0xFFFFu;
                        while (bits) { const int bp = 31 - __clz((int)bits), i = 15 - bp; bits &= ~(1u << bp);
                            const float val = scr[i * 64 + lane]; const unsigned key = (unsigned)(64 * c + 32 * sub + crow(i, hh));
                            const unsigned pos = __hip_atomic_fetch_add(CNT + r, 1u, __ATOMIC_RELAXED, __HIP_MEMORY_SCOPE_WORKGROUP);
                            if (pos < (unsigned)IDX_CAP) { cand[(r * IDX_CAP + pos) * 2] = __float_as_uint(val); cand[(r * IDX_CAP + pos) * 2 + 1] = key; } }
                    }
                }
            } }
            VM_WAIT(); __syncthreads();
#pragma unroll 1
            for (int k = 0; k < 4; ++k) { const int q = 4 * wave + k; const unsigned cc = CNT[q]; const int need = INFO[q * 4 + 1];
                if (cc > (unsigned)IDX_CAP) { if (lane == 0) INFO[q * 4 + 2] = 1; continue; }
                if (INFO[q * 4 + 2]) continue;
                for (unsigned i = lane; i < cc; i += 64) { const float si = __uint_as_float(cand[(q * IDX_CAP + i) * 2]); const unsigned ki = cand[(q * IDX_CAP + i) * 2 + 1]; int rank = 0;
                    for (unsigned jx = 0; jx < cc; ++jx) { const float sj = __uint_as_float(cand[(q * IDX_CAP + jx) * 2]); const unsigned kj = cand[(q * IDX_CAP + jx) * 2 + 1]; rank += (sj > si || (sj == si && kj < ki)) ? 1 : 0; }
                    if (rank < need) { const unsigned c = ki >> 6, sub = (ki >> 5) & 1u, row = ki & 31u, hk = (row >> 2) & 1u, rr = (row & 3u) + 4u * (row >> 3);
                        __hip_atomic_fetch_or(mrow + (size_t)c * 16384 + (q * 2 + hk), 1u << (16u * sub + 15u - rr), __ATOMIC_RELAXED, __HIP_MEMORY_SCOPE_AGENT); } }
            }
            __syncthreads();
#pragma unroll 1
            for (int q = 0; q < 32; ++q) {
                if (!INFO[q * 4 + 2]) continue;
                LAS float* s_score = (LAS float*)(L + SL_SCORE); LAS unsigned* s_hist = (LAS unsigned*)(L + SL_HIST); LAS unsigned* s_ctl = (LAS unsigned*)(L + SL_CTL);
                __syncthreads();
                for (int s = tid; s < N; s += NTHR) {
                    const h16* kr = KI + (size_t)(b * SEQ + s) * 64; float kv[64];
#pragma unroll
                    for (int i = 0; i < 8; ++i) { const h16x8 t8 = *(const h16x8*)(kr + 8 * i);
#pragma unroll
                        for (int e = 0; e < 8; ++e) kv[8 * i + e] = (float)t8[e]; }
                    float sc = 0.f;
#pragma unroll 1
                    for (int h = 0; h < 9; ++h) { float d = 0.f;
#pragma unroll
                        for (int c8 = 0; c8 < 8; ++c8) { const h16x8 qv = *(const LAS h16x8*)(L + IL_QL + h * 4096 + q * 128 + ((c8 ^ (q & 7)) << 4));
#pragma unroll
                            for (int e = 0; e < 8; ++e) d += (float)qv[e] * kv[8 * c8 + e]; }
                        sc += (h == 8) ? d : fabsf(d) * WL[q * 8 + h]; }
                    s_score[s] = sc;
                }
                __syncthreads();
                unsigned prefix = 0u, msk = 0u, remaining = TOPK, n_eq = 0u;
                for (int pass = 0; pass < 4; ++pass) {
                    const int shift = 24 - 8 * pass;
                    if (tid < 256) s_hist[tid] = 0u;
                    __syncthreads();
                    for (int s = tid; s < N; s += NTHR) { const unsigned key = ord_key(s_score[s]); if ((key & msk) == prefix) __hip_atomic_fetch_add(s_hist + ((key >> shift) & 255u), 1u, __ATOMIC_RELAXED, __HIP_MEMORY_SCOPE_WORKGROUP); }
                    __syncthreads();
                    if (wave == 0) {
                        const unsigned h0 = s_hist[4 * lane], h1 = s_hist[4 * lane + 1], h2 = s_hist[4 * lane + 2], h3 = s_hist[4 * lane + 3];
                        unsigned v = h0 + h1 + h2 + h3;
#pragma unroll
                        for (int o = 1; o < 64; o <<= 1) { const unsigned tv = __shfl_down(v, o); if (lane + o < 64) v += tv; }
                        unsigned above = __shfl_down(v, 1); if (lane == 63) above = 0u;
                        if (v >= remaining && above < remaining) {
                            unsigned cum = above; int dsel; unsigned rem; unsigned hv;
                            if (cum + h3 >= remaining) { dsel = 3; rem = remaining - cum; hv = h3; }
                            else { cum += h3; if (cum + h2 >= remaining) { dsel = 2; rem = remaining - cum; hv = h2; }
                            else { cum += h2; if (cum + h1 >= remaining) { dsel = 1; rem = remaining - cum; hv = h1; }
                            else { cum += h1; dsel = 0; rem = remaining - cum; hv = h0; } } }
                            s_ctl[0] = (unsigned)(4 * lane + dsel); s_ctl[1] = rem; s_ctl[4] = hv; }
                    }
                    __syncthreads();
                    prefix |= s_ctl[0] << shift; msk |= 255u << shift; remaining = s_ctl[1]; n_eq = s_ctl[4];
                    __syncthreads();
                }
                const unsigned tu = (prefix & 0x80000000u) ? (prefix ^ 0x80000000u) : ~prefix; const float thr = __uint_as_float(tu);
                unsigned idx_cut = 0xFFFFFFFFu;
                if (n_eq > remaining) {
                    if (tid == 0) { unsigned cnt = 0, cut = 0; for (int s = 0; s < N; ++s) if (s_score[s] == thr) { ++cnt; if (cnt == remaining) { cut = (unsigned)s; break; } } s_ctl[3] = cut; }
                    __syncthreads();
                    idx_cut = s_ctl[3];
                }
                int i0 = tid; asm volatile("" : "+v"(i0));
                for (int i = i0; i < NC * 2; i += NTHR) { const int c = i >> 1, hk = i & 1; unsigned word = 0u;
#pragma unroll
                    for (int sub = 0; sub < 2; ++sub)
#pragma unroll
                        for (int rr = 0; rr < 16; ++rr) { const int key = 64 * c + 32 * sub + crow(rr, hk); const float sc = s_score[key];
                            if (sc > thr || (sc == thr && (unsigned)key <= idx_cut)) word |= 1u << (16 * sub + 15 - rr); }
                    mrow[(size_t)c * 16384 + (q * 2 + hk)] = word; }
                __syncthreads();
            }
#undef IDX_LOADA
        }
    }
}

namespace at {
typedef short s16x4 __attribute__((ext_vector_type(4)));
constexpr int NSLOT = 3, SLOTB = 8192;
constexpr int LDS_K = 0, LDS_V = NSLOT * SLOTB, LDS_WS = 2 * NSLOT * SLOTB, LDS_TB = LDS_WS + 8 * 256, LDS_OST = 53248, LDS_BYTES = LDS_OST + 8 * 4096;
constexpr float LOG2E = 1.4426950408889634f;
__device__ __forceinline__ void glds16(const void* gsrc, unsigned lds_dst) { unsigned keep;
    asm volatile("s_mov_b32 %0, m0\n\ts_mov_b32 m0, %2\n\ts_nop 0\n\tglobal_load_lds_dwordx4 %1, off\n\ts_mov_b32 m0, %0" : "=&s"(keep) : "v"(gsrc), "s"(lds_dst) : "memory"); }
#define AT_WAIT_BAR(N) asm volatile("s_waitcnt vmcnt(" #N ") lgkmcnt(0)\n\ts_barrier" ::: "memory")
__device__ __forceinline__ h16x8 vtr8(const LAS unsigned char* p0, const LAS unsigned char* p1) {
    const s16x4 lo = __builtin_amdgcn_ds_read_tr16_b64_v4i16((LAS s16x4*)p0), hi = __builtin_amdgcn_ds_read_tr16_b64_v4i16((LAS s16x4*)p1);
    typedef short s16x8 __attribute__((ext_vector_type(8)));
    const s16x8 v = {lo[0], lo[1], lo[2], lo[3], hi[0], hi[1], hi[2], hi[3]}; return __builtin_bit_cast(h16x8, v); }
__device__ __forceinline__ h16x8 pack8(const f32x16& p, int b) {
    v4u w; w.x = cvt_pk_h16(p[b], p[b + 1]); w.y = cvt_pk_h16(p[b + 2], p[b + 3]); w.z = cvt_pk_h16(p[b + 4], p[b + 5]); w.w = cvt_pk_h16(p[b + 6], p[b + 7]); return __builtin_bit_cast(h16x8, w); }

__device__ __forceinline__ void attn_unit(int b, int h, int qb, const h16* Q, const h16* K, const h16* V, const unsigned* MASK, const float* relb, h16* O, LAS unsigned char* shm) {
    int tid_o = threadIdx.x; asm volatile("" : "+v"(tid_o));
    const int tid = tid_o, lane = tid & 63, r32 = lane & 31, hi = lane >> 5; const int wid = __builtin_amdgcn_readfirstlane(tid >> 6);
    const long rowbase = (long)b * SEQ; const int q0 = qb * 256, qw = q0 + wid * 32, cq = qw >> 6, NT = 4 * qb + 4;
    const h16* Qw = Q + (rowbase + qw) * 512 + h * 64;
    const h16* Kh = K + rowbase * 512 + h * 64; const h16* Vh = V + rowbase * 512 + h * 64;
    const unsigned lds0 = (unsigned)(uintptr_t)shm;
    LAS float* wsf = (LAS float*)(shm + LDS_WS) + wid * 64;
    LAS float* Tb = (LAS float*)(shm + LDS_TB);
    const h16* ksrc = Kh + (long)lane * 512 + wid * 8;
    const h16* vsrc = Vh + (long)(16 * (wid & 3) + (lane >> 2)) * 512 + (wid >> 2) * 32 + (lane & 3) * 8;
    const unsigned kdst = lds0 + LDS_K + wid * 1024, vdst = lds0 + LDS_V + wid * 1024;
#define AT_DMA_K(t, slot) glds16(ksrc + (long)(t) * 64 * 512, (unsigned)__builtin_amdgcn_readfirstlane(kdst + (slot)))
#define AT_DMA_V(t, slot) glds16(vsrc + (long)(t) * 64 * 512, (unsigned)__builtin_amdgcn_readfirstlane(vdst + (slot)))
    AT_DMA_K(0, 0); AT_DMA_V(0, 0); AT_DMA_K(1, SLOTB); AT_DMA_V(1, SLOTB);
    if (tid < 255) Tb[tid] = relb[t5_bucket(tid - 191) * 8 + h] * LOG2E;
    const float b15l = relb[15 * 8 + h] * LOG2E;
    h16x8 qr[4];
#pragma unroll
    for (int d0 = 0; d0 < 4; ++d0) qr[d0] = *(const h16x8*)(Qw + (long)r32 * 512 + d0 * 16 + hi * 8);
    const unsigned* mk = MASK + ((size_t)(b * 128) * 8192 + (qw + r32)) * 2 + hi;
    const LAS unsigned char* kp0 = shm + LDS_K + hi * 1024 + r32 * 16;
    const LAS unsigned char* vp0 = shm + LDS_V + ((lane >> 4) & 1) * 32 + (lane & 3) * 8 + (4 * hi + ((lane & 15) >> 2)) * 64;
    f32x16 o[2]; o[0] = f32x16{}; o[1] = f32x16{};
    float m = -1e30f, l = 0.f;
    int slot = 0, slot2 = 2 * SLOTB;
    unsigned mw_next = mk[0];
#pragma unroll 1
    for (int t = 0; t < NT; ++t) {
        const unsigned mw = mw_next; if (t + 1 < NT) mw_next = mk[(size_t)(t + 1) * 16384];
        if (t + 1 < NT) { AT_WAIT_BAR(2); } else { AT_WAIT_BAR(0); }
        if (t + 2 < NT) { AT_DMA_K(t + 2, slot2); AT_DMA_V(t + 2, slot2); }
        if (t <= cq) {
            const bool nearb = (t >= cq - 2);
            const float c0 = nearb ? 0.f : b15l;
            f32x16 p0, p1;
#pragma unroll
            for (int r = 0; r < 16; ++r) { p0[r] = c0; p1[r] = c0; }
            const LAS unsigned char* kb = kp0 + slot;
#pragma unroll
            for (int d0 = 0; d0 < 4; ++d0) { const h16x8 k0 = *(const LAS h16x8*)(kb + d0 * 2048), k1 = *(const LAS h16x8*)(kb + d0 * 2048 + 512);
                p0 = __builtin_amdgcn_mfma_f32_32x32x16_f16(k0, qr[d0], p0, 0, 0, 0); p1 = __builtin_amdgcn_mfma_f32_32x32x16_f16(k1, qr[d0], p1, 0, 0, 0); }
            if (nearb) { const int ib = 64 * t - (qw + r32) + 191 + 4 * hi;
#pragma unroll
                for (int r = 0; r < 16; ++r) { const int kk = (r & 3) + 8 * (r >> 2); p0[r] += Tb[ib + kk]; p1[r] += Tb[ib + 32 + kk]; } }
#pragma unroll
            for (int r = 0; r < 16; ++r) { p0[r] = ((mw >> (15 - r)) & 1u) ? p0[r] : -INFINITY; p1[r] = ((mw >> (31 - r)) & 1u) ? p1[r] : -INFINITY; }
            float mx = fmaxf(p0[0], p1[0]);
#pragma unroll
            for (int r = 1; r < 16; ++r) mx = fmaxf(mx, fmaxf(p0[r], p1[r]));
            { auto rr = __builtin_amdgcn_permlane32_swap(__float_as_uint(mx), __float_as_uint(mx), false, false); mx = fmaxf(__uint_as_float(rr[0]), __uint_as_float(rr[1])); }
            const float mn = fmaxf(m, mx), alpha = __builtin_amdgcn_exp2f(m - mn); m = mn;
            float ps = 0.f;
#pragma unroll
            for (int r = 0; r < 16; ++r) { p0[r] = __builtin_amdgcn_exp2f(p0[r] - mn); p1[r] = __builtin_amdgcn_exp2f(p1[r] - mn); ps += p0[r] + p1[r]; }
            l = l * alpha + ps;
            if (!__all(alpha == 1.0f)) {
                if (hi == 0) wsf[r32] = alpha;
                LDS_WAIT();
#pragma unroll
                for (int r = 0; r < 16; ++r) { const float f = wsf[crow(r, hi)]; o[0][r] *= f; o[1][r] *= f; }
            }
            const h16x8 pa0 = pack8(p0, 0), pa1 = pack8(p0, 8), pa2 = pack8(p1, 0), pa3 = pack8(p1, 8);
            const LAS unsigned char* vb = vp0 + slot;
#pragma unroll
            for (int d0 = 0; d0 < 2; ++d0) {
                const h16x8 v0 = vtr8(vb + d0 * 4096, vb + d0 * 4096 + 512), v1 = vtr8(vb + d0 * 4096 + 1024, vb + d0 * 4096 + 1024 + 512);
                const h16x8 v2 = vtr8(vb + d0 * 4096 + 2048, vb + d0 * 4096 + 2048 + 512), v3 = vtr8(vb + d0 * 4096 + 3072, vb + d0 * 4096 + 3072 + 512);
                o[d0] = __builtin_amdgcn_mfma_f32_32x32x16_f16(pa0, v0, o[d0], 0, 0, 0); o[d0] = __builtin_amdgcn_mfma_f32_32x32x16_f16(pa1, v1, o[d0], 0, 0, 0);
                o[d0] = __builtin_amdgcn_mfma_f32_32x32x16_f16(pa2, v2, o[d0], 0, 0, 0); o[d0] = __builtin_amdgcn_mfma_f32_32x32x16_f16(pa3, v3, o[d0], 0, 0, 0); }
        }
        slot2 = slot; slot = (slot == (NSLOT - 1) * SLOTB) ? 0 : slot + SLOTB;
    }
    { auto rr = __builtin_amdgcn_permlane32_swap(__float_as_uint(l), __float_as_uint(l), false, false); l = __uint_as_float(rr[0]) + __uint_as_float(rr[1]); }
    if (hi == 0) wsf[32 + r32] = l;
    LDS_WAIT();
    h16* Ow = O + (rowbase + qw) * 512 + h * 64;
    { LAS h16* stg = (LAS h16*)(shm + LDS_OST) + wid * 2048;
#pragma unroll
      for (int r = 0; r < 16; ++r) { const int orow = crow(r, hi); const float rl = 1.0f / wsf[32 + orow];
#pragma unroll
          for (int d0 = 0; d0 < 2; ++d0) stg[orow * 64 + d0 * 32 + r32] = (h16)(o[d0][r] * rl); }
      LDS_WAIT();
#pragma unroll
      for (int i = 0; i < 4; ++i) { const int row = i * 8 + (lane >> 3), ch = lane & 7; const v4u v = *(const LAS v4u*)(stg + row * 64 + ch * 8); *(GAS v4u*)(Ow + (long)row * 512 + ch * 8) = v; } }
    asm volatile("s_waitcnt lgkmcnt(0)\n\ts_barrier" ::: "memory");
#undef AT_DMA_K
#undef AT_DMA_V
}
__device__ __forceinline__ void attn_phase(Frame& F, const Args& A) {
    unsigned char* ws = A.ws;
    for (int v = F.vcu; v < 256; v += F.G) {
        const int bh = v >> 4, s = v & 15;
#pragma unroll 1
        for (int i = 0; i < 2; ++i) attn_unit(bh >> 3, bh & 7, i ? 31 - s : s, (const h16*)(ws + WS_Q), (const h16*)(ws + WS_K), (const h16*)(ws + WS_V), (const unsigned*)(ws + WS_MASK), A.in[12], (h16*)(ws + WS_O), F.lds + RING_OFF);
    }
}
#undef AT_WAIT_BAR
}

__device__ __forceinline__ void attn_norm_phase(Frame& F, const Args& A) {
    unsigned char* ws = A.ws; const h16* O = (const h16*)(ws + WS_O); h16* MERGED = (h16*)(ws + WS_MERGED);
    const f32x4 g0 = *(const f32x4*)(A.in[20] + 8 * F.lane), g1 = *(const f32x4*)(A.in[20] + 8 * F.lane + 4);
    const int gw = F.vcu * NWAVES + F.wave, NGW = F.G * NWAVES;
    for (int row = gw; row < M; row += NGW) {
        const h16x8 v = *(const h16x8*)(O + (size_t)row * 512 + 8 * F.lane); float f[8]; float s = 0.f;
#pragma unroll
        for (int e = 0; e < 8; ++e) { f[e] = (float)v[e]; s += f[e] * f[e]; }
        const float rstd = 1.0f / sqrtf(wave_sum(s) * (1.0f / DATT) + EPS);
        v4u o; o.x = cvt_pk_h16(f[0] * rstd * g0.x, f[1] * rstd * g0.y); o.y = cvt_pk_h16(f[2] * rstd * g0.z, f[3] * rstd * g0.w);
        o.z = cvt_pk_h16(f[4] * rstd * g1.x, f[5] * rstd * g1.y); o.w = cvt_pk_h16(f[6] * rstd * g1.z, f[7] * rstd * g1.w);
        *(GAS v4u*)(MERGED + (size_t)row * 1024 + 8 * F.lane) = o;
    }
}

__global__ void __launch_bounds__(NTHR, 2) fwd_kernel(Args args) {
    extern __shared__ __attribute__((aligned(16))) unsigned char lds[];
    Frame F;
    F.lds = (LAS unsigned char*)lds;
    F.MISC = (volatile LAS unsigned*)(F.lds + MISC_OFF);
    F.tid = threadIdx.x; F.lane = F.tid & 63; F.wave = __builtin_amdgcn_readfirstlane(F.tid >> 6);
    F.G = gridDim.x; { const int bx = blockIdx.x; F.vcu = (F.G % 8 == 0) ? (bx % 8) * (F.G / 8) + bx / 8 : bx; }
    unsigned char* ws = args.ws;
    F.ctl = (gu32*)(ws + WS_CTL);
    for (int u = F.tid; u < (LDS_BYTES - LDSCTL_OFF) / 4; u += NTHR) ((LAS unsigned*)(F.lds + LDSCTL_OFF))[u] = 0u;
    __syncthreads();
    XcdBarrier bar; bar.bar = (unsigned*)(F.ctl + CW_BAR); bar.x = 0; bar.st = nullptr;
    if (N_LAUNCHES == 1) bar = xcd_barrier_post((unsigned*)(F.ctl + CW_BAR), F.MISC + 8);
    const int lo = args.ph_lo, hi = args.ph_hi;
#define IN(k) (lo <= (k) && (k) < hi)
#define SEAM(k) do { if (IN(k) && IN((k) + 1)) xcd_barrier(bar); } while (0)
    const float* mod = (const float*)(ws + WS_MOD);
    h16* H = (h16*)(ws + WS_H); h16* ACT = (h16*)(ws + WS_ACT); float* Y = (float*)(ws + WS_Y);
    const int bx = (int)blockIdx.x;

    if (IN(0)) { p0_prologue(F, args); } SEAM(0);
    if (IN(1)) { thin_phase<false, true>(F, mod, nullptr, nullptr, 0.f, 0, args.in[0], nullptr, args.in[4], 0, 1, H); } SEAM(1);
    if (IN(2)) { pg8::Gemm g{H, (const h16*)(ws + WS_W1GU), M, NGU, D}; pg8::StaticOrder S; S.init(M, NGU, F.G, bx);
        pg8::EpiSwiGLU E{ACT, FF}; pg8::gemm_phase<pg8::EpiSwiGLU, pg8::StaticOrder, true>(F.lds + RING_OFF, g, S, E); } SEAM(2);
    if (IN(3)) { pg8::Gemm g{ACT, (const h16*)(ws + WS_W1D), M, D, FF}; pg8::StaticOrder S; S.init(M, D, F.G, bx);
        pg8::EpiF32 E{Y, D}; pg8::gemm_phase<pg8::EpiF32, pg8::StaticOrder, false>(F.lds + RING_OFF, g, S, E); } SEAM(3);
    if (IN(4)) { thin_phase<true, true>(F, mod, Y, args.in[5], 0.5f, 2, args.in[0], args.out, args.in[9], 3, 4, H); } SEAM(4);
    if (IN(5)) { pg8::Gemm g{H, (const h16*)(ws + WS_WIN), M, NPROJ, D}; pg8::StaticOrder S; S.init(M, NPROJ, F.G, bx);
        pg8::EpiProj E{ws + WS_Q, (size_t)(WS_K - WS_Q), (h16*)(ws + WS_QS), (h16*)(ws + WS_KI), (float*)(ws + WS_WI), (h16*)(ws + WS_LRU)};
        pg8::gemm_phase<pg8::EpiProj, pg8::StaticOrder, true>(F.lds + RING_OFF, g, S, E); } SEAM(5);
    if (IN(6)) { lru_phase<false>(F, args); } if (IN(6) && IN(7)) __syncthreads();
    if (IN(7)) { idx_phase(F, args); } SEAM(7);
    if (IN(8)) { lru_phase<true>(F, args); } if (IN(8) && IN(9)) __syncthreads();
    if (IN(9)) { at::attn_phase(F, args); } SEAM(9);
    if (IN(10)) { attn_norm_phase(F, args); } SEAM(10);
    if (IN(11)) { pg8::Gemm g{(const h16*)(ws + WS_MERGED), (const h16*)(ws + WS_WOUT), M, D, D}; pg8::StaticOrder S; S.init(M, D, F.G, bx);
        pg8::EpiF32 E{Y, D}; pg8::gemm_phase<pg8::EpiF32, pg8::StaticOrder, false>(F.lds + RING_OFF, g, S, E); } SEAM(11);
    if (IN(12)) { thin_phase<true, true>(F, mod, Y, args.in[10], 1.0f, 5, args.out, args.out, args.in[23], 6, 7, H); } SEAM(12);
    if (IN(13)) { pg8::Gemm g{H, (const h16*)(ws + WS_W2GU), M, NGU, D}; pg8::StaticOrder S; S.init(M, NGU, F.G, bx);
        pg8::EpiSwiGLU E{ACT, FF}; pg8::gemm_phase<pg8::EpiSwiGLU, pg8::StaticOrder, true>(F.lds + RING_OFF, g, S, E); } SEAM(13);
    if (IN(14)) { pg8::Gemm g{ACT, (const h16*)(ws + WS_W2D), M, D, FF}; pg8::StaticOrder S; S.init(M, D, F.G, bx);
        pg8::EpiF32 E{Y, D}; pg8::gemm_phase<pg8::EpiF32, pg8::StaticOrder, false>(F.lds + RING_OFF, g, S, E); } SEAM(14);
    if (IN(15)) { thin_phase<true, false>(F, mod, Y, args.in[24], 0.5f, 8, args.out, args.out, nullptr, 0, 0, nullptr); }
#undef IN
#undef SEAM
}

extern "C" void kernel_launch(void* const* d_in, const int* in_sizes, int n_in, void* d_out, int out_size, void* d_ws, size_t ws_size, hipStream_t stream) {
    static int grid = 0;
    if (grid == 0) {
        if (n_in != 28 || in_sizes[0] != M * D || out_size != M * D || ws_size < WS_END) { fprintf(stderr, "kernel_launch: unexpected shapes (n_in %d, in0 %d, out %d, ws %zu); nothing launched\n", n_in, n_in > 0 ? in_sizes[0] : -1, out_size, ws_size); grid = -1; return; }
        int dev = 0, cus = 0, per_cu = 0;
        if (hipGetDevice(&dev) != hipSuccess || hipDeviceGetAttribute(&cus, hipDeviceAttributeMultiprocessorCount, dev) != hipSuccess) { grid = -1; return; }
        if (hipFuncSetAttribute((const void*)fwd_kernel, hipFuncAttributeMaxDynamicSharedMemorySize, LDS_BYTES) != hipSuccess) { fprintf(stderr, "kernel_launch: hipFuncSetAttribute failed\n"); grid = -1; return; }
        if (hipOccupancyMaxActiveBlocksPerMultiprocessor(&per_cu, (const void*)fwd_kernel, NTHR, LDS_BYTES) != hipSuccess || per_cu < 1) { fprintf(stderr, "kernel_launch: occupancy query reports %d\n", per_cu); }
        (void)hipGetLastError();
        grid = cus;
    }
    if (grid < 0) return;
    if (hipMemsetAsync((char*)d_ws + WS_CTL, 0, CTL_ZERO_BYTES, stream) != hipSuccess) return;
    Args a{};
    for (int i = 0; i < 28; ++i) a.in[i] = (const float*)d_in[i];
    a.out = (float*)d_out; a.ws = (unsigned char*)d_ws;
    if (N_LAUNCHES == 1) { a.ph_lo = 0; a.ph_hi = N_PHASES; a.li = 0; hipLaunchKernelGGL(fwd_kernel, dim3(grid), dim3(NTHR), LDS_BYTES, stream, a); }
    else { for (int p = 0; p < N_PHASES; ++p) { a.ph_lo = p; a.ph_hi = p + 1; a.li = p; const int reps = (p == PROBE_PHASE) ? 2 : 1;
        for (int rr = 0; rr < reps; ++rr) hipLaunchKernelGGL(fwd_kernel, dim3(grid), dim3(NTHR), LDS_BYTES, stream, a); } }
}
```

```cpp
#include <hip/hip_runtime.h>
#include <cstdio>
#include <cstdint>

#ifndef PROBE_PHASE
#define PROBE_PHASE -1
#endif
#ifndef MK_N_LAUNCHES
#define MK_N_LAUNCHES 1
#endif

namespace pg8 {
#define PG8_LAS __attribute__((address_space(3)))
typedef _Float16 h16;
typedef _Float16 h16x8 __attribute__((ext_vector_type(8)));
typedef _Float16 h16x2 __attribute__((ext_vector_type(2)));
typedef float f32x4 __attribute__((ext_vector_type(4)));
typedef float f32x2 __attribute__((ext_vector_type(2)));
typedef unsigned u32x4 __attribute__((ext_vector_type(4)));
constexpr int BM = 256, BK = 64, HALF = 128, HTB = HALF * BK * 2, STAGE_BYTES = 8 * HTB, NXCD = 8, WGM = 8;

__host__ __device__ __forceinline__ int lds_byte(int r, int c) { const int st = (r >> 4) * 2 + (c >> 5), rr = r & 15, cc = c & 31, ob = rr * 64 + cc * 2; return st * 1024 + (ob ^ (((ob >> 9) & 1) << 5)); }
__host__ __device__ __forceinline__ void stage_rc(int b, int& R, int& C) { const int st = b / 1024, sb = b % 1024, swz = sb ^ (((sb >> 9) & 1) << 5); R = (st >> 1) * 16 + swz / 64; C = (st & 1) * 32 + (swz % 64) / 2; }
__host__ __device__ __forceinline__ int perm32(int rho) { const int n = rho >> 4, i = rho & 15; return 8 * (i >> 2) + 4 * n + (i & 3); }

struct Unit { int pm, pn; };
struct Gemm { const h16* A; const h16* Bt; int M, N, K; };

struct StaticOrder {
    int nM, nN, nwg, G, c;
    __host__ __device__ void init(int M, int N, int G_, int c_) { nM = M / BM; nN = N / BM; nwg = nM * nN; G = G_; c = c_; }
    __host__ __device__ bool next(int i, Unit& u) const {
        const long L = (long)i * G + c; if (L >= nwg) return false;
        int wgid = (int)L; { const int q = nwg / NXCD, r = nwg % NXCD, xcd = wgid % NXCD, off = wgid / NXCD; wgid = (xcd < r ? xcd * (q + 1) : r * (q + 1) + (xcd - r) * q) + off; }
        const int nig = WGM * nN, gid = wgid / nig, fm = gid * WGM, gsz = (nM - fm) < WGM ? (nM - fm) : WGM;
        u.pm = fm + ((wgid % nig) % gsz); u.pn = (wgid % nig) / gsz; return true;
    }
    __device__ __forceinline__ void a_ready(const Unit&) const {}
    __device__ __forceinline__ void done(const Unit&) const {}
};

__device__ __forceinline__ unsigned cvt_pk_h16(float lo, float hi) { f32x2 v = {lo, hi}; h16x2 h = __builtin_convertvector(v, h16x2); return __builtin_bit_cast(unsigned, h); }

struct EpiF32 {
    static constexpr bool PERM = false, AFTER_DRAIN = false;
    float* C; int ldc;
    __device__ __forceinline__ void operator()(const f32x4 (&acc)[2][2][4][2], const Unit& u, int wr, int wc, int fr, int fq) const {
        const int row0 = u.pm * BM + wr * 64 + fr, col0 = u.pn * BM + wc * 32 + 4 * fq;
#pragma unroll
        for (int ai = 0; ai < 2; ++ai)
#pragma unroll
            for (int m = 0; m < 4; ++m) { float* rowp = C + (size_t)(row0 + ai * HALF + m * 16) * ldc + col0;
#pragma unroll
                for (int bj = 0; bj < 2; ++bj)
#pragma unroll
                    for (int n = 0; n < 2; ++n) *(f32x4*)(rowp + bj * HALF + n * 16) = acc[ai][bj][m][n]; }
    }
};
struct EpiSwiGLU {
    static constexpr bool PERM = true, AFTER_DRAIN = false;
    h16* O; int ldc;
    __device__ __forceinline__ void operator()(const f32x4 (&acc)[2][2][4][2], const Unit& u, int wr, int wc, int fr, int fq) const {
        const int row0 = u.pm * BM + wr * 64 + fr, col0 = u.pn * HALF + wc * 32 + 8 * fq;
#pragma unroll
        for (int ai = 0; ai < 2; ++ai)
#pragma unroll
            for (int m = 0; m < 4; ++m) { h16* rowp = O + (size_t)(row0 + ai * HALF + m * 16) * ldc + col0;
                float v[8];
#pragma unroll
                for (int n = 0; n < 2; ++n)
#pragma unroll
                    for (int i = 0; i < 4; ++i) { const float g = acc[ai][0][m][n][i], up = acc[ai][1][m][n][i];
                        const float e = __builtin_amdgcn_exp2f(-1.4426950408889634f * g); v[4 * n + i] = g * __builtin_amdgcn_rcpf(1.0f + e) * up; }
                u32x4 w; w.x = cvt_pk_h16(v[0], v[1]); w.y = cvt_pk_h16(v[2], v[3]); w.z = cvt_pk_h16(v[4], v[5]); w.w = cvt_pk_h16(v[6], v[7]);
                *(u32x4*)rowp = w; }
    }
};
struct EpiProj {
    static constexpr bool PERM = true, AFTER_DRAIN = false;
    unsigned char* qkv; size_t qkv_stride; h16* QS; h16* KI; float* WI; h16* LRU;
    __device__ __forceinline__ void store_h16(const f32x4 (&acc)[2][2][4][2], h16* base, int ld, int row0, int c0, float sc) const {
#pragma unroll
        for (int ai = 0; ai < 2; ++ai)
#pragma unroll
            for (int m = 0; m < 4; ++m) { h16* rowp = base + (size_t)(row0 + ai * HALF + m * 16) * ld + c0;
#pragma unroll
                for (int bj = 0; bj < 2; ++bj) { const f32x4 v0 = acc[ai][bj][m][0] * sc, v1 = acc[ai][bj][m][1] * sc;
                    u32x4 w; w.x = cvt_pk_h16(v0[0], v0[1]); w.y = cvt_pk_h16(v0[2], v0[3]); w.z = cvt_pk_h16(v1[0], v1[1]); w.w = cvt_pk_h16(v1[2], v1[3]);
                    *(u32x4*)(rowp + bj * HALF) = w; } }
    }
    __device__ __forceinline__ void operator()(const f32x4 (&acc)[2][2][4][2], const Unit& u, int wr, int wc, int fr, int fq) const {
        const int row0 = u.pm * BM + wr * 64 + fr, cw = wc * 32 + 8 * fq; const int pn = u.pn;
        if (pn < 6) { store_h16(acc, (h16*)(qkv + (size_t)(pn >> 1) * qkv_stride), 512, row0, (pn & 1) * 256 + cw, pn < 2 ? 0.125f * 1.4426950408889634f : 1.0f); }
        else if (pn >= 9) { store_h16(acc, LRU, 1024, row0, (pn - 9) * 256 + cw, 1.0f); }
        else if (pn < 8) { store_h16(acc, QS, 512, row0, (pn - 6) * 256 + cw, 0.125f); }
        else {
#pragma unroll
            for (int ai = 0; ai < 2; ++ai)
#pragma unroll
                for (int m = 0; m < 4; ++m) { const size_t row = (size_t)(row0 + ai * HALF + m * 16); const f32x4 v0 = acc[ai][0][m][0], v1 = acc[ai][0][m][1];
                    if (cw < 64) { u32x4 w; w.x = cvt_pk_h16(v0[0], v0[1]); w.y = cvt_pk_h16(v0[2], v0[3]); w.z = cvt_pk_h16(v1[0], v1[1]); w.w = cvt_pk_h16(v1[2], v1[3]); *(u32x4*)(KI + row * 64 + cw) = w; }
                    else if (cw == 64) { const float sc = 0.5f * 0.35355339059327373f; *(f32x4*)(WI + row * 8) = v0 * sc; *(f32x4*)(WI + row * 8 + 4) = v1 * sc; } }
        }
    }
};

template <class Epi, class Sched, bool ALIGN_EPI = false>
__device__ __forceinline__ void gemm_phase(PG8_LAS unsigned char* lds, const Gemm g, const Sched& S, const Epi& E) {
    const int tid = threadIdx.x, wid = __builtin_amdgcn_readfirstlane(tid >> 6), lane = tid & 63, wr = wid >> 2, wc = wid & 3, fr = lane & 15, fq = lane >> 4;
    const int K = g.K, nt = K / BK;
    unsigned voffA[2], voffB[2];
#pragma unroll
    for (int i = 0; i < 2; ++i) { int R, C; stage_rc(tid * 16 + i * 8192, R, C); const int Rb = Epi::PERM ? ((R & ~31) + perm32(R & 31)) : R;
        voffA[i] = (unsigned)(R * K + C) * 2u; voffB[i] = (unsigned)(Rb * K + C) * 2u; }
    const size_t kstep = (size_t)(BK * 2);
    const size_t hstep = (size_t)HALF * K * 2;
    const size_t tstep = 2 * hstep;
    const unsigned ldsw = (unsigned)wid * 1024u;
    const int aoff = lds_byte(wr * 64 + fr, fq * 8), boff = lds_byte(wc * 32 + fr, fq * 8);
#define PG8_SA(b, h) (((b) * 2 + (h)) * HTB)
#define PG8_SB(b, h) ((4 + (b) * 2 + (h)) * HTB)
#define PG8_STAGE(bufoff, gbase, voff) do { _Pragma("unroll") for (int _i = 0; _i < 2; ++_i) \
        __builtin_amdgcn_global_load_lds((const unsigned*)((const char*)(gbase) + (voff)[_i]), (PG8_LAS unsigned*)(lds + (bufoff) + ldsw + _i * 8192), 16, 0, 0); } while (0)
#define PG8_LDA(dst, b, h) do { _Pragma("unroll") for (int m = 0; m < 4; ++m) _Pragma("unroll") for (int k = 0; k < 2; ++k) dst[m][k] = *(const PG8_LAS h16x8*)(lds + PG8_SA(b, h) + aoff + m * 2048 + k * 1024); } while (0)
#define PG8_LDB(dst, b, h) do { _Pragma("unroll") for (int n = 0; n < 2; ++n) _Pragma("unroll") for (int k = 0; k < 2; ++k) dst[n][k] = *(const PG8_LAS h16x8*)(lds + PG8_SB(b, h) + boff + n * 2048 + k * 1024); } while (0)
#define PG8_MMA(ai, bj, At, Bt) do { __builtin_amdgcn_s_setprio(1); _Pragma("unroll") for (int m = 0; m < 4; ++m) _Pragma("unroll") for (int n = 0; n < 2; ++n) _Pragma("unroll") for (int k = 0; k < 2; ++k) \
        acc[ai][bj][m][n] = __builtin_amdgcn_mfma_f32_16x16x32_f16(Bt[n][k], At[m][k], acc[ai][bj][m][n], 0, 0, 0); __builtin_amdgcn_s_setprio(0); } while (0)
#define PG8_WAIT_V(n) asm volatile("s_waitcnt vmcnt(" #n ")" ::: "memory")
#define PG8_WAIT_L(n) asm volatile("s_waitcnt lgkmcnt(" #n ")" ::: "memory")
#define PG8_BAR __builtin_amdgcn_s_barrier()
#define PG8_SCHED __builtin_amdgcn_sched_barrier(0)
    Unit cur, nxt; int ui = 0;
    if (!S.next(0, cur)) return;
    f32x4 acc[2][2][4][2];
#pragma unroll
    for (int a = 0; a < 2; ++a)
#pragma unroll
        for (int b = 0; b < 2; ++b)
#pragma unroll
            for (int m = 0; m < 4; ++m)
#pragma unroll
                for (int n = 0; n < 2; ++n) acc[a][b][m][n] = (f32x4){0.f, 0.f, 0.f, 0.f};
    h16x8 At[4][2], B0[2][2], B1[2][2];
    const char* cA = (const char*)g.A + (size_t)cur.pm * tstep; const char* cB = (const char*)g.Bt + (size_t)cur.pn * tstep;
    S.a_ready(cur);
    PG8_STAGE(PG8_SB(0, 0), cB, voffB); PG8_STAGE(PG8_SB(0, 1), cB + hstep, voffB); PG8_STAGE(PG8_SA(0, 0), cA, voffA); PG8_STAGE(PG8_SA(0, 1), cA + hstep, voffA);
    if (wr == 1) PG8_BAR;
    PG8_WAIT_V(2); PG8_BAR;
    PG8_STAGE(PG8_SB(1, 0), cB + kstep, voffB); PG8_STAGE(PG8_SA(1, 0), cA + kstep, voffA); PG8_STAGE(PG8_SB(1, 1), cB + hstep + kstep, voffB);
    PG8_WAIT_V(6); PG8_BAR;
    for (;;) {
        const bool has_next = S.next(ui + 1, nxt);
        const char* nA = has_next ? (const char*)g.A + (size_t)nxt.pm * tstep : cA; const char* nB = has_next ? (const char*)g.Bt + (size_t)nxt.pn * tstep : cB;
        for (int t = 0; t < nt; t += 2) {
            const bool last = (t == nt - 2);
            const char* a1 = cA + (size_t)(t + 1) * kstep;
            const char* a2 = last ? nA : cA + (size_t)(t + 2) * kstep; const char* b2 = last ? nB : cB + (size_t)(t + 2) * kstep;
            const char* a3 = a2 + kstep; const char* b3 = b2 + kstep;
            if (last && has_next) S.a_ready(nxt);
            PG8_LDB(B0, 0, 0); PG8_LDB(B1, 0, 1); PG8_SCHED; PG8_LDA(At, 0, 0); PG8_STAGE(PG8_SA(1, 1), a1 + hstep, voffA);
            PG8_WAIT_V(8); PG8_WAIT_L(0); PG8_BAR; PG8_MMA(0, 0, At, B0); PG8_MMA(0, 1, At, B1); PG8_BAR; PG8_SCHED;
            PG8_LDA(At, 0, 1); PG8_STAGE(PG8_SB(0, 0), b2, voffB); PG8_STAGE(PG8_SB(0, 1), b2 + hstep, voffB); PG8_STAGE(PG8_SA(0, 0), a2, voffA);
            PG8_WAIT_V(8); PG8_WAIT_L(0); PG8_BAR; PG8_MMA(1, 0, At, B0); PG8_MMA(1, 1, At, B1); PG8_BAR; PG8_SCHED;
            PG8_LDB(B0, 1, 0); PG8_LDB(B1, 1, 1); PG8_SCHED; PG8_LDA(At, 1, 0); PG8_STAGE(PG8_SA(0, 1), a2 + hstep, voffA);
            PG8_WAIT_V(8); PG8_WAIT_L(0); PG8_BAR; PG8_MMA(0, 0, At, B0); PG8_MMA(0, 1, At, B1); PG8_BAR; PG8_SCHED;
            PG8_LDA(At, 1, 1); PG8_STAGE(PG8_SB(1, 0), b3, voffB); PG8_STAGE(PG8_SB(1, 1), b3 + hstep, voffB); PG8_STAGE(PG8_SA(1, 0), a3, voffA);
            PG8_WAIT_V(8); PG8_WAIT_L(0); PG8_BAR; PG8_MMA(1, 0, At, B0); PG8_MMA(1, 1, At, B1); PG8_BAR; PG8_SCHED;
        }
        if constexpr (ALIGN_EPI) { if (wr == 0) PG8_BAR; }
        E(acc, cur, wr, wc, fr, fq); S.done(cur);
        if (!has_next) break;
#pragma unroll
        for (int a = 0; a < 2; ++a)
#pragma unroll
            for (int b = 0; b < 2; ++b)
#pragma unroll
                for (int m = 0; m < 4; ++m)
#pragma unroll
                    for (int n = 0; n < 2; ++n) acc[a][b][m][n] = (f32x4){0.f, 0.f, 0.f, 0.f};
        cur = nxt; cA = nA; cB = nB; ++ui;
        if constexpr (ALIGN_EPI) { if (wr == 1) PG8_BAR; }
    }
    PG8_WAIT_V(0);
    if constexpr (!ALIGN_EPI) { if (wr == 0) PG8_BAR; }
    PG8_BAR;
#undef PG8_SA
#undef PG8_SB
#undef PG8_STAGE
#undef PG8_LDA
#undef PG8_LDB
#undef PG8_MMA
#undef PG8_WAIT_V
#undef PG8_WAIT_L
#undef PG8_BAR
#undef PG8_SCHED
}
}

constexpr int NWAVES = 8, NTHR = NWAVES * 64;
constexpr int N_LAUNCHES = MK_N_LAUNCHES;
constexpr int N_PHASES = 16;
constexpr int BATCH = 2, SEQ = 8192, D = 1024, FF = 2816, M = BATCH * SEQ;
constexpr int NGU = 2 * FF;
constexpr int NPROJ = 3328;
constexpr int DIN = 3144;
constexpr int NH = 8, HD = 64, DATT = 512, DLRU = 512, TOPK = 256, CHUNK = 64;
constexpr int LCH = 32, NLCH = SEQ / LCH;
constexpr float EPS = 1e-6f;

constexpr size_t MiB = 1u << 20;
constexpr size_t WS_CTL = 0, CTL_ZERO_BYTES = 1 * MiB;
constexpr size_t WS_MOD = 1 * MiB;
constexpr size_t WS_LRUW = 2 * MiB;
constexpr size_t WS_LRUS = 246 * MiB;
constexpr size_t WS_W1GU = 3 * MiB, WS_W1D = 14 * MiB, WS_WIN = 20 * MiB, WS_WOUT = 27 * MiB, WS_W2GU = 29 * MiB, WS_W2D = 40 * MiB;
constexpr size_t WS_H = 46 * MiB;
constexpr size_t WS_ACT = 78 * MiB;
constexpr size_t WS_Y = 166 * MiB;
constexpr size_t WS_Q = 78 * MiB, WS_K = 94 * MiB, WS_V = 110 * MiB;
constexpr size_t WS_QS = 126 * MiB;
constexpr size_t WS_O = 142 * MiB;
constexpr size_t WS_KI = 158 * MiB;
constexpr size_t WS_WI = 160 * MiB;
constexpr size_t WS_MASK = 230 * MiB;
constexpr size_t WS_LRU = 166 * MiB;
constexpr size_t WS_MERGED = WS_H;
constexpr size_t WS_END = 248 * MiB;
constexpr int CW_BAR = 4096;

constexpr int RING_OFF = 0, RING_BYTES = 131072;
constexpr int LDSCTL_OFF = RING_BYTES, MISC_OFF = LDSCTL_OFF + 320;
constexpr int LDS_BYTES = 147456;

#define GAS __attribute__((address_space(1)))
#define LAS __attribute__((address_space(3)))
typedef _Float16 h16;
typedef unsigned v4u __attribute__((ext_vector_type(4)));
typedef unsigned v2u __attribute__((ext_vector_type(2)));
typedef float f32x4 __attribute__((ext_vector_type(4)));
typedef _Float16 h16x8 __attribute__((ext_vector_type(8)));
typedef _Float16 h16x4 __attribute__((ext_vector_type(4)));
typedef GAS unsigned gu32;
#define RLX_AGENT __ATOMIC_RELAXED, __HIP_MEMORY_SCOPE_AGENT
#define LDS_WAIT() asm volatile("s_waitcnt lgkmcnt(0)" ::: "memory")
#define VM_WAIT() asm volatile("s_waitcnt vmcnt(0)" ::: "memory")
using pg8::cvt_pk_h16;

#define XB_TMO      128
#define XB_XCNT(j)  (256  + 64 * (j))
#define XB_XSUB(j)  (1280 + 64 * (j))
#define XB_XGEN(j)  (2304 + 64 * (j))
#define XB_TOP      3328
#define XB_TOPGEN   3392
#define XCD_BAR_WORDS 3456
#define XB_SPIN_CAP (1u << 18)
__device__ __forceinline__ unsigned xb_ld(unsigned* p)              { return __hip_atomic_load(p, __ATOMIC_RELAXED, __HIP_MEMORY_SCOPE_AGENT); }
__device__ __forceinline__ unsigned xb_add(unsigned* p, unsigned v) { return __hip_atomic_fetch_add(p, v, __ATOMIC_RELAXED, __HIP_MEMORY_SCOPE_AGENT); }
__device__ __forceinline__ unsigned xb_xcc_id() { return (unsigned)__builtin_amdgcn_s_getreg((3 << 11) | 20) & 0xFu; }
#define XB_SPIN(cond, bar) do { unsigned _sp = 0; while (cond) { __builtin_amdgcn_s_sleep(1); \
    if ((++_sp & 255u) == 0u) { if (xb_ld(&(bar)[XB_TMO])) break; if (_sp > XB_SPIN_CAP) { atomicAdd(&(bar)[XB_TMO], 1u); break; } } } } while (0)
struct XcdBarrier { unsigned* bar; unsigned x; volatile LAS unsigned* st; };
__device__ __forceinline__ XcdBarrier xcd_barrier_post(unsigned* bar, volatile LAS unsigned* st) {
    XcdBarrier b; b.bar = bar; b.x = xb_xcc_id(); b.st = st;
    if (threadIdx.x == 0) (void)xb_add(&bar[XB_XCNT(b.x)], 1u);
    return b;
}
__device__ __forceinline__ void xcd_barrier_complete(unsigned* bar, unsigned x, unsigned& nloc, unsigned& nx) {
    const unsigned G = gridDim.x * gridDim.y * gridDim.z;
    unsigned sum, cnt, mine, sp = 0u;
    for (;;) {
        sum = 0u; cnt = 0u; mine = 0u;
#pragma unroll
        for (unsigned j = 0; j < 16; ++j) { const unsigned c = xb_ld(&bar[XB_XCNT(j)]); sum += c; cnt += (c > 0u) ? 1u : 0u; mine = (j == x) ? c : mine; }
        if (sum == G) break;
        __builtin_amdgcn_s_sleep(1);
        if ((++sp & 255u) == 0u) { if (xb_ld(&bar[XB_TMO])) break; if (sp > XB_SPIN_CAP) { atomicAdd(&bar[XB_TMO], 1u); break; } }
    }
    nloc = mine > 0u ? mine : 1u; nx = cnt > 0u ? cnt : 1u;
}
__device__ __forceinline__ void xcd_barrier(const XcdBarrier& b) {
    asm volatile("s_waitcnt vmcnt(0)" ::: "memory");
    __syncthreads();
    if (threadIdx.x == 0) {
        unsigned* bar = b.bar;
        __builtin_amdgcn_s_waitcnt(0);
        unsigned nloc = b.st[0], nx = b.st[1];
        if (nloc == 0u) { xcd_barrier_complete(bar, b.x, nloc, nx); b.st[0] = nloc; b.st[1] = nx; }
        const unsigned old = xb_add(&bar[XB_XSUB(b.x)], 1u);
        const unsigned gen = old / nloc;
        if (old + 1u == (gen + 1u) * nloc) {
            __builtin_amdgcn_fence(__ATOMIC_RELEASE, "agent");
            asm volatile("s_waitcnt vmcnt(0)" ::: "memory");
            const unsigned og = xb_add(&bar[XB_TOP], 1u);
            const unsigned tg = og / nx;
            if (og + 1u == (tg + 1u) * nx) xb_add(&bar[XB_TOPGEN], 1u);
            else XB_SPIN(xb_ld(&bar[XB_TOPGEN]) == tg, bar);
            __builtin_amdgcn_fence(__ATOMIC_ACQUIRE, "agent");
            xb_add(&bar[XB_XGEN(b.x)], 1u);
            asm volatile("s_waitcnt vmcnt(0)" ::: "memory");
        } else {
            XB_SPIN(xb_ld(&bar[XB_XGEN(b.x)]) == gen, bar);
            __builtin_amdgcn_fence(__ATOMIC_ACQUIRE, "agent");
            asm volatile("s_waitcnt vmcnt(0)" ::: "memory");
        }
    }
    __syncthreads();
}

struct Frame {
    LAS unsigned char* lds;
    volatile LAS unsigned* MISC;
    gu32* ctl;
    int tid, lane, wave;
    int vcu, G;
};
struct Args { const float* in[28]; float* out; unsigned char* ws; int ph_lo, ph_hi, li, pad; };

__device__ __forceinline__ float wave_sum(float v) {
#pragma unroll
    for (int o = 1; o < 64; o <<= 1) v += __shfl_xor(v, o);
    return v;
}
__device__ __forceinline__ float wave_max(float v) {
#pragma unroll
    for (int o = 1; o < 64; o <<= 1) v = fmaxf(v, __shfl_xor(v, o));
    return v;
}

struct MapId { __device__ __forceinline__ int operator()(int n) const { return n; } };
struct MapGU { int half; __device__ __forceinline__ int operator()(int n) const { return (n >> 7) * 256 + half * 128 + (n & 127); } };
struct MapIn { __device__ __forceinline__ int operator()(int n) const { return n < 2120 ? n : n + 184; } };
template <class RowMap>
__device__ __forceinline__ void p0_transpose_item(const float* W, int K, int N, h16* WT, RowMap rm, LAS float* scr, int item, int lane) {
    const int nblk = (N + 31) / 32, kb = item / nblk, nb = item % nblk, k0 = 64 * kb, n0 = 32 * nb;
    const int nl = n0 + (lane & 31);
#pragma unroll 8
    for (int i = 0; i < 32; ++i) { const int kk = 2 * i + (lane >> 5); scr[kk * 33 + (lane & 31)] = (nl < N) ? W[(size_t)(k0 + kk) * N + nl] : 0.f; }
    LDS_WAIT(); asm volatile("" ::: "memory");
    const int c = lane & 7;
#pragma unroll
    for (int j = 0; j < 4; ++j) { const int nn = (lane >> 3) + 8 * j; const LAS float* s = scr + (8 * c) * 33 + nn;
        v4u o; o.x = cvt_pk_h16(s[0 * 33], s[1 * 33]); o.y = cvt_pk_h16(s[2 * 33], s[3 * 33]); o.z = cvt_pk_h16(s[4 * 33], s[5 * 33]); o.w = cvt_pk_h16(s[6 * 33], s[7 * 33]);
        if (n0 + nn < N) *(GAS v4u*)(WT + (size_t)rm(n0 + nn) * K + k0 + 8 * c) = o; }
    LDS_WAIT(); asm volatile("" ::: "memory");
}

__device__ __forceinline__ void p0_prologue(Frame& F, const Args& A) {
    unsigned char* ws = A.ws;
    if (blockIdx.x < 36) {
        LAS float* sc = (LAS float*)(F.lds);
        LAS float* red = (LAS float*)(F.lds + 8192);
        const float* c = A.in[1];
        for (int i = F.tid; i < 2048; i += NTHR) { const float v = c[i]; sc[i] = v / (1.0f + __expf(-v)); }
        __syncthreads();
        const float* wa = A.in[2]; const int col = blockIdx.x * 256 + 4 * F.lane;
        f32x4 a0 = {0.f, 0.f, 0.f, 0.f}, a1 = {0.f, 0.f, 0.f, 0.f};
        const int kb = F.wave * 128;
#pragma unroll 8
        for (int k = 0; k < 128; ++k) { const f32x4 w = *(const f32x4*)(wa + (size_t)(kb + k) * 9216 + col); a0 += w * sc[kb + k]; a1 += w * sc[1024 + kb + k]; }
        *(LAS f32x4*)(red + (F.wave * 2 + 0) * 256 + 4 * F.lane) = a0; *(LAS f32x4*)(red + (F.wave * 2 + 1) * 256 + 4 * F.lane) = a1;
        __syncthreads();
        { const int b = F.tid >> 8, j = F.tid & 255; float s = 0.f;
#pragma unroll
          for (int w = 0; w < 8; ++w) s += red[(w * 2 + b) * 256 + j];
          const int cc = blockIdx.x * 256 + j; ((float*)(ws + WS_MOD))[b * 9216 + cc] = s + A.in[3][cc]; }
        __syncthreads();
    }
    LAS float* scr = (LAS float*)(F.lds + RING_OFF + F.wave * 16384);
    const int gw = F.vcu * NWAVES + F.wave, NGW = F.G * NWAVES;
    constexpr int I_GU = (D / 64) * (FF / 32), I_DN = (FF / 64) * (D / 32), I_IN = (D / 64) * ((DIN + 31) / 32), I_OUT = (D / 64) * (D / 32);
    constexpr int NITEMS = 6 * I_GU + I_IN + I_OUT; static_assert(I_GU == I_DN, "items");
    h16* W1GU = (h16*)(ws + WS_W1GU); h16* W1D = (h16*)(ws + WS_W1D); h16* WIN = (h16*)(ws + WS_WIN); h16* WOUT = (h16*)(ws + WS_WOUT); h16* W2GU = (h16*)(ws + WS_W2GU); h16* W2D = (h16*)(ws + WS_W2D);
    for (int it = gw; it < NITEMS; it += NGW) {
        int r = it;
        if (r < I_GU) { p0_transpose_item(A.in[6], D, FF, W1GU, MapGU{0}, scr, r, F.lane); continue; } r -= I_GU;
        if (r < I_GU) { p0_transpose_item(A.in[7], D, FF, W1GU, MapGU{1}, scr, r, F.lane); continue; } r -= I_GU;
        if (r < I_DN) { p0_transpose_item(A.in[8], FF, D, W1D, MapId{}, scr, r, F.lane); continue; } r -= I_DN;
        if (r < I_IN) { p0_transpose_item(A.in[11], D, DIN, WIN, MapIn{}, scr, r, F.lane); continue; } r -= I_IN;
        if (r < I_OUT) { p0_transpose_item(A.in[22], D, D, WOUT, MapId{}, scr, r, F.lane); continue; } r -= I_OUT;
        if (r < I_GU) { p0_transpose_item(A.in[25], D, FF, W2GU, MapGU{0}, scr, r, F.lane); continue; } r -= I_GU;
        if (r < I_GU) { p0_transpose_item(A.in[26], D, FF, W2GU, MapGU{1}, scr, r, F.lane); continue; } r -= I_GU;
        p0_transpose_item(A.in[27], FF, D, W2D, MapId{}, scr, r, F.lane);
    }
    for (int tk = gw; tk < 128; tk += NGW) { const int s4 = tk & 3, jt = (tk >> 2) & 1, g = (tk >> 3) & 7, gate = tk >> 6; const float* W = A.in[gate ? 17 : 15]; const int r = F.lane & 31, hh = F.lane >> 5;
        float v[8];
#pragma unroll
        for (int e = 0; e < 8; ++e) v[e] = W[(g * 64 + 16 * s4 + 8 * hh + e) * 64 + 32 * jt + r];
        v4u o; o.x = cvt_pk_h16(v[0], v[1]); o.y = cvt_pk_h16(v[2], v[3]); o.z = cvt_pk_h16(v[4], v[5]); o.w = cvt_pk_h16(v[6], v[7]);
        *(GAS v4u*)(ws + WS_LRUW + ((size_t)tk * 64 + F.lane) * 16) = o; }
    for (int i = blockIdx.x * NTHR + F.tid; i < 184 * 128; i += F.G * NTHR) *(GAS v4u*)(WIN + (size_t)2120 * D + (size_t)i * 8) = (v4u){0u, 0u, 0u, 0u};
}

template <bool HAS_Y, bool HAS_H>
__device__ __forceinline__ void thin_phase(Frame& F, const float* mod, const float* yin, const float* gpost, float gscale, int mg,
                                           const float* xin, float* xout, const float* gpre, int msh, int msc, h16* hout) {
    LAS float* TA = (LAS float*)(F.lds); LAS float* TB = TA + 2048; LAS float* TC = TB + 2048;
    for (int i = F.tid; i < 2048; i += NTHR) { const int b = i >> 10, cidx = i & 1023;
        if (HAS_Y) TA[i] = gscale * mod[b * 9216 + mg * 1024 + cidx] * gpost[cidx];
        if (HAS_H) { TB[i] = gpre[cidx] * (1.0f + mod[b * 9216 + msc * 1024 + cidx]); TC[i] = mod[b * 9216 + msh * 1024 + cidx]; } }
    __syncthreads();
    const int gw = F.vcu * NWAVES + F.wave, NGW = F.G * NWAVES;
    for (int row = gw; row < M; row += NGW) {
        const int b = row >> 13;
        const GAS f32x4* xr = (const GAS f32x4*)(xin + (size_t)row * D) + F.lane;
        f32x4 x[4];
#pragma unroll
        for (int j = 0; j < 4; ++j) x[j] = xr[64 * j];
        if (HAS_Y) {
            const GAS f32x4* yr = (const GAS f32x4*)(yin + (size_t)row * D) + F.lane;
            f32x4 y[4]; float s = 0.f;
#pragma unroll
            for (int j = 0; j < 4; ++j) { y[j] = yr[64 * j]; s += (y[j].x * y[j].x + y[j].y * y[j].y) + (y[j].z * y[j].z + y[j].w * y[j].w); }
            const float rstd = 1.0f / sqrtf(wave_sum(s) * (1.0f / D) + EPS);
            GAS f32x4* xo = (GAS f32x4*)(xout + (size_t)row * D) + F.lane;
#pragma unroll
            for (int j = 0; j < 4; ++j) { const f32x4 ta = *(const LAS f32x4*)(TA + b * 1024 + 4 * F.lane + 256 * j); x[j] = x[j] + ta * (y[j] * rstd); xo[64 * j] = x[j]; }
        }
        if (HAS_H) {
            float s = 0.f;
#pragma unroll
            for (int j = 0; j < 4; ++j) s += (x[j].x * x[j].x + x[j].y * x[j].y) + (x[j].z * x[j].z + x[j].w * x[j].w);
            const float rstd = 1.0f / sqrtf(wave_sum(s) * (1.0f / D) + EPS);
            GAS v2u* ho = (GAS v2u*)(hout + (size_t)row * D) + F.lane;
#pragma unroll
            for (int j = 0; j < 4; ++j) { const f32x4 tb = *(const LAS f32x4*)(TB + b * 1024 + 4 * F.lane + 256 * j), tc = *(const LAS f32x4*)(TC + b * 1024 + 4 * F.lane + 256 * j);
                const f32x4 h = (x[j] * rstd) * tb + tc; v2u o; o.x = cvt_pk_h16(h.x, h.y); o.y = cvt_pk_h16(h.z, h.w); ho[64 * j] = o; }
        }
    }
    __syncthreads();
}

__device__ __forceinline__ float gelu_tanh(float x) { const float u = 0.7978845608028654f * (x + 0.044715f * x * x * x); const float e = __builtin_amdgcn_exp2f(2.0f * 1.4426950408889634f * u); const float t = 1.0f - 2.0f * __builtin_amdgcn_rcpf(e + 1.0f); return 0.5f * x * (1.0f + t); }
__device__ __forceinline__ float fast_sigmoid(float z) { return __builtin_amdgcn_rcpf(1.0f + __builtin_amdgcn_exp2f(-1.4426950408889634f * z)); }
__device__ __forceinline__ float lane_partner(float x, int hh) { auto rr = __builtin_amdgcn_permlane32_swap(__float_as_uint(x), __float_as_uint(x), false, false); return __uint_as_float(hh ? rr[0] : rr[1]); }
typedef float f32x16 __attribute__((ext_vector_type(16)));
__device__ __forceinline__ int crow(int r, int hi) { return (r & 3) + 8 * (r >> 2) + 4 * hi; }
constexpr int LL_XC = 0, LL_OUT = 32768, LL_CAR = 131072 + 1024;
template <bool PASS_B>
__device__ __forceinline__ void lru_phase(Frame& F, const Args& A) {
    unsigned char* ws = A.ws;
    const h16* LRU = (const h16*)(ws + WS_LRU); float* SA = (float*)(ws + WS_LRUS); float* SB = SA + BATCH * NLCH * DLRU;
    h16* MERGED = (h16*)(ws + WS_MERGED);
    int tid_o = F.tid; asm volatile("" : "+v"(tid_o));
    const int tid = tid_o, lane = tid & 63, g = F.wave, r = lane & 31, hh = lane >> 5;
    LAS unsigned char* XC = F.lds + LL_XC; LAS float* OUT = (LAS float*)(F.lds + LL_OUT); LAS float* CAR = (LAS float*)(F.lds + LL_CAR);
    const h16x8* LW = (const h16x8*)(ws + WS_LRUW);
    float ba[2], bi[2], sp8[2];
#pragma unroll
    for (int jt = 0; jt < 2; ++jt) { const int ch = g * 64 + 32 * jt + r; ba[jt] = A.in[16][ch]; bi[jt] = A.in[18][ch]; const float lam = A.in[19][ch]; sp8[jt] = 8.0f * ((lam < -15.f) ? -lam : log1pf(__expf(-lam))); }
    for (int p = blockIdx.x; p < 256; p += F.G) {
#pragma unroll 1
        for (int uu = 0; uu < 2; ++uu) {
            const int b = p >> 7, c = uu ? 255 - (p & 127) : (p & 127), t0 = c * LCH;
            const h16* xb = LRU + (size_t)(b * SEQ) * 1024;
            __syncthreads();
            if (PASS_B) { float H = 0.f; const float* pa = SA + (size_t)(b * NLCH) * DLRU + tid; const float* pb = SB + (size_t)(b * NLCH) * DLRU + tid;
#pragma unroll 1
                for (int cc0 = 0; cc0 < c; cc0 += 16) {
                    float fa[16], fb[16];
#pragma unroll
                    for (int k = 0; k < 16; ++k) { const int ci = (cc0 + k < c) ? cc0 + k : c - 1; fa[k] = pa[(size_t)ci * DLRU]; fb[k] = pb[(size_t)ci * DLRU]; }
#pragma unroll
                    for (int k = 0; k < 16; ++k) { const bool ok = cc0 + k < c; H = (ok ? fa[k] : 1.0f) * H + (ok ? fb[k] : 0.0f); } }
                CAR[tid] = H; }
            asm volatile("" ::: "memory");
            { h16x8 xr[7]; f32x4 cwv[4][2], cbv[2];
              cbv[0] = *(const f32x4*)(A.in[14] + 8 * lane); cbv[1] = *(const f32x4*)(A.in[14] + 8 * lane + 4);
#pragma unroll
              for (int jx = 0; jx < 4; ++jx) { cwv[jx][0] = *(const f32x4*)(A.in[13] + jx * DLRU + 8 * lane); cwv[jx][1] = *(const f32x4*)(A.in[13] + jx * DLRU + 8 * lane + 4); }
#pragma unroll
              for (int k = 0; k < 7; ++k) { const int t = t0 + 4 * g - 3 + k; if (t >= 0) xr[k] = *(const h16x8*)(xb + (size_t)t * 1024 + 8 * lane); else xr[k] = (h16x8){0, 0, 0, 0, 0, 0, 0, 0}; }
#pragma unroll
              for (int tt = 0; tt < 4; ++tt) { float v[8];
#pragma unroll
                  for (int e = 0; e < 8; ++e) v[e] = cbv[e >> 2][e & 3] + (float)xr[tt][e] * cwv[0][e >> 2][e & 3] + (float)xr[tt + 1][e] * cwv[1][e >> 2][e & 3] + (float)xr[tt + 2][e] * cwv[2][e >> 2][e & 3] + (float)xr[tt + 3][e] * cwv[3][e >> 2][e & 3];
                  v4u o; o.x = cvt_pk_h16(v[0], v[1]); o.y = cvt_pk_h16(v[2], v[3]); o.z = cvt_pk_h16(v[4], v[5]); o.w = cvt_pk_h16(v[6], v[7]);
                  const int row = 4 * g + tt; *(LAS v4u*)(XC + row * 1024 + ((lane ^ (row & 7)) << 4)) = o; } }
            __syncthreads();
            h16x8 af[4];
#pragma unroll
            for (int s = 0; s < 4; ++s) af[s] = *(const LAS h16x8*)(XC + r * 1024 + (((g * 8 + 2 * s + hh) ^ (r & 7)) << 4));
#pragma unroll 1
            for (int jt = 0; jt < 2; ++jt) {
                float gt[16];
                if (PASS_B) {
#pragma unroll
                    for (int i = 0; i < 16; ++i) gt[i] = (float)xb[(size_t)(t0 + crow(i, hh)) * 1024 + 512 + g * 64 + 32 * jt + r]; }
                float av[16], bv[16];
                const int ch = g * 64 + 32 * jt + r;
                {   h16x8 wf[4];
#pragma unroll
                    for (int s = 0; s < 4; ++s) wf[s] = LW[(((0 * 8 + g) * 2 + jt) * 4 + s) * 64 + lane];
                    f32x16 za = {};
#pragma unroll
                    for (int s = 0; s < 4; ++s) za = __builtin_amdgcn_mfma_f32_32x32x16_f16(af[s], wf[s], za, 0, 0, 0);
#pragma unroll
                    for (int i = 0; i < 16; ++i) { const float rg = fast_sigmoid(za[i] + (jt ? ba[1] : ba[0])); const float la = -(jt ? sp8[1] : sp8[0]) * rg, y = 2.0f * la;
                        const float em = (y > -0.03f) ? -y * (1.0f + y * (0.5f + y * (0.16666667f + y * 0.041666668f))) : 1.0f - __expf(y);
                        av[i] = __expf(la); bv[i] = __builtin_amdgcn_sqrtf(em); } }
                {   h16x8 wf[4];
#pragma unroll
                    for (int s = 0; s < 4; ++s) wf[s] = LW[(((1 * 8 + g) * 2 + jt) * 4 + s) * 64 + lane];
                    f32x16 zi = {};
#pragma unroll
                    for (int s = 0; s < 4; ++s) zi = __builtin_amdgcn_mfma_f32_32x32x16_f16(af[s], wf[s], zi, 0, 0, 0);
#pragma unroll
                    for (int i = 0; i < 16; ++i) { const int t = crow(i, hh); const float ig = fast_sigmoid(zi[i] + (jt ? bi[1] : bi[0]));
                        const float xcv = (float)*(const LAS h16*)(XC + t * 1024 + ((((ch >> 3)) ^ (t & 7)) << 4) + (ch & 7) * 2);
                        bv[i] *= ig * xcv; } }
                float GA[4], GB[4];
#pragma unroll
                for (int k = 0; k < 4; ++k) { float Ak = av[4 * k], Bk = bv[4 * k];
#pragma unroll
                    for (int e = 1; e < 4; ++e) { Bk = av[4 * k + e] * Bk + bv[4 * k + e]; Ak *= av[4 * k + e]; }
                    GA[k] = Ak; GB[k] = Bk; }
                float state = PASS_B ? CAR[ch] : 0.f; float cin[4];
#pragma unroll
                for (int k = 0; k < 4; ++k) { const float out0 = GA[k] * state + GB[k]; const float p0 = lane_partner(out0, hh); const float in1 = hh ? p0 : state; cin[k] = in1;
                    const float out1 = GA[k] * in1 + GB[k]; const float p1 = lane_partner(out1, hh); state = hh ? out1 : p1; }
                if (!PASS_B) { float P = (GA[0] * GA[1]) * (GA[2] * GA[3]); P *= lane_partner(P, hh);
                    if (hh == 0) { SA[(size_t)(b * NLCH + c) * DLRU + ch] = P; SB[(size_t)(b * NLCH + c) * DLRU + ch] = state; } }
                else {
#pragma unroll
                    for (int k = 0; k < 4; ++k) { float h = cin[k];
#pragma unroll
                        for (int e = 0; e < 4; ++e) { const int i = 4 * k + e; h = av[i] * h + bv[i]; OUT[crow(i, hh) * 512 + ch] = h * gelu_tanh(gt[i]); } } }
            }
            if (PASS_B) {
                __syncthreads();
#pragma unroll
                for (int k = 0; k < 4; ++k) { const int tt = 4 * g + k;
                    const f32x4 o0 = *(const LAS f32x4*)(OUT + tt * 512 + 8 * lane), o1 = *(const LAS f32x4*)(OUT + tt * 512 + 8 * lane + 4);
                    const float s = (o0.x * o0.x + o0.y * o0.y) + (o0.z * o0.z + o0.w * o0.w) + (o1.x * o1.x + o1.y * o1.y) + (o1.z * o1.z + o1.w * o1.w);
                    const float rstd = 1.0f / sqrtf(wave_sum(s) * (1.0f / DLRU) + EPS);
                    const f32x4 g0 = *(const f32x4*)(A.in[21] + 8 * lane), g1 = *(const f32x4*)(A.in[21] + 8 * lane + 4);
                    v4u o; o.x = cvt_pk_h16(o0.x * rstd * g0.x, o0.y * rstd * g0.y); o.y = cvt_pk_h16(o0.z * rstd * g0.z, o0.w * rstd * g0.w);
                    o.z = cvt_pk_h16(o1.x * rstd * g1.x, o1.y * rstd * g1.y); o.w = cvt_pk_h16(o1.z * rstd * g1.z, o1.w * rstd * g1.w);
                    *(GAS v4u*)(MERGED + (size_t)(b * SEQ + t0 + tt) * 1024 + 512 + 8 * lane) = o; }
            }
        }
    }
}

constexpr int IDX_CAP = 128;
constexpr int IL_QL = 0, IL_WL = 36864, IL_INFO = 37888, IL_CNT = 38400, IL_PS = 38912, IL_HIST = 65536, IL_CAND = 65536, IL_SCR = 98304;
constexpr int SL_SCORE = 65536, SL_HIST = 98304, SL_CTL = 99328;
__device__ __forceinline__ unsigned ord_key(float f) { const unsigned u = __float_as_uint(f); return u ^ ((u >> 31) ? 0xFFFFFFFFu : 0x80000000u); }
__device__ __forceinline__ int t5_bucket(int rel) {
    const int n = rel < 0 ? -rel : rel; int large;
    if (n < 12) large = 8; else if (n < 16) large = 9; else if (n < 23) large = 10; else if (n < 32) large = 11; else if (n < 46) large = 12; else if (n < 64) large = 13; else if (n < 91) large = 14; else large = 15;
    return (rel > 0 ? 16 : 0) + (n < 8 ? n : large);
}
#define IDX_FMA_ABS(s_, x_, w_) asm("v_fma_f32 %0, |%1|, %2, %0" : "+v"(s_) : "v"(x_), "v"(w_))
__device__ __forceinline__ void idx_scores(f32x16 (&S)[2], const h16x8 (&a)[2][4], const LAS unsigned char* ql, int foff, int sw, int hh, const LAS float* wl) {
    {   h16x8 qf[4];
#pragma unroll
        for (int s = 0; s < 4; ++s) qf[s] = *(const LAS h16x8*)(ql + 8 * 4096 + foff + (((2 * s + hh) ^ sw) << 4));
#pragma unroll
        for (int sub = 0; sub < 2; ++sub) { f32x16 acc = {};
#pragma unroll
            for (int s = 0; s < 4; ++s) acc = __builtin_amdgcn_mfma_f32_32x32x16_f16(a[sub][s], qf[s], acc, 0, 0, 0);
            S[sub] = acc; } }
#pragma unroll 1
    for (int h = 0; h < 8; ++h) {
        h16x8 qf[4]; const float wh = wl[h];
#pragma unroll
        for (int s = 0; s < 4; ++s) qf[s] = *(const LAS h16x8*)(ql + h * 4096 + foff + (((2 * s + hh) ^ sw) << 4));
        f32x16 acc0 = {}, acc1 = {};
#pragma unroll
        for (int s = 0; s < 4; ++s) acc0 = __builtin_amdgcn_mfma_f32_32x32x16_f16(a[0][s], qf[s], acc0, 0, 0, 0);
#pragma unroll
        for (int s = 0; s < 4; ++s) acc1 = __builtin_amdgcn_mfma_f32_32x32x16_f16(a[1][s], qf[s], acc1, 0, 0, 0);
        asm volatile("s_nop 15" : "+v"(acc0), "+v"(S[0]));
#pragma unroll
        for (int i = 0; i < 16; ++i) IDX_FMA_ABS(S[0][i], acc0[i], wh);
        asm volatile("s_nop 15" : "+v"(acc1), "+v"(S[1]));
#pragma unroll
        for (int i = 0; i < 16; ++i) IDX_FMA_ABS(S[1][i], acc1[i], wh);
    }
    asm volatile("s_nop 1" : "+v"(S[0]), "+v"(S[1]));
}
__device__ __forceinline__ void idx_phase(Frame& F, const Args& A) {
    unsigned char* ws = A.ws;
    const h16* QS = (const h16*)(ws + WS_QS); const h16* KI = (const h16*)(ws + WS_KI); const float* WI = (const float*)(ws + WS_WI);
    unsigned* MASK = (unsigned*)(ws + WS_MASK);
    LAS unsigned char* L = F.lds;
    int tid_o = F.tid; asm volatile("" : "+v"(tid_o));
    const int tid = tid_o, lane = tid & 63, wave = F.wave, r = lane & 31, hh = lane >> 5;
    LAS float* WL = (LAS float*)(L + IL_WL); LAS int* INFO = (LAS int*)(L + IL_INFO); LAS unsigned* CNT = (LAS unsigned*)(L + IL_CNT);
    LAS unsigned* HIST = (LAS unsigned*)(L + IL_HIST);
    for (int p = blockIdx.x; p < 256; p += F.G) {
        const int b = p >> 7, jj = p & 127;
        for (int uu = 0; uu < 2; ++uu) {
            const int j = uu ? 255 - jj : jj;
            const int q0 = 32 * j, rowb = b * SEQ + q0, N = ((j >> 1) + 1) * 64, NC = N >> 6;
            unsigned* mrow = MASK + ((size_t)(b * 128) * 8192 + q0) * 2;
            if (N <= TOPK) {
                for (int i = tid; i < NC * 64; i += NTHR) mrow[(size_t)(i >> 6) * 16384 + (i & 63)] = 0xFFFFFFFFu;
                continue;
            }
            __syncthreads();
#pragma unroll
            for (int i = 0; i < 4; ++i) { const int idx = tid + NTHR * i, q = idx >> 6, cc = idx & 63, head = cc >> 3, c8 = cc & 7;
                const v4u v = *(const GAS v4u*)(QS + (size_t)(rowb + q) * 512 + cc * 8);
                *(LAS v4u*)(L + IL_QL + head * 4096 + q * 128 + ((c8 ^ (q & 7)) << 4)) = v; }
            if (tid < 256) WL[tid] = WI[(size_t)rowb * 8 + tid];
            for (int i = tid; i < 16384; i += NTHR) HIST[i] = 0u;
            if (tid < 32) CNT[tid] = 0u;
            __syncthreads();
            { const int q = tid >> 4, dg = tid & 15, c8 = dg >> 1; float a0 = 0.f, a1 = 0.f, a2 = 0.f, a3 = 0.f;
              const int o = q * 128 + ((c8 ^ (q & 7)) << 4) + (dg & 1) * 8;
#pragma unroll
              for (int h = 0; h < 8; ++h) { const h16x4 v = *(const LAS h16x4*)(L + IL_QL + h * 4096 + o); const float wv = WL[q * 8 + h];
                  a0 += wv * (float)v[0]; a1 += wv * (float)v[1]; a2 += wv * (float)v[2]; a3 += wv * (float)v[3]; }
              v2u pk; pk.x = cvt_pk_h16(a0, a1); pk.y = cvt_pk_h16(a2, a3); *(LAS v2u*)(L + IL_QL + 8 * 4096 + o) = pk; }
            __syncthreads();
            const LAS float* w = WL + r * 8;
            const int foff = r * 128, sw = r & 7;
            const h16* kbase = KI + (size_t)(b * SEQ) * 64 + (size_t)r * 64 + 8 * hh;
            const LAS unsigned char* ql = L + IL_QL;
#define IDX_LOADA(dst, c) do { _Pragma("unroll") for (int sub_ = 0; sub_ < 2; ++sub_) _Pragma("unroll") for (int s_ = 0; s_ < 4; ++s_) \
                dst[sub_][s_] = *(const h16x8*)(kbase + (size_t)(64 * (c) + 32 * sub_) * 64 + 16 * s_); } while (0)
            h16x8 a[2][4]; f32x16 S[2];
            IDX_LOADA(a, 0); idx_scores(S, a, ql, foff, sw, hh, w);
            float s1 = 0.f, s2 = 0.f;
#pragma unroll
            for (int sub = 0; sub < 2; ++sub)
#pragma unroll
                for (int i = 0; i < 16; ++i) { s1 += S[sub][i]; s2 += S[sub][i] * S[sub][i]; }
            s1 += __shfl_xor(s1, 32); s2 += __shfl_xor(s2, 32);
            const float mean = s1 * (1.0f / 64.0f), sd = sqrtf(fmaxf(s2 * (1.0f / 64.0f) - mean * mean, 1e-30f));
            const float inv_w = 510.0f / (8.0f * sd), off = 1.0f - (mean - 3.0f * sd) * inv_w;
            { int c = wave; if (c < NC) IDX_LOADA(a, c);
              for (; c < NC; c += 8) {
                idx_scores(S, a, ql, foff, sw, hh, w);
                if (c + 8 < NC) IDX_LOADA(a, c + 8);
#pragma unroll
                for (int sub = 0; sub < 2; ++sub)
#pragma unroll
                    for (int i = 0; i < 16; ++i) { const float f = floorf(__builtin_fmaf(S[sub][i], inv_w, off)); const int bin = (int)fminf(fmaxf(f, 0.f), 511.f);
                        __hip_atomic_fetch_add(HIST + bin * 32 + r, 1u, __ATOMIC_RELAXED, __HIP_MEMORY_SCOPE_WORKGROUP); }
              } }
            __syncthreads();
            { LAS unsigned* PS = (LAS unsigned*)(L + IL_PS); const int rg = wave * 2 + hh; unsigned sum = 0u;
#pragma unroll
              for (int k = 0; k < 32; ++k) sum += HIST[(rg * 32 + k) * 32 + r];
              PS[rg * 32 + r] = sum;
              __syncthreads();
              if (wave == 0 && hh == 0) { const int q = r; unsigned cum = 0u; int rsel = 0; unsigned ps[16];
#pragma unroll
                  for (int k = 0; k < 16; ++k) ps[k] = PS[k * 32 + q];
                  bool found = false; unsigned above = 0u;
#pragma unroll
                  for (int k = 15; k >= 0; --k) { if (!found) { if (cum + ps[k] >= (unsigned)TOPK) { found = true; rsel = k; above = cum; } else cum += ps[k]; } }
                  int bsel = -1; unsigned cb = 0u, ca = 0u; cum = above;
                  for (int k = 31; k >= 0; --k) { const unsigned cn = HIST[(rsel * 32 + k) * 32 + q]; if (bsel < 0) { if (cum + cn >= (unsigned)TOPK) { bsel = rsel * 32 + k; cb = cn; ca = cum; } else cum += cn; } }
                  int slow = (!found || bsel <= 0 || bsel >= 511 || cb > (unsigned)IDX_CAP) ? 1 : 0;
#ifdef IDX_FORCE_SLOW
                  if (((rowb + q) % 251) == 0) slow = 1;
#endif
                  INFO[q * 4 + 0] = bsel; INFO[q * 4 + 1] = TOPK - (int)ca; INFO[q * 4 + 2] = slow; }
            }
            __syncthreads();
            const float blo = (float)INFO[r * 4 + 0], bhi = blo + 1.0f;
            LAS float* scr = (LAS float*)(L + IL_SCR + wave * 4096);
            LAS unsigned* cand = (LAS unsigned*)(L + IL_CAND);
            { int c = wave; if (c < NC) IDX_LOADA(a, c);
            for (; c < NC; c += 8) {
                idx_scores(S, a, ql, foff, sw, hh, w);
                if (c + 8 < NC) IDX_LOADA(a, c + 8);
                unsigned selw = 0u, cndw = 0u;
#pragma unroll
                for (int sub = 0; sub < 2; ++sub)
#pragma unroll
                    for (int i = 0; i < 16; ++i) { const float f = __builtin_fmaf(S[sub][i], inv_w, off); selw = selw * 2u + (f >= bhi ? 1u : 0u); cndw = cndw * 2u + (f >= blo ? 1u : 0u); }
                selw = (selw >> 16) | (selw << 16); cndw = (cndw >> 16) | (cndw << 16);
                mrow[(size_t)c * 16384 + (r * 2 + hh)] = selw;
                unsigned rem = cndw & ~selw;
                if (__any(rem != 0u)) {
#pragma unroll
                    for (int sub = 0; sub < 2; ++sub) {
                        LDS_WAIT();
#pragma unroll
                        for (int i = 0; i < 16; ++i) scr[i * 64 + lane] = S[sub][i];
                        LDS_WAIT();
                        unsigned bits = (rem >> (16 * sub)) & 0xFFFFu;
                        while (bits) { const int bp = 31 - __clz((int)bits), i = 15 - bp; bits &= ~(1u << bp);
                            const float val = scr[i * 64 + lane]; const unsigned key = (unsigned)(64 * c + 32 * sub + crow(i, hh));
                            const unsigned pos = __hip_atomic_fetch_add(CNT + r, 1u, __ATOMIC_RELAXED, __HIP_MEMORY_SCOPE_WORKGROUP);
                            if (pos < (unsigned)IDX_CAP) { cand[(r * IDX_CAP + pos) * 2] = __float_as_uint(val); cand[(r * IDX_CAP + pos) * 2 + 1] = key; } }
                    }
                }
            } }
            VM_WAIT(); __syncthreads();
#pragma unroll 1
            for (int k = 0; k < 4; ++k) { const int q = 4 * wave + k; const unsigned cc = CNT[q]; const int need = INFO[q * 4 + 1];
                if (cc > (unsigned)IDX_CAP) { if (lane == 0) INFO[q * 4 + 2] = 1; continue; }
                if (INFO[q * 4 + 2]) continue;
                for (unsigned i = lane; i < cc; i += 64) { const float si = __uint_as_float(cand[(q * IDX_CAP + i) * 2]); const unsigned ki = cand[(q * IDX_CAP + i) * 2 + 1]; int rank = 0;
                    for (unsigned jx = 0; jx < cc; ++jx) { const float sj = __uint_as_float(cand[(q * IDX_CAP + jx) * 2]); const unsigned kj = cand[(q * IDX_CAP + jx) * 2 + 1]; rank += (sj > si || (sj == si && kj < ki)) ? 1 : 0; }
                    if (rank < need) { const unsigned c = ki >> 6, sub = (ki >> 5) & 1u, row = ki & 31u, hk = (row >> 2) & 1u, rr = (row & 3u) + 4u * (row >> 3);
                        __hip_atomic_fetch_or(mrow + (size_t)c * 16384 + (q * 2 + hk), 1u << (16u * sub + 15u - rr), __ATOMIC_RELAXED, __HIP_MEMORY_SCOPE_AGENT); } }
            }
            __syncthreads();
#pragma unroll 1
            for (int q = 0; q < 32; ++q) {
                if (!INFO[q * 4 + 2]) continue;
                LAS float* s_score = (LAS float*)(L + SL_SCORE); LAS unsigned* s_hist = (LAS unsigned*)(L + SL_HIST); LAS unsigned* s_ctl = (LAS unsigned*)(L + SL_CTL);
                __syncthreads();
                for (int s = tid; s < N; s += NTHR) {
                    const h16* kr = KI + (size_t)(b * SEQ + s) * 64; float kv[64];
#pragma unroll
                    for (int i = 0; i < 8; ++i) { const h16x8 t8 = *(const h16x8*)(kr + 8 * i);
#pragma unroll
                        for (int e = 0; e < 8; ++e) kv[8 * i + e] = (float)t8[e]; }
                    float sc = 0.f;
#pragma unroll 1
                    for (int h = 0; h < 9; ++h) { float d = 0.f;
#pragma unroll
                        for (int c8 = 0; c8 < 8; ++c8) { const h16x8 qv = *(const LAS h16x8*)(L + IL_QL + h * 4096 + q * 128 + ((c8 ^ (q & 7)) << 4));
#pragma unroll
                            for (int e = 0; e < 8; ++e) d += (float)qv[e] * kv[8 * c8 + e]; }
                        sc += (h == 8) ? d : fabsf(d) * WL[q * 8 + h]; }
                    s_score[s] = sc;
                }
                __syncthreads();
                unsigned prefix = 0u, msk = 0u, remaining = TOPK, n_eq = 0u;
                for (int pass = 0; pass < 4; ++pass) {
                    const int shift = 24 - 8 * pass;
                    if (tid < 256) s_hist[tid] = 0u;
                    __syncthreads();
                    for (int s = tid; s < N; s += NTHR) { const unsigned key = ord_key(s_score[s]); if ((key & msk) == prefix) __hip_atomic_fetch_add(s_hist + ((key >> shift) & 255u), 1u, __ATOMIC_RELAXED, __HIP_MEMORY_SCOPE_WORKGROUP); }
                    __syncthreads();
                    if (wave == 0) {
                        const unsigned h0 = s_hist[4 * lane], h1 = s_hist[4 * lane + 1], h2 = s_hist[4 * lane + 2], h3 = s_hist[4 * lane + 3];
                        unsigned v = h0 + h1 + h2 + h3;
#pragma unroll
                        for (int o = 1; o < 64; o <<= 1) { const unsigned tv = __shfl_down(v, o); if (lane + o < 64) v += tv; }
                        unsigned above = __shfl_down(v, 1); if (lane == 63) above = 0u;
                        if (v >= remaining && above < remaining) {
                            unsigned cum = above; int dsel; unsigned rem; unsigned hv;
                            if (cum + h3 >= remaining) { dsel = 3; rem = remaining - cum; hv = h3; }
                            else { cum += h3; if (cum + h2 >= remaining) { dsel = 2; rem = remaining - cum; hv = h2; }
                            else { cum += h2; if (cum + h1 >= remaining) { dsel = 1; rem = remaining - cum; hv = h1; }
                            else { cum += h1; dsel = 0; rem = remaining - cum; hv = h0; } } }
                            s_ctl[0] = (unsigned)(4 * lane + dsel); s_ctl[1] = rem; s_ctl[4] = hv; }
                    }
                    __syncthreads();
                    prefix |= s_ctl[0] << shift; msk |= 255u << shift; remaining = s_ctl[1]; n_eq = s_ctl[4];
                    __syncthreads();
                }
                const unsigned tu = (prefix & 0x80000000u) ? (prefix ^ 0x80000000u) : ~prefix; const float thr = __uint_as_float(tu);
                unsigned idx_cut = 0xFFFFFFFFu;
                if (n_eq > remaining) {
                    if (tid == 0) { unsigned cnt = 0, cut = 0; for (int s = 0; s < N; ++s) if (s_score[s] == thr) { ++cnt; if (cnt == remaining) { cut = (unsigned)s; break; } } s_ctl[3] = cut; }
                    __syncthreads();
                    idx_cut = s_ctl[3];
                }
                int i0 = tid; asm volatile("" : "+v"(i0));
                for (int i = i0; i < NC * 2; i += NTHR) { const int c = i >> 1, hk = i & 1; unsigned word = 0u;
#pragma unroll
                    for (int sub = 0; sub < 2; ++sub)
#pragma unroll
                        for (int rr = 0; rr < 16; ++rr) { const int key = 64 * c + 32 * sub + crow(rr, hk); const float sc = s_score[key];
                            if (sc > thr || (sc == thr && (unsigned)key <= idx_cut)) word |= 1u << (16 * sub + 15 - rr); }
                    mrow[(size_t)c * 16384 + (q * 2 + hk)] = word; }
                __syncthreads();
            }
#undef IDX_LOADA
        }
    }
}

namespace at {
typedef short s16x4 __attribute__((ext_vector_type(4)));
constexpr int NSLOT = 3, SLOTB = 8192;
constexpr int LDS_K = 0, LDS_V = NSLOT * SLOTB, LDS_WS = 2 * NSLOT * SLOTB, LDS_TB = LDS_WS + 8 * 256, LDS_OST = 53248, LDS_BYTES = LDS_OST + 8 * 4096;
constexpr float LOG2E = 1.4426950408889634f;
__device__ __forceinline__ void glds16(const void* gsrc, unsigned lds_dst) { unsigned keep;
    asm volatile("s_mov_b32 %0, m0\n\ts_mov_b32 m0, %2\n\ts_nop 0\n\tglobal_load_lds_dwordx4 %1, off\n\ts_mov_b32 m0, %0" : "=&s"(keep) : "v"(gsrc), "s"(lds_dst) : "memory"); }
#define AT_WAIT_BAR(N) asm volatile("s_waitcnt vmcnt(" #N ") lgkmcnt(0)\n\ts_barrier" ::: "memory")
__device__ __forceinline__ h16x8 vtr8(const LAS unsigned char* p0, const LAS unsigned char* p1) {
    const s16x4 lo = __builtin_amdgcn_ds_read_tr16_b64_v4i16((LAS s16x4*)p0), hi = __builtin_amdgcn_ds_read_tr16_b64_v4i16((LAS s16x4*)p1);
    typedef short s16x8 __attribute__((ext_vector_type(8)));
    const s16x8 v = {lo[0], lo[1], lo[2], lo[3], hi[0], hi[1], hi[2], hi[3]}; return __builtin_bit_cast(h16x8, v); }
__device__ __forceinline__ h16x8 pack8(const f32x16& p, int b) {
    v4u w; w.x = cvt_pk_h16(p[b], p[b + 1]); w.y = cvt_pk_h16(p[b + 2], p[b + 3]); w.z = cvt_pk_h16(p[b + 4], p[b + 5]); w.w = cvt_pk_h16(p[b + 6], p[b + 7]); return __builtin_bit_cast(h16x8, w); }

__device__ __forceinline__ void attn_unit(int b, int h, int qb, const h16* Q, const h16* K, const h16* V, const unsigned* MASK, const float* relb, h16* O, LAS unsigned char* shm) {
    int tid_o = threadIdx.x; asm volatile("" : "+v"(tid_o));
    const int tid = tid_o, lane = tid & 63, r32 = lane & 31, hi = lane >> 5; const int wid = __builtin_amdgcn_readfirstlane(tid >> 6);
    const long rowbase = (long)b * SEQ; const int q0 = qb * 256, qw = q0 + wid * 32, cq = qw >> 6, NT = 4 * qb + 4;
    const h16* Qw = Q + (rowbase + qw) * 512 + h * 64;
    const h16* Kh = K + rowbase * 512 + h * 64; const h16* Vh = V + rowbase * 512 + h * 64;
    const unsigned lds0 = (unsigned)(uintptr_t)shm;
    LAS float* wsf = (LAS float*)(shm + LDS_WS) + wid * 64;
    LAS float* Tb = (LAS float*)(shm + LDS_TB);
    const h16* ksrc = Kh + (long)lane * 512 + wid * 8;
    const h16* vsrc = Vh + (long)(16 * (wid & 3) + (lane >> 2)) * 512 + (wid >> 2) * 32 + (lane & 3) * 8;
    const unsigned kdst = lds0 + LDS_K + wid * 1024, vdst = lds0 + LDS_V + wid * 1024;
#define AT_DMA_K(t, slot) glds16(ksrc + (long)(t) * 64 * 512, (unsigned)__builtin_amdgcn_readfirstlane(kdst + (slot)))
#define AT_DMA_V(t, slot) glds16(vsrc + (long)(t) * 64 * 512, (unsigned)__builtin_amdgcn_readfirstlane(vdst + (slot)))
    AT_DMA_K(0, 0); AT_DMA_V(0, 0); AT_DMA_K(1, SLOTB); AT_DMA_V(1, SLOTB);
    if (tid < 255) Tb[tid] = relb[t5_bucket(tid - 191) * 8 + h] * LOG2E;
    const float b15l = relb[15 * 8 + h] * LOG2E;
    h16x8 qr[4];
#pragma unroll
    for (int d0 = 0; d0 < 4; ++d0) qr[d0] = *(const h16x8*)(Qw + (long)r32 * 512 + d0 * 16 + hi * 8);
    const unsigned* mk = MASK + ((size_t)(b * 128) * 8192 + (qw + r32)) * 2 + hi;
    const LAS unsigned char* kp0 = shm + LDS_K + hi * 1024 + r32 * 16;
    const LAS unsigned char* vp0 = shm + LDS_V + ((lane >> 4) & 1) * 32 + (lane & 3) * 8 + (4 * hi + ((lane & 15) >> 2)) * 64;
    f32x16 o[2]; o[0] = f32x16{}; o[1] = f32x16{};
    float mref = 0.f, l = 0.f;
    int slot = 0, slot2 = 2 * SLOTB;
    unsigned mw_next = mk[0];
#pragma unroll 1
    for (int t = 0; t < NT; ++t) {
        const unsigned mw = mw_next; if (t + 1 < NT) mw_next = mk[(size_t)(t + 1) * 16384];
        if (t + 1 < NT) { AT_WAIT_BAR(2); } else { AT_WAIT_BAR(0); }
        if (t + 2 < NT) { AT_DMA_K(t + 2, slot2); AT_DMA_V(t + 2, slot2); }
        if (t <= cq) {
            const bool nearb = (t >= cq - 2);
            const float c0 = (nearb ? 0.f : b15l) - mref;
            f32x16 p0, p1;
#pragma unroll
            for (int r = 0; r < 16; ++r) { p0[r] = c0; p1[r] = c0; }
            const LAS unsigned char* kb = kp0 + slot;
#pragma unroll
            for (int d0 = 0; d0 < 4; ++d0) { const h16x8 k0 = *(const LAS h16x8*)(kb + d0 * 2048), k1 = *(const LAS h16x8*)(kb + d0 * 2048 + 512);
                p0 = __builtin_amdgcn_mfma_f32_32x32x16_f16(k0, qr[d0], p0, 0, 0, 0); p1 = __builtin_amdgcn_mfma_f32_32x32x16_f16(k1, qr[d0], p1, 0, 0, 0); }
            if (nearb) { const int ib = 64 * t - (qw + r32) + 191 + 4 * hi;
#pragma unroll
                for (int r = 0; r < 16; ++r) { const int kk = (r & 3) + 8 * (r >> 2); p0[r] += Tb[ib + kk]; p1[r] += Tb[ib + 32 + kk]; } }
            float mx = __builtin_fmaxf(__builtin_fmaxf(p0[0], p0[1]), p1[0]);
#pragma unroll
            for (int r = 1; r < 16; ++r) mx = __builtin_fmaxf(__builtin_fmaxf(mx, p0[r]), p1[r]);
            { auto rr = __builtin_amdgcn_permlane32_swap(__float_as_uint(mx), __float_as_uint(mx), false, false); mx = fmaxf(__uint_as_float(rr[0]), __uint_as_float(rr[1])); }
            if (t == 0 || __any(mx > 8.0f)) {
                const float d = (t == 0) ? mx : fmaxf(mx, 0.f); mref += d;
#pragma unroll
                for (int r = 0; r < 16; ++r) { p0[r] -= d; p1[r] -= d; }
                const float f = __builtin_amdgcn_exp2f(-d); l *= f;
                if (t != 0) { if (hi == 0) wsf[r32] = f; LDS_WAIT();
#pragma unroll
                    for (int r = 0; r < 16; ++r) { const float fr = wsf[crow(r, hi)]; o[0][r] *= fr; o[1][r] *= fr; } }
            }
#pragma unroll
            for (int r = 0; r < 16; ++r) {
                unsigned t0, t1;
                asm("v_bfe_i32 %0, %1, %2, 1" : "=v"(t0) : "v"(mw), "n"(15 - r)); asm("v_bfe_i32 %0, %1, %2, 1" : "=v"(t1) : "v"(mw), "n"(31 - r));
                p0[r] = __uint_as_float(__float_as_uint(__builtin_amdgcn_exp2f(p0[r])) & t0);
                p1[r] = __uint_as_float(__float_as_uint(__builtin_amdgcn_exp2f(p1[r])) & t1); }
            const h16x8 pa0 = pack8(p0, 0), pa1 = pack8(p0, 8), pa2 = pack8(p1, 0), pa3 = pack8(p1, 8);
            { typedef _Float16 h2 __attribute__((ext_vector_type(2))); const h2 one2 = {(h16)1.0f, (h16)1.0f}; float ps = 0.f;
#pragma unroll
              for (int k = 0; k < 4; ++k) { const h16x8 pk = (k == 0) ? pa0 : (k == 1) ? pa1 : (k == 2) ? pa2 : pa3;
#pragma unroll
                  for (int e = 0; e < 4; ++e) { const h2 pr = {pk[2 * e], pk[2 * e + 1]}; ps = __builtin_amdgcn_fdot2(pr, one2, ps, false); } }
              l += ps; }
            const LAS unsigned char* vb = vp0 + slot;
#pragma unroll
            for (int d0 = 0; d0 < 2; ++d0) {
                const h16x8 v0 = vtr8(vb + d0 * 4096, vb + d0 * 4096 + 512), v1 = vtr8(vb + d0 * 4096 + 1024, vb + d0 * 4096 + 1024 + 512);
                const h16x8 v2 = vtr8(vb + d0 * 4096 + 2048, vb + d0 * 4096 + 2048 + 512), v3 = vtr8(vb + d0 * 4096 + 3072, vb + d0 * 4096 + 3072 + 512);
                o[d0] = __builtin_amdgcn_mfma_f32_32x32x16_f16(pa0, v0, o[d0], 0, 0, 0); o[d0] = __builtin_amdgcn_mfma_f32_32x32x16_f16(pa1, v1, o[d0], 0, 0, 0);
                o[d0] = __builtin_amdgcn_mfma_f32_32x32x16_f16(pa2, v2, o[d0], 0, 0, 0); o[d0] = __builtin_amdgcn_mfma_f32_32x32x16_f16(pa3, v3, o[d0], 0, 0, 0); }
        }
        slot2 = slot; slot = (slot == (NSLOT - 1) * SLOTB) ? 0 : slot + SLOTB;
    }
    { auto rr = __builtin_amdgcn_permlane32_swap(__float_as_uint(l), __float_as_uint(l), false, false); l = __uint_as_float(rr[0]) + __uint_as_float(rr[1]); }
    if (hi == 0) wsf[32 + r32] = l;
    LDS_WAIT();
    h16* Ow = O + (rowbase + qw) * 512 + h * 64;
    { LAS h16* stg = (LAS h16*)(shm + LDS_OST) + wid * 2048;
#pragma unroll
      for (int r = 0; r < 16; ++r) { const int orow = crow(r, hi); const float rl = 1.0f / wsf[32 + orow];
#pragma unroll
          for (int d0 = 0; d0 < 2; ++d0) stg[orow * 64 + d0 * 32 + r32] = (h16)(o[d0][r] * rl); }
      LDS_WAIT();
#pragma unroll
      for (int i = 0; i < 4; ++i) { const int row = i * 8 + (lane >> 3), ch = lane & 7; const v4u v = *(const LAS v4u*)(stg + row * 64 + ch * 8); *(GAS v4u*)(Ow + (long)row * 512 + ch * 8) = v; } }
    asm volatile("s_waitcnt lgkmcnt(0)\n\ts_barrier" ::: "memory");
#undef AT_DMA_K
#undef AT_DMA_V
}
__device__ __forceinline__ void attn_phase(Frame& F, const Args& A) {
    unsigned char* ws = A.ws;
    for (int v = F.vcu; v < 256; v += F.G) {
        const int bh = v >> 4, s = v & 15;
#pragma unroll 1
        for (int i = 0; i < 2; ++i) attn_unit(bh >> 3, bh & 7, i ? 31 - s : s, (const h16*)(ws + WS_Q), (const h16*)(ws + WS_K), (const h16*)(ws + WS_V), (const unsigned*)(ws + WS_MASK), A.in[12], (h16*)(ws + WS_O), F.lds + RING_OFF);
    }
}
#undef AT_WAIT_BAR
}

__device__ __forceinline__ void attn_norm_phase(Frame& F, const Args& A) {
    unsigned char* ws = A.ws; const h16* O = (const h16*)(ws + WS_O); h16* MERGED = (h16*)(ws + WS_MERGED);
    const f32x4 g0 = *(const f32x4*)(A.in[20] + 8 * F.lane), g1 = *(const f32x4*)(A.in[20] + 8 * F.lane + 4);
    const int gw = F.vcu * NWAVES + F.wave, NGW = F.G * NWAVES;
    for (int row = gw; row < M; row += NGW) {
        const h16x8 v = *(const h16x8*)(O + (size_t)row * 512 + 8 * F.lane); float f[8]; float s = 0.f;
#pragma unroll
        for (int e = 0; e < 8; ++e) { f[e] = (float)v[e]; s += f[e] * f[e]; }
        const float rstd = 1.0f / sqrtf(wave_sum(s) * (1.0f / DATT) + EPS);
        v4u o; o.x = cvt_pk_h16(f[0] * rstd * g0.x, f[1] * rstd * g0.y); o.y = cvt_pk_h16(f[2] * rstd * g0.z, f[3] * rstd * g0.w);
        o.z = cvt_pk_h16(f[4] * rstd * g1.x, f[5] * rstd * g1.y); o.w = cvt_pk_h16(f[6] * rstd * g1.z, f[7] * rstd * g1.w);
        *(GAS v4u*)(MERGED + (size_t)row * 1024 + 8 * F.lane) = o;
    }
}

__global__ void __launch_bounds__(NTHR, 2) fwd_kernel(Args args) {
    extern __shared__ __attribute__((aligned(16))) unsigned char lds[];
    Frame F;
    F.lds = (LAS unsigned char*)lds;
    F.MISC = (volatile LAS unsigned*)(F.lds + MISC_OFF);
    F.tid = threadIdx.x; F.lane = F.tid & 63; F.wave = __builtin_amdgcn_readfirstlane(F.tid >> 6);
    F.G = gridDim.x; { const int bx = blockIdx.x; F.vcu = (F.G % 8 == 0) ? (bx % 8) * (F.G / 8) + bx / 8 : bx; }
    unsigned char* ws = args.ws;
    F.ctl = (gu32*)(ws + WS_CTL);
    for (int u = F.tid; u < (LDS_BYTES - LDSCTL_OFF) / 4; u += NTHR) ((LAS unsigned*)(F.lds + LDSCTL_OFF))[u] = 0u;
    __syncthreads();
    XcdBarrier bar; bar.bar = (unsigned*)(F.ctl + CW_BAR); bar.x = 0; bar.st = nullptr;
    if (N_LAUNCHES == 1) bar = xcd_barrier_post((unsigned*)(F.ctl + CW_BAR), F.MISC + 8);
    const int lo = args.ph_lo, hi = args.ph_hi;
#define IN(k) (lo <= (k) && (k) < hi)
#define SEAM(k) do { if (IN(k) && IN((k) + 1)) xcd_barrier(bar); } while (0)
    const float* mod = (const float*)(ws + WS_MOD);
    h16* H = (h16*)(ws + WS_H); h16* ACT = (h16*)(ws + WS_ACT); float* Y = (float*)(ws + WS_Y);
    const int bx = (int)blockIdx.x;

    if (IN(0)) { p0_prologue(F, args); } SEAM(0);
    if (IN(1)) { thin_phase<false, true>(F, mod, nullptr, nullptr, 0.f, 0, args.in[0], nullptr, args.in[4], 0, 1, H); } SEAM(1);
    if (IN(2)) { pg8::Gemm g{H, (const h16*)(ws + WS_W1GU), M, NGU, D}; pg8::StaticOrder S; S.init(M, NGU, F.G, bx);
        pg8::EpiSwiGLU E{ACT, FF}; pg8::gemm_phase<pg8::EpiSwiGLU, pg8::StaticOrder, true>(F.lds + RING_OFF, g, S, E); } SEAM(2);
    if (IN(3)) { pg8::Gemm g{ACT, (const h16*)(ws + WS_W1D), M, D, FF}; pg8::StaticOrder S; S.init(M, D, F.G, bx);
        pg8::EpiF32 E{Y, D}; pg8::gemm_phase<pg8::EpiF32, pg8::StaticOrder, false>(F.lds + RING_OFF, g, S, E); } SEAM(3);
    if (IN(4)) { thin_phase<true, true>(F, mod, Y, args.in[5], 0.5f, 2, args.in[0], args.out, args.in[9], 3, 4, H); } SEAM(4);
    if (IN(5)) { pg8::Gemm g{H, (const h16*)(ws + WS_WIN), M, NPROJ, D}; pg8::StaticOrder S; S.init(M, NPROJ, F.G, bx);
        pg8::EpiProj E{ws + WS_Q, (size_t)(WS_K - WS_Q), (h16*)(ws + WS_QS), (h16*)(ws + WS_KI), (float*)(ws + WS_WI), (h16*)(ws + WS_LRU)};
        pg8::gemm_phase<pg8::EpiProj, pg8::StaticOrder, true>(F.lds + RING_OFF, g, S, E); } SEAM(5);
    if (IN(6)) { lru_phase<false>(F, args); } if (IN(6) && IN(7)) __syncthreads();
    if (IN(7)) { idx_phase(F, args); } SEAM(7);
    if (IN(8)) { lru_phase<true>(F, args); } if (IN(8) && IN(9)) __syncthreads();
    if (IN(9)) { at::attn_phase(F, args); } SEAM(9);
    if (IN(10)) { attn_norm_phase(F, args); } SEAM(10);
    if (IN(11)) { pg8::Gemm g{(const h16*)(ws + WS_MERGED), (const h16*)(ws + WS_WOUT), M, D, D}; pg8::StaticOrder S; S.init(M, D, F.G, bx);
        pg8::EpiF32 E{Y, D}; pg8::gemm_phase<pg8::EpiF32, pg8::StaticOrder, false>(F.lds + RING_OFF, g, S, E); } SEAM(11);
    if (IN(12)) { thin_phase<true, true>(F, mod, Y, args.in[10], 1.0f, 5, args.out, args.out, args.in[23], 6, 7, H); } SEAM(12);
    if (IN(13)) { pg8::Gemm g{H, (const h16*)(ws + WS_W2GU), M, NGU, D}; pg8::StaticOrder S; S.init(M, NGU, F.G, bx);
        pg8::EpiSwiGLU E{ACT, FF}; pg8::gemm_phase<pg8::EpiSwiGLU, pg8::StaticOrder, true>(F.lds + RING_OFF, g, S, E); } SEAM(13);
    if (IN(14)) { pg8::Gemm g{ACT, (const h16*)(ws + WS_W2D), M, D, FF}; pg8::StaticOrder S; S.init(M, D, F.G, bx);
        pg8::EpiF32 E{Y, D}; pg8::gemm_phase<pg8::EpiF32, pg8::StaticOrder, false>(F.lds + RING_OFF, g, S, E); } SEAM(14);
    if (IN(15)) { thin_phase<true, false>(F, mod, Y, args.in[24], 0.5f, 8, args.out, args.out, nullptr, 0, 0, nullptr); }
#undef IN
#undef SEAM
}

extern "C" void kernel_launch(void* const* d_in, const int* in_sizes, int n_in, void* d_out, int out_size, void* d_ws, size_t ws_size, hipStream_t stream) {
    static int grid = 0;
    if (grid == 0) {
        if (n_in != 28 || in_sizes[0] != M * D || out_size != M * D || ws_size < WS_END) { fprintf(stderr, "kernel_launch: unexpected shapes (n_in %d, in0 %d, out %d, ws %zu); nothing launched\n", n_in, n_in > 0 ? in_sizes[0] : -1, out_size, ws_size); grid = -1; return; }
        int dev = 0, cus = 0, per_cu = 0;
        if (hipGetDevice(&dev) != hipSuccess || hipDeviceGetAttribute(&cus, hipDeviceAttributeMultiprocessorCount, dev) != hipSuccess) { grid = -1; return; }
        if (hipFuncSetAttribute((const void*)fwd_kernel, hipFuncAttributeMaxDynamicSharedMemorySize, LDS_BYTES) != hipSuccess) { fprintf(stderr, "kernel_launch: hipFuncSetAttribute failed\n"); grid = -1; return; }
        if (hipOccupancyMaxActiveBlocksPerMultiprocessor(&per_cu, (const void*)fwd_kernel, NTHR, LDS_BYTES) != hipSuccess || per_cu < 1) { fprintf(stderr, "kernel_launch: occupancy query reports %d\n", per_cu); }
        (void)hipGetLastError();
        grid = cus;
    }
    if (grid < 0) return;
    if (hipMemsetAsync((char*)d_ws + WS_CTL, 0, CTL_ZERO_BYTES, stream) != hipSuccess) return;
    Args a{};
    for (int i = 0; i < 28; ++i) a.in[i] = (const float*)d_in[i];
    a.out = (float*)d_out; a.ws = (unsigned char*)d_ws;
    if (N_LAUNCHES == 1) { a.ph_lo = 0; a.ph_hi = N_PHASES; a.li = 0; hipLaunchKernelGGL(fwd_kernel, dim3(grid), dim3(NTHR), LDS_BYTES, stream, a); }
    else { for (int p = 0; p < N_PHASES; ++p) { a.ph_lo = p; a.ph_hi = p + 1; a.li = p; const int reps = (p == PROBE_PHASE) ? 2 : 1;
        for (int rr = 0; rr < reps; ++rr) hipLaunchKernelGGL(fwd_kernel, dim3(grid), dim3(NTHR), LDS_BYTES, stream, a); } }
}
```

```cpp
#include <hip/hip_runtime.h>
#include <cstdio>
#include <cstdint>

#ifndef PROBE_PHASE
#define PROBE_PHASE -1
#endif
#ifndef MK_N_LAUNCHES
#define MK_N_LAUNCHES 1
#endif

namespace pg8 {
#define PG8_LAS __attribute__((address_space(3)))
typedef _Float16 h16;
typedef _Float16 h16x8 __attribute__((ext_vector_type(8)));
typedef _Float16 h16x2 __attribute__((ext_vector_type(2)));
typedef float f32x4 __attribute__((ext_vector_type(4)));
typedef float f32x2 __attribute__((ext_vector_type(2)));
typedef unsigned u32x4 __attribute__((ext_vector_type(4)));
constexpr int BM = 256, BK = 64, HALF = 128, HTB = HALF * BK * 2, STAGE_BYTES = 8 * HTB, NXCD = 8, WGM = 8;

__host__ __device__ __forceinline__ int lds_byte(int r, int c) { const int st = (r >> 4) * 2 + (c >> 5), rr = r & 15, cc = c & 31, ob = rr * 64 + cc * 2; return st * 1024 + (ob ^ (((ob >> 9) & 1) << 5)); }
__host__ __device__ __forceinline__ void stage_rc(int b, int& R, int& C) { const int st = b / 1024, sb = b % 1024, swz = sb ^ (((sb >> 9) & 1) << 5); R = (st >> 1) * 16 + swz / 64; C = (st & 1) * 32 + (swz % 64) / 2; }
__host__ __device__ __forceinline__ int perm32(int rho) { const int n = rho >> 4, i = rho & 15; return 8 * (i >> 2) + 4 * n + (i & 3); }

struct Unit { int pm, pn; };
struct Gemm { const h16* A; const h16* Bt; int M, N, K; };

struct StaticOrder {
    int nM, nN, nwg, G, c;
    __host__ __device__ void init(int M, int N, int G_, int c_) { nM = M / BM; nN = N / BM; nwg = nM * nN; G = G_; c = c_; }
    __host__ __device__ bool next(int i, Unit& u) const {
        const long L = (long)i * G + c; if (L >= nwg) return false;
        int wgid = (int)L; { const int q = nwg / NXCD, r = nwg % NXCD, xcd = wgid % NXCD, off = wgid / NXCD; wgid = (xcd < r ? xcd * (q + 1) : r * (q + 1) + (xcd - r) * q) + off; }
        const int nig = WGM * nN, gid = wgid / nig, fm = gid * WGM, gsz = (nM - fm) < WGM ? (nM - fm) : WGM;
        u.pm = fm + ((wgid % nig) % gsz); u.pn = (wgid % nig) / gsz; return true;
    }
    __device__ __forceinline__ void a_ready(const Unit&) const {}
    __device__ __forceinline__ void done(const Unit&) const {}
};

__device__ __forceinline__ unsigned cvt_pk_h16(float lo, float hi) { f32x2 v = {lo, hi}; h16x2 h = __builtin_convertvector(v, h16x2); return __builtin_bit_cast(unsigned, h); }

struct EpiF32 {
    static constexpr bool PERM = false, AFTER_DRAIN = false;
    float* C; int ldc;
    __device__ __forceinline__ void operator()(const f32x4 (&acc)[2][2][4][2], const Unit& u, int wr, int wc, int fr, int fq) const {
        const int row0 = u.pm * BM + wr * 64 + fr, col0 = u.pn * BM + wc * 32 + 4 * fq;
#pragma unroll
        for (int ai = 0; ai < 2; ++ai)
#pragma unroll
            for (int m = 0; m < 4; ++m) { float* rowp = C + (size_t)(row0 + ai * HALF + m * 16) * ldc + col0;
#pragma unroll
                for (int bj = 0; bj < 2; ++bj)
#pragma unroll
                    for (int n = 0; n < 2; ++n) *(f32x4*)(rowp + bj * HALF + n * 16) = acc[ai][bj][m][n]; }
    }
};
struct EpiSwiGLU {
    static constexpr bool PERM = true, AFTER_DRAIN = false;
    h16* O; int ldc;
    __device__ __forceinline__ void operator()(const f32x4 (&acc)[2][2][4][2], const Unit& u, int wr, int wc, int fr, int fq) const {
        const int row0 = u.pm * BM + wr * 64 + fr, col0 = u.pn * HALF + wc * 32 + 8 * fq;
#pragma unroll
        for (int ai = 0; ai < 2; ++ai)
#pragma unroll
            for (int m = 0; m < 4; ++m) { h16* rowp = O + (size_t)(row0 + ai * HALF + m * 16) * ldc + col0;
                float v[8];
#pragma unroll
                for (int n = 0; n < 2; ++n)
#pragma unroll
                    for (int i = 0; i < 4; ++i) { const float g = acc[ai][0][m][n][i], up = acc[ai][1][m][n][i];
                        const float e = __builtin_amdgcn_exp2f(-1.4426950408889634f * g); v[4 * n + i] = g * __builtin_amdgcn_rcpf(1.0f + e) * up; }
                u32x4 w; w.x = cvt_pk_h16(v[0], v[1]); w.y = cvt_pk_h16(v[2], v[3]); w.z = cvt_pk_h16(v[4], v[5]); w.w = cvt_pk_h16(v[6], v[7]);
                *(u32x4*)rowp = w; }
    }
};
struct EpiProj {
    static constexpr bool PERM = true, AFTER_DRAIN = false;
    unsigned char* qkv; size_t qkv_stride; h16* QS; h16* KI; float* WI; h16* LRU;
    __device__ __forceinline__ void store_h16(const f32x4 (&acc)[2][2][4][2], h16* base, int ld, int row0, int c0, float sc) const {
#pragma unroll
        for (int ai = 0; ai < 2; ++ai)
#pragma unroll
            for (int m = 0; m < 4; ++m) { h16* rowp = base + (size_t)(row0 + ai * HALF + m * 16) * ld + c0;
#pragma unroll
                for (int bj = 0; bj < 2; ++bj) { const f32x4 v0 = acc[ai][bj][m][0] * sc, v1 = acc[ai][bj][m][1] * sc;
                    u32x4 w; w.x = cvt_pk_h16(v0[0], v0[1]); w.y = cvt_pk_h16(v0[2], v0[3]); w.z = cvt_pk_h16(v1[0], v1[1]); w.w = cvt_pk_h16(v1[2], v1[3]);
                    *(u32x4*)(rowp + bj * HALF) = w; } }
    }
    __device__ __forceinline__ void operator()(const f32x4 (&acc)[2][2][4][2], const Unit& u, int wr, int wc, int fr, int fq) const {
        const int row0 = u.pm * BM + wr * 64 + fr, cw = wc * 32 + 8 * fq; const int pn = u.pn;
        if (pn < 6) { store_h16(acc, (h16*)(qkv + (size_t)(pn >> 1) * qkv_stride), 512, row0, (pn & 1) * 256 + cw, pn < 2 ? 0.125f * 1.4426950408889634f : 1.0f); }
        else if (pn >= 9) { store_h16(acc, LRU, 1024, row0, (pn - 9) * 256 + cw, 1.0f); }
        else if (pn < 8) { store_h16(acc, QS, 512, row0, (pn - 6) * 256 + cw, 0.125f); }
        else {
#pragma unroll
            for (int ai = 0; ai < 2; ++ai)
#pragma unroll
                for (int m = 0; m < 4; ++m) { const size_t row = (size_t)(row0 + ai * HALF + m * 16); const f32x4 v0 = acc[ai][0][m][0], v1 = acc[ai][0][m][1];
                    if (cw < 64) { u32x4 w; w.x = cvt_pk_h16(v0[0], v0[1]); w.y = cvt_pk_h16(v0[2], v0[3]); w.z = cvt_pk_h16(v1[0], v1[1]); w.w = cvt_pk_h16(v1[2], v1[3]); *(u32x4*)(KI + row * 64 + cw) = w; }
                    else if (cw == 64) { const float sc = 0.5f * 0.35355339059327373f; *(f32x4*)(WI + row * 8) = v0 * sc; *(f32x4*)(WI + row * 8 + 4) = v1 * sc; } }
        }
    }
};

template <class Epi, class Sched, bool ALIGN_EPI = false>
__device__ __forceinline__ void gemm_phase(PG8_LAS unsigned char* lds, const Gemm g, const Sched& S, const Epi& E) {
    const int tid = threadIdx.x, wid = __builtin_amdgcn_readfirstlane(tid >> 6), lane = tid & 63, wr = wid >> 2, wc = wid & 3, fr = lane & 15, fq = lane >> 4;
    const int K = g.K, nt = K / BK;
    unsigned voffA[2], voffB[2];
#pragma unroll
    for (int i = 0; i < 2; ++i) { int R, C; stage_rc(tid * 16 + i * 8192, R, C); const int Rb = Epi::PERM ? ((R & ~31) + perm32(R & 31)) : R;
        voffA[i] = (unsigned)(R * K + C) * 2u; voffB[i] = (unsigned)(Rb * K + C) * 2u; }
    const size_t kstep = (size_t)(BK * 2);
    const size_t hstep = (size_t)HALF * K * 2;
    const size_t tstep = 2 * hstep;
    const unsigned ldsw = (unsigned)wid * 1024u;
    const int aoff = lds_byte(wr * 64 + fr, fq * 8), boff = lds_byte(wc * 32 + fr, fq * 8);
#define PG8_SA(b, h) (((b) * 2 + (h)) * HTB)
#define PG8_SB(b, h) ((4 + (b) * 2 + (h)) * HTB)
#define PG8_STAGE(bufoff, gbase, voff) do { _Pragma("unroll") for (int _i = 0; _i < 2; ++_i) \
        __builtin_amdgcn_global_load_lds((const unsigned*)((const char*)(gbase) + (voff)[_i]), (PG8_LAS unsigned*)(lds + (bufoff) + ldsw + _i * 8192), 16, 0, 0); } while (0)
#define PG8_LDA(dst, b, h) do { _Pragma("unroll") for (int m = 0; m < 4; ++m) _Pragma("unroll") for (int k = 0; k < 2; ++k) dst[m][k] = *(const PG8_LAS h16x8*)(lds + PG8_SA(b, h) + aoff + m * 2048 + k * 1024); } while (0)
#define PG8_LDB(dst, b, h) do { _Pragma("unroll") for (int n = 0; n < 2; ++n) _Pragma("unroll") for (int k = 0; k < 2; ++k) dst[n][k] = *(const PG8_LAS h16x8*)(lds + PG8_SB(b, h) + boff + n * 2048 + k * 1024); } while (0)
#define PG8_MMA(ai, bj, At, Bt) do { __builtin_amdgcn_s_setprio(1); _Pragma("unroll") for (int m = 0; m < 4; ++m) _Pragma("unroll") for (int n = 0; n < 2; ++n) _Pragma("unroll") for (int k = 0; k < 2; ++k) \
        acc[ai][bj][m][n] = __builtin_amdgcn_mfma_f32_16x16x32_f16(Bt[n][k], At[m][k], acc[ai][bj][m][n], 0, 0, 0); __builtin_amdgcn_s_setprio(0); } while (0)
#define PG8_WAIT_V(n) asm volatile("s_waitcnt vmcnt(" #n ")" ::: "memory")
#define PG8_WAIT_L(n) asm volatile("s_waitcnt lgkmcnt(" #n ")" ::: "memory")
#define PG8_BAR __builtin_amdgcn_s_barrier()
#define PG8_SCHED __builtin_amdgcn_sched_barrier(0)
    Unit cur, nxt; int ui = 0;
    if (!S.next(0, cur)) return;
    f32x4 acc[2][2][4][2];
#pragma unroll
    for (int a = 0; a < 2; ++a)
#pragma unroll
        for (int b = 0; b < 2; ++b)
#pragma unroll
            for (int m = 0; m < 4; ++m)
#pragma unroll
                for (int n = 0; n < 2; ++n) acc[a][b][m][n] = (f32x4){0.f, 0.f, 0.f, 0.f};
    h16x8 At[4][2], B0[2][2], B1[2][2];
    const char* cA = (const char*)g.A + (size_t)cur.pm * tstep; const char* cB = (const char*)g.Bt + (size_t)cur.pn * tstep;
    S.a_ready(cur);
    PG8_STAGE(PG8_SB(0, 0), cB, voffB); PG8_STAGE(PG8_SB(0, 1), cB + hstep, voffB); PG8_STAGE(PG8_SA(0, 0), cA, voffA); PG8_STAGE(PG8_SA(0, 1), cA + hstep, voffA);
    if (wr == 1) PG8_BAR;
    PG8_WAIT_V(2); PG8_BAR;
    PG8_STAGE(PG8_SB(1, 0), cB + kstep, voffB); PG8_STAGE(PG8_SA(1, 0), cA + kstep, voffA); PG8_STAGE(PG8_SB(1, 1), cB + hstep + kstep, voffB);
    PG8_WAIT_V(6); PG8_BAR;
    for (;;) {
        const bool has_next = S.next(ui + 1, nxt);
        const char* nA = has_next ? (const char*)g.A + (size_t)nxt.pm * tstep : cA; const char* nB = has_next ? (const char*)g.Bt + (size_t)nxt.pn * tstep : cB;
        for (int t = 0; t < nt; t += 2) {
            const bool last = (t == nt - 2);
            const char* a1 = cA + (size_t)(t + 1) * kstep;
            const char* a2 = last ? nA : cA + (size_t)(t + 2) * kstep; const char* b2 = last ? nB : cB + (size_t)(t + 2) * kstep;
            const char* a3 = a2 + kstep; const char* b3 = b2 + kstep;
            if (last && has_next) S.a_ready(nxt);
            PG8_LDB(B0, 0, 0); PG8_LDB(B1, 0, 1); PG8_SCHED; PG8_LDA(At, 0, 0); PG8_STAGE(PG8_SA(1, 1), a1 + hstep, voffA);
            PG8_WAIT_V(8); PG8_WAIT_L(0); PG8_BAR; PG8_MMA(0, 0, At, B0); PG8_MMA(0, 1, At, B1); PG8_BAR; PG8_SCHED;
            PG8_LDA(At, 0, 1); PG8_STAGE(PG8_SB(0, 0), b2, voffB); PG8_STAGE(PG8_SB(0, 1), b2 + hstep, voffB); PG8_STAGE(PG8_SA(0, 0), a2, voffA);
            PG8_WAIT_V(8); PG8_WAIT_L(0); PG8_BAR; PG8_MMA(1, 0, At, B0); PG8_MMA(1, 1, At, B1); PG8_BAR; PG8_SCHED;
            PG8_LDB(B0, 1, 0); PG8_LDB(B1, 1, 1); PG8_SCHED; PG8_LDA(At, 1, 0); PG8_STAGE(PG8_SA(0, 1), a2 + hstep, voffA);
            PG8_WAIT_V(8); PG8_WAIT_L(0); PG8_BAR; PG8_MMA(0, 0, At, B0); PG8_MMA(0, 1, At, B1); PG8_BAR; PG8_SCHED;
            PG8_LDA(At, 1, 1); PG8_STAGE(PG8_SB(1, 0), b3, voffB); PG8_STAGE(PG8_SB(1, 1), b3 + hstep, voffB); PG8_STAGE(PG8_SA(1, 0), a3, voffA);
            PG8_WAIT_V(8); PG8_WAIT_L(0); PG8_BAR; PG8_MMA(1, 0, At, B0); PG8_MMA(1, 1, At, B1); PG8_BAR; PG8_SCHED;
        }
        if constexpr (ALIGN_EPI) { if (wr == 0) PG8_BAR; }
        E(acc, cur, wr, wc, fr, fq); S.done(cur);
        if (!has_next) break;
#pragma unroll
        for (int a = 0; a < 2; ++a)
#pragma unroll
            for (int b = 0; b < 2; ++b)
#pragma unroll
                for (int m = 0; m < 4; ++m)
#pragma unroll
                    for (int n = 0; n < 2; ++n) acc[a][b][m][n] = (f32x4){0.f, 0.f, 0.f, 0.f};
        cur = nxt; cA = nA; cB = nB; ++ui;
        if constexpr (ALIGN_EPI) { if (wr == 1) PG8_BAR; }
    }
    PG8_WAIT_V(0);
    if constexpr (!ALIGN_EPI) { if (wr == 0) PG8_BAR; }
    PG8_BAR;
#undef PG8_SA
#undef PG8_SB
#undef PG8_STAGE
#undef PG8_LDA
#undef PG8_LDB
#undef PG8_MMA
#undef PG8_WAIT_V
#undef PG8_WAIT_L
#undef PG8_BAR
#undef PG8_SCHED
}
}

constexpr int NWAVES = 8, NTHR = NWAVES * 64;
constexpr int N_LAUNCHES = MK_N_LAUNCHES;
constexpr int N_PHASES = 16;
constexpr int BATCH = 2, SEQ = 8192, D = 1024, FF = 2816, M = BATCH * SEQ;
constexpr int NGU = 2 * FF;
constexpr int NPROJ = 3328;
constexpr int DIN = 3144;
constexpr int NH = 8, HD = 64, DATT = 512, DLRU = 512, TOPK = 256, CHUNK = 64;
constexpr int LCH = 32, NLCH = SEQ / LCH;
constexpr float EPS = 1e-6f;

constexpr size_t MiB = 1u << 20;
constexpr size_t WS_CTL = 0, CTL_ZERO_BYTES = 1 * MiB;
constexpr size_t WS_MOD = 1 * MiB;
constexpr size_t WS_LRUW = 2 * MiB;
constexpr size_t WS_LRUS = 246 * MiB;
constexpr size_t WS_W1GU = 3 * MiB, WS_W1D = 14 * MiB, WS_WIN = 20 * MiB, WS_WOUT = 27 * MiB, WS_W2GU = 29 * MiB, WS_W2D = 40 * MiB;
constexpr size_t WS_H = 46 * MiB;
constexpr size_t WS_ACT = 78 * MiB;
constexpr size_t WS_Y = 166 * MiB;
constexpr size_t WS_Q = 78 * MiB, WS_K = 94 * MiB, WS_V = 110 * MiB;
constexpr size_t WS_QS = 126 * MiB;
constexpr size_t WS_O = 142 * MiB;
constexpr size_t WS_KI = 158 * MiB;
constexpr size_t WS_WI = 160 * MiB;
constexpr size_t WS_MASK = 230 * MiB;
constexpr size_t WS_LRU = 166 * MiB;
constexpr size_t WS_MERGED = WS_H;
constexpr size_t WS_END = 248 * MiB;
constexpr int CW_BAR = 4096;

constexpr int RING_OFF = 0, RING_BYTES = 131072;
constexpr int LDSCTL_OFF = RING_BYTES, MISC_OFF = LDSCTL_OFF + 320;
constexpr int LDS_BYTES = 147456;

#define GAS __attribute__((address_space(1)))
#define LAS __attribute__((address_space(3)))
typedef _Float16 h16;
typedef unsigned v4u __attribute__((ext_vector_type(4)));
typedef unsigned v2u __attribute__((ext_vector_type(2)));
typedef float f32x4 __attribute__((ext_vector_type(4)));
typedef _Float16 h16x8 __attribute__((ext_vector_type(8)));
typedef _Float16 h16x4 __attribute__((ext_vector_type(4)));
typedef GAS unsigned gu32;
#define RLX_AGENT __ATOMIC_RELAXED, __HIP_MEMORY_SCOPE_AGENT
#define LDS_WAIT() asm volatile("s_waitcnt lgkmcnt(0)" ::: "memory")
#define VM_WAIT() asm volatile("s_waitcnt vmcnt(0)" ::: "memory")
using pg8::cvt_pk_h16;

#define XB_TMO      128
#define XB_XCNT(j)  (256  + 64 * (j))
#define XB_XSUB(j)  (1280 + 64 * (j))
#define XB_XGEN(j)  (2304 + 64 * (j))
#define XB_TOP      3328
#define XB_TOPGEN   3392
#define XCD_BAR_WORDS 3456
#define XB_SPIN_CAP (1u << 18)
__device__ __forceinline__ unsigned xb_ld(unsigned* p)              { return __hip_atomic_load(p, __ATOMIC_RELAXED, __HIP_MEMORY_SCOPE_AGENT); }
__device__ __forceinline__ unsigned xb_add(unsigned* p, unsigned v) { return __hip_atomic_fetch_add(p, v, __ATOMIC_RELAXED, __HIP_MEMORY_SCOPE_AGENT); }
__device__ __forceinline__ unsigned xb_xcc_id() { return (unsigned)__builtin_amdgcn_s_getreg((3 << 11) | 20) & 0xFu; }
#define XB_SPIN(cond, bar) do { unsigned _sp = 0; while (cond) { __builtin_amdgcn_s_sleep(1); \
    if ((++_sp & 255u) == 0u) { if (xb_ld(&(bar)[XB_TMO])) break; if (_sp > XB_SPIN_CAP) { atomicAdd(&(bar)[XB_TMO], 1u); break; } } } } while (0)
struct XcdBarrier { unsigned* bar; unsigned x; volatile LAS unsigned* st; };
__device__ __forceinline__ XcdBarrier xcd_barrier_post(unsigned* bar, volatile LAS unsigned* st) {
    XcdBarrier b; b.bar = bar; b.x = xb_xcc_id(); b.st = st;
    if (threadIdx.x == 0) (void)xb_add(&bar[XB_XCNT(b.x)], 1u);
    return b;
}
__device__ __forceinline__ void xcd_barrier_complete(unsigned* bar, unsigned x, unsigned& nloc, unsigned& nx) {
    const unsigned G = gridDim.x * gridDim.y * gridDim.z;
    unsigned sum, cnt, mine, sp = 0u;
    for (;;) {
        sum = 0u; cnt = 0u; mine = 0u;
#pragma unroll
        for (unsigned j = 0; j < 16; ++j) { const unsigned c = xb_ld(&bar[XB_XCNT(j)]); sum += c; cnt += (c > 0u) ? 1u : 0u; mine = (j == x) ? c : mine; }
        if (sum == G) break;
        __builtin_amdgcn_s_sleep(1);
        if ((++sp & 255u) == 0u) { if (xb_ld(&bar[XB_TMO])) break; if (sp > XB_SPIN_CAP) { atomicAdd(&bar[XB_TMO], 1u); break; } }
    }
    nloc = mine > 0u ? mine : 1u; nx = cnt > 0u ? cnt : 1u;
}
__device__ __forceinline__ void xcd_barrier(const XcdBarrier& b) {
    asm volatile("s_waitcnt vmcnt(0)" ::: "memory");
    __syncthreads();
    if (threadIdx.x == 0) {
        unsigned* bar = b.bar;
        __builtin_amdgcn_s_waitcnt(0);
        unsigned nloc = b.st[0], nx = b.st[1];
        if (nloc == 0u) { xcd_barrier_complete(bar, b.x, nloc, nx); b.st[0] = nloc; b.st[1] = nx; }
        const unsigned old = xb_add(&bar[XB_XSUB(b.x)], 1u);
        const unsigned gen = old / nloc;
        if (old + 1u == (gen + 1u) * nloc) {
            __builtin_amdgcn_fence(__ATOMIC_RELEASE, "agent");
            asm volatile("s_waitcnt vmcnt(0)" ::: "memory");
            const unsigned og = xb_add(&bar[XB_TOP], 1u);
            const unsigned tg = og / nx;
            if (og + 1u == (tg + 1u) * nx) xb_add(&bar[XB_TOPGEN], 1u);
            else XB_SPIN(xb_ld(&bar[XB_TOPGEN]) == tg, bar);
            __builtin_amdgcn_fence(__ATOMIC_ACQUIRE, "agent");
            xb_add(&bar[XB_XGEN(b.x)], 1u);
            asm volatile("s_waitcnt vmcnt(0)" ::: "memory");
        } else {
            XB_SPIN(xb_ld(&bar[XB_XGEN(b.x)]) == gen, bar);
            __builtin_amdgcn_fence(__ATOMIC_ACQUIRE, "agent");
            asm volatile("s_waitcnt vmcnt(0)" ::: "memory");
        }
    }
    __syncthreads();
}

struct Frame {
    LAS unsigned char* lds;
    volatile LAS unsigned* MISC;
    gu32* ctl;
    int tid, lane, wave;
    int vcu, G;
};
struct Args { const float* in[28]; float* out; unsigned char* ws; int ph_lo, ph_hi, li, pad; };

__device__ __forceinline__ float wave_sum(float v) {
#pragma unroll
    for (int o = 1; o < 64; o <<= 1) v += __shfl_xor(v, o);
    return v;
}
__device__ __forceinline__ float wave_max(float v) {
#pragma unroll
    for (int o = 1; o < 64; o <<= 1) v = fmaxf(v, __shfl_xor(v, o));
    return v;
}

struct MapId { __device__ __forceinline__ int operator()(int n) const { return n; } };
struct MapGU { int half; __device__ __forceinline__ int operator()(int n) const { return (n >> 7) * 256 + half * 128 + (n & 127); } };
struct MapIn { __device__ __forceinline__ int operator()(int n) const { return n < 2120 ? n : n + 184; } };
template <class RowMap>
__device__ __forceinline__ void p0_transpose_item(const float* W, int K, int N, h16* WT, RowMap rm, LAS float* scr, int item, int lane) {
    const int nblk = (N + 31) / 32, kb = item / nblk, nb = item % nblk, k0 = 64 * kb, n0 = 32 * nb;
    const int nl = n0 + (lane & 31);
#pragma unroll 8
    for (int i = 0; i < 32; ++i) { const int kk = 2 * i + (lane >> 5); scr[kk * 33 + (lane & 31)] = (nl < N) ? W[(size_t)(k0 + kk) * N + nl] : 0.f; }
    LDS_WAIT(); asm volatile("" ::: "memory");
    const int c = lane & 7;
#pragma unroll
    for (int j = 0; j < 4; ++j) { const int nn = (lane >> 3) + 8 * j; const LAS float* s = scr + (8 * c) * 33 + nn;
        v4u o; o.x = cvt_pk_h16(s[0 * 33], s[1 * 33]); o.y = cvt_pk_h16(s[2 * 33], s[3 * 33]); o.z = cvt_pk_h16(s[4 * 33], s[5 * 33]); o.w = cvt_pk_h16(s[6 * 33], s[7 * 33]);
        if (n0 + nn < N) *(GAS v4u*)(WT + (size_t)rm(n0 + nn) * K + k0 + 8 * c) = o; }
    LDS_WAIT(); asm volatile("" ::: "memory");
}

__device__ __forceinline__ void p0_prologue(Frame& F, const Args& A) {
    unsigned char* ws = A.ws;
    if (blockIdx.x < 36) {
        LAS float* sc = (LAS float*)(F.lds);
        LAS float* red = (LAS float*)(F.lds + 8192);
        const float* c = A.in[1];
        for (int i = F.tid; i < 2048; i += NTHR) { const float v = c[i]; sc[i] = v / (1.0f + __expf(-v)); }
        __syncthreads();
        const float* wa = A.in[2]; const int col = blockIdx.x * 256 + 4 * F.lane;
        f32x4 a0 = {0.f, 0.f, 0.f, 0.f}, a1 = {0.f, 0.f, 0.f, 0.f};
        const int kb = F.wave * 128;
#pragma unroll 8
        for (int k = 0; k < 128; ++k) { const f32x4 w = *(const f32x4*)(wa + (size_t)(kb + k) * 9216 + col); a0 += w * sc[kb + k]; a1 += w * sc[1024 + kb + k]; }
        *(LAS f32x4*)(red + (F.wave * 2 + 0) * 256 + 4 * F.lane) = a0; *(LAS f32x4*)(red + (F.wave * 2 + 1) * 256 + 4 * F.lane) = a1;
        __syncthreads();
        { const int b = F.tid >> 8, j = F.tid & 255; float s = 0.f;
#pragma unroll
          for (int w = 0; w < 8; ++w) s += red[(w * 2 + b) * 256 + j];
          const int cc = blockIdx.x * 256 + j; ((float*)(ws + WS_MOD))[b * 9216 + cc] = s + A.in[3][cc]; }
        __syncthreads();
    }
    LAS float* scr = (LAS float*)(F.lds + RING_OFF + F.wave * 16384);
    const int gw = F.vcu * NWAVES + F.wave, NGW = F.G * NWAVES;
    constexpr int I_GU = (D / 64) * (FF / 32), I_DN = (FF / 64) * (D / 32), I_IN = (D / 64) * ((DIN + 31) / 32), I_OUT = (D / 64) * (D / 32);
    constexpr int NITEMS = 6 * I_GU + I_IN + I_OUT; static_assert(I_GU == I_DN, "items");
    h16* W1GU = (h16*)(ws + WS_W1GU); h16* W1D = (h16*)(ws + WS_W1D); h16* WIN = (h16*)(ws + WS_WIN); h16* WOUT = (h16*)(ws + WS_WOUT); h16* W2GU = (h16*)(ws + WS_W2GU); h16* W2D = (h16*)(ws + WS_W2D);
    for (int it = gw; it < NITEMS; it += NGW) {
        int r = it;
        if (r < I_GU) { p0_transpose_item(A.in[6], D, FF, W1GU, MapGU{0}, scr, r, F.lane); continue; } r -= I_GU;
        if (r < I_GU) { p0_transpose_item(A.in[7], D, FF, W1GU, MapGU{1}, scr, r, F.lane); continue; } r -= I_GU;
        if (r < I_DN) { p0_transpose_item(A.in[8], FF, D, W1D, MapId{}, scr, r, F.lane); continue; } r -= I_DN;
        if (r < I_IN) { p0_transpose_item(A.in[11], D, DIN, WIN, MapIn{}, scr, r, F.lane); continue; } r -= I_IN;
        if (r < I_OUT) { p0_transpose_item(A.in[22], D, D, WOUT, MapId{}, scr, r, F.lane); continue; } r -= I_OUT;
        if (r < I_GU) { p0_transpose_item(A.in[25], D, FF, W2GU, MapGU{0}, scr, r, F.lane); continue; } r -= I_GU;
        if (r < I_GU) { p0_transpose_item(A.in[26], D, FF, W2GU, MapGU{1}, scr, r, F.lane); continue; } r -= I_GU;
        p0_transpose_item(A.in[27], FF, D, W2D, MapId{}, scr, r, F.lane);
    }
    for (int tk = gw; tk < 128; tk += NGW) { const int s4 = tk & 3, jt = (tk >> 2) & 1, g = (tk >> 3) & 7, gate = tk >> 6; const float* W = A.in[gate ? 17 : 15]; const int r = F.lane & 31, hh = F.lane >> 5;
        float v[8];
#pragma unroll
        for (int e = 0; e < 8; ++e) v[e] = W[(g * 64 + 16 * s4 + 8 * hh + e) * 64 + 32 * jt + r];
        v4u o; o.x = cvt_pk_h16(v[0], v[1]); o.y = cvt_pk_h16(v[2], v[3]); o.z = cvt_pk_h16(v[4], v[5]); o.w = cvt_pk_h16(v[6], v[7]);
        *(GAS v4u*)(ws + WS_LRUW + ((size_t)tk * 64 + F.lane) * 16) = o; }
    for (int i = blockIdx.x * NTHR + F.tid; i < 184 * 128; i += F.G * NTHR) *(GAS v4u*)(WIN + (size_t)2120 * D + (size_t)i * 8) = (v4u){0u, 0u, 0u, 0u};
}

template <bool HAS_Y, bool HAS_H>
__device__ __forceinline__ void thin_phase(Frame& F, const float* mod, const float* yin, const float* gpost, float gscale, int mg,
                                           const float* xin, float* xout, const float* gpre, int msh, int msc, h16* hout) {
    LAS float* TA = (LAS float*)(F.lds); LAS float* TB = TA + 2048; LAS float* TC = TB + 2048;
    for (int i = F.tid; i < 2048; i += NTHR) { const int b = i >> 10, cidx = i & 1023;
        if (HAS_Y) TA[i] = gscale * mod[b * 9216 + mg * 1024 + cidx] * gpost[cidx];
        if (HAS_H) { TB[i] = gpre[cidx] * (1.0f + mod[b * 9216 + msc * 1024 + cidx]); TC[i] = mod[b * 9216 + msh * 1024 + cidx]; } }
    __syncthreads();
    const int gw = F.vcu * NWAVES + F.wave, NGW = F.G * NWAVES;
    for (int row = gw; row < M; row += NGW) {
        const int b = row >> 13;
        const GAS f32x4* xr = (const GAS f32x4*)(xin + (size_t)row * D) + F.lane;
        f32x4 x[4];
#pragma unroll
        for (int j = 0; j < 4; ++j) x[j] = xr[64 * j];
        if (HAS_Y) {
            const GAS f32x4* yr = (const GAS f32x4*)(yin + (size_t)row * D) + F.lane;
            f32x4 y[4]; float s = 0.f;
#pragma unroll
            for (int j = 0; j < 4; ++j) { y[j] = yr[64 * j]; s += (y[j].x * y[j].x + y[j].y * y[j].y) + (y[j].z * y[j].z + y[j].w * y[j].w); }
            const float rstd = 1.0f / sqrtf(wave_sum(s) * (1.0f / D) + EPS);
            GAS f32x4* xo = (GAS f32x4*)(xout + (size_t)row * D) + F.lane;
#pragma unroll
            for (int j = 0; j < 4; ++j) { const f32x4 ta = *(const LAS f32x4*)(TA + b * 1024 + 4 * F.lane + 256 * j); x[j] = x[j] + ta * (y[j] * rstd); xo[64 * j] = x[j]; }
        }
        if (HAS_H) {
            float s = 0.f;
#pragma unroll
            for (int j = 0; j < 4; ++j) s += (x[j].x * x[j].x + x[j].y * x[j].y) + (x[j].z * x[j].z + x[j].w * x[j].w);
            const float rstd = 1.0f / sqrtf(wave_sum(s) * (1.0f / D) + EPS);
            GAS v2u* ho = (GAS v2u*)(hout + (size_t)row * D) + F.lane;
#pragma unroll
            for (int j = 0; j < 4; ++j) { const f32x4 tb = *(const LAS f32x4*)(TB + b * 1024 + 4 * F.lane + 256 * j), tc = *(const LAS f32x4*)(TC + b * 1024 + 4 * F.lane + 256 * j);
                const f32x4 h = (x[j] * rstd) * tb + tc; v2u o; o.x = cvt_pk_h16(h.x, h.y); o.y = cvt_pk_h16(h.z, h.w); ho[64 * j] = o; }
        }
    }
    __syncthreads();
}

__device__ __forceinline__ float gelu_tanh(float x) { const float u = 0.7978845608028654f * (x + 0.044715f * x * x * x); const float e = __builtin_amdgcn_exp2f(2.0f * 1.4426950408889634f * u); const float t = 1.0f - 2.0f * __builtin_amdgcn_rcpf(e + 1.0f); return 0.5f * x * (1.0f + t); }
__device__ __forceinline__ float fast_sigmoid(float z) { return __builtin_amdgcn_rcpf(1.0f + __builtin_amdgcn_exp2f(-1.4426950408889634f * z)); }
__device__ __forceinline__ float lane_partner(float x, int hh) { auto rr = __builtin_amdgcn_permlane32_swap(__float_as_uint(x), __float_as_uint(x), false, false); return __uint_as_float(hh ? rr[0] : rr[1]); }
typedef float f32x16 __attribute__((ext_vector_type(16)));
__device__ __forceinline__ int crow(int r, int hi) { return (r & 3) + 8 * (r >> 2) + 4 * hi; }
constexpr int LL_XC = 0, LL_OUT = 32768, LL_CAR = 131072 + 1024;
template <bool PASS_B>
__device__ __forceinline__ void lru_phase(Frame& F, const Args& A) {
    unsigned char* ws = A.ws;
    const h16* LRU = (const h16*)(ws + WS_LRU); float* SA = (float*)(ws + WS_LRUS); float* SB = SA + BATCH * NLCH * DLRU;
    h16* MERGED = (h16*)(ws + WS_MERGED);
    int tid_o = F.tid; asm volatile("" : "+v"(tid_o));
    const int tid = tid_o, lane = tid & 63, g = F.wave, r = lane & 31, hh = lane >> 5;
    LAS unsigned char* XC = F.lds + LL_XC; LAS float* OUT = (LAS float*)(F.lds + LL_OUT); LAS float* CAR = (LAS float*)(F.lds + LL_CAR);
    const h16x8* LW = (const h16x8*)(ws + WS_LRUW);
    float ba[2], bi[2], sp8[2];
#pragma unroll
    for (int jt = 0; jt < 2; ++jt) { const int ch = g * 64 + 32 * jt + r; ba[jt] = A.in[16][ch]; bi[jt] = A.in[18][ch]; const float lam = A.in[19][ch]; sp8[jt] = 8.0f * ((lam < -15.f) ? -lam : log1pf(__expf(-lam))); }
    for (int p = blockIdx.x; p < 256; p += F.G) {
#pragma unroll 1
        for (int uu = 0; uu < 2; ++uu) {
            const int b = p >> 7, c = uu ? 255 - (p & 127) : (p & 127), t0 = c * LCH;
            const h16* xb = LRU + (size_t)(b * SEQ) * 1024;
            __syncthreads();
            if (PASS_B) { float H = 0.f; const float* pa = SA + (size_t)(b * NLCH) * DLRU + tid; const float* pb = SB + (size_t)(b * NLCH) * DLRU + tid;
#pragma unroll 1
                for (int cc0 = 0; cc0 < c; cc0 += 16) {
                    float fa[16], fb[16];
#pragma unroll
                    for (int k = 0; k < 16; ++k) { const int ci = (cc0 + k < c) ? cc0 + k : c - 1; fa[k] = pa[(size_t)ci * DLRU]; fb[k] = pb[(size_t)ci * DLRU]; }
#pragma unroll
                    for (int k = 0; k < 16; ++k) { const bool ok = cc0 + k < c; H = (ok ? fa[k] : 1.0f) * H + (ok ? fb[k] : 0.0f); } }
                CAR[tid] = H; }
            asm volatile("" ::: "memory");
            { h16x8 xr[7]; f32x4 cwv[4][2], cbv[2];
              cbv[0] = *(const f32x4*)(A.in[14] + 8 * lane); cbv[1] = *(const f32x4*)(A.in[14] + 8 * lane + 4);
#pragma unroll
              for (int jx = 0; jx < 4; ++jx) { cwv[jx][0] = *(const f32x4*)(A.in[13] + jx * DLRU + 8 * lane); cwv[jx][1] = *(const f32x4*)(A.in[13] + jx * DLRU + 8 * lane + 4); }
#pragma unroll
              for (int k = 0; k < 7; ++k) { const int t = t0 + 4 * g - 3 + k; if (t >= 0) xr[k] = *(const h16x8*)(xb + (size_t)t * 1024 + 8 * lane); else xr[k] = (h16x8){0, 0, 0, 0, 0, 0, 0, 0}; }
#pragma unroll
              for (int tt = 0; tt < 4; ++tt) { float v[8];
#pragma unroll
                  for (int e = 0; e < 8; ++e) v[e] = cbv[e >> 2][e & 3] + (float)xr[tt][e] * cwv[0][e >> 2][e & 3] + (float)xr[tt + 1][e] * cwv[1][e >> 2][e & 3] + (float)xr[tt + 2][e] * cwv[2][e >> 2][e & 3] + (float)xr[tt + 3][e] * cwv[3][e >> 2][e & 3];
                  v4u o; o.x = cvt_pk_h16(v[0], v[1]); o.y = cvt_pk_h16(v[2], v[3]); o.z = cvt_pk_h16(v[4], v[5]); o.w = cvt_pk_h16(v[6], v[7]);
                  const int row = 4 * g + tt; *(LAS v4u*)(XC + row * 1024 + ((lane ^ (row & 7)) << 4)) = o; } }
            __syncthreads();
            h16x8 af[4];
#pragma unroll
            for (int s = 0; s < 4; ++s) af[s] = *(const LAS h16x8*)(XC + r * 1024 + (((g * 8 + 2 * s + hh) ^ (r & 7)) << 4));
#pragma unroll 1
            for (int jt = 0; jt < 2; ++jt) {
                float gt[16];
                if (PASS_B) {
#pragma unroll
                    for (int i = 0; i < 16; ++i) gt[i] = (float)xb[(size_t)(t0 + crow(i, hh)) * 1024 + 512 + g * 64 + 32 * jt + r]; }
                float av[16], bv[16];
                const int ch = g * 64 + 32 * jt + r;
                {   h16x8 wf[4];
#pragma unroll
                    for (int s = 0; s < 4; ++s) wf[s] = LW[(((0 * 8 + g) * 2 + jt) * 4 + s) * 64 + lane];
                    f32x16 za = {};
#pragma unroll
                    for (int s = 0; s < 4; ++s) za = __builtin_amdgcn_mfma_f32_32x32x16_f16(af[s], wf[s], za, 0, 0, 0);
#pragma unroll
                    for (int i = 0; i < 16; ++i) { const float rg = fast_sigmoid(za[i] + (jt ? ba[1] : ba[0])); const float la = -(jt ? sp8[1] : sp8[0]) * rg, y = 2.0f * la;
                        const float em = (y > -0.03f) ? -y * (1.0f + y * (0.5f + y * (0.16666667f + y * 0.041666668f))) : 1.0f - __expf(y);
                        av[i] = __expf(la); bv[i] = __builtin_amdgcn_sqrtf(em); } }
                {   h16x8 wf[4];
#pragma unroll
                    for (int s = 0; s < 4; ++s) wf[s] = LW[(((1 * 8 + g) * 2 + jt) * 4 + s) * 64 + lane];
                    f32x16 zi = {};
#pragma unroll
                    for (int s = 0; s < 4; ++s) zi = __builtin_amdgcn_mfma_f32_32x32x16_f16(af[s], wf[s], zi, 0, 0, 0);
#pragma unroll
                    for (int i = 0; i < 16; ++i) { const int t = crow(i, hh); const float ig = fast_sigmoid(zi[i] + (jt ? bi[1] : bi[0]));
                        const float xcv = (float)*(const LAS h16*)(XC + t * 1024 + ((((ch >> 3)) ^ (t & 7)) << 4) + (ch & 7) * 2);
                        bv[i] *= ig * xcv; } }
                float GA[4], GB[4];
#pragma unroll
                for (int k = 0; k < 4; ++k) { float Ak = av[4 * k], Bk = bv[4 * k];
#pragma unroll
                    for (int e = 1; e < 4; ++e) { Bk = av[4 * k + e] * Bk + bv[4 * k + e]; Ak *= av[4 * k + e]; }
                    GA[k] = Ak; GB[k] = Bk; }
                float state = PASS_B ? CAR[ch] : 0.f; float cin[4];
#pragma unroll
                for (int k = 0; k < 4; ++k) { const float out0 = GA[k] * state + GB[k]; const float p0 = lane_partner(out0, hh); const float in1 = hh ? p0 : state; cin[k] = in1;
                    const float out1 = GA[k] * in1 + GB[k]; const float p1 = lane_partner(out1, hh); state = hh ? out1 : p1; }
                if (!PASS_B) { float P = (GA[0] * GA[1]) * (GA[2] * GA[3]); P *= lane_partner(P, hh);
                    if (hh == 0) { SA[(size_t)(b * NLCH + c) * DLRU + ch] = P; SB[(size_t)(b * NLCH + c) * DLRU + ch] = state; } }
                else {
#pragma unroll
                    for (int k = 0; k < 4; ++k) { float h = cin[k];
#pragma unroll
                        for (int e = 0; e < 4; ++e) { const int i = 4 * k + e; h = av[i] * h + bv[i]; OUT[crow(i, hh) * 512 + ch] = h * gelu_tanh(gt[i]); } } }
            }
            if (PASS_B) {
                __syncthreads();
#pragma unroll
                for (int k = 0; k < 4; ++k) { const int tt = 4 * g + k;
                    const f32x4 o0 = *(const LAS f32x4*)(OUT + tt * 512 + 8 * lane), o1 = *(const LAS f32x4*)(OUT + tt * 512 + 8 * lane + 4);
                    const float s = (o0.x * o0.x + o0.y * o0.y) + (o0.z * o0.z + o0.w * o0.w) + (o1.x * o1.x + o1.y * o1.y) + (o1.z * o1.z + o1.w * o1.w);
                    const float rstd = 1.0f / sqrtf(wave_sum(s) * (1.0f / DLRU) + EPS);
                    const f32x4 g0 = *(const f32x4*)(A.in[21] + 8 * lane), g1 = *(const f32x4*)(A.in[21] + 8 * lane + 4);
                    v4u o; o.x = cvt_pk_h16(o0.x * rstd * g0.x, o0.y * rstd * g0.y); o.y = cvt_pk_h16(o0.z * rstd * g0.z, o0.w * rstd * g0.w);
                    o.z = cvt_pk_h16(o1.x * rstd * g1.x, o1.y * rstd * g1.y); o.w = cvt_pk_h16(o1.z * rstd * g1.z, o1.w * rstd * g1.w);
                    *(GAS v4u*)(MERGED + (size_t)(b * SEQ + t0 + tt) * 1024 + 512 + 8 * lane) = o; }
            }
        }
    }
}

constexpr int IDX_CAP = 128;
constexpr int IL_QL = 0, IL_WL = 36864, IL_INFO = 37888, IL_CNT = 38400, IL_PS = 38912, IL_MAXCC = 40960, IL_HIST = 65536  , IL_CAND = 98304  , IL_SCR = 65536  ;
constexpr int SL_SCORE = 65536, SL_HIST = 98304, SL_CTL = 99328;
constexpr size_t IDX_SLOT_BYTES = 129 * 2048;
__device__ __forceinline__ unsigned ord_key(float f) { const unsigned u = __float_as_uint(f); return u ^ ((u >> 31) ? 0xFFFFFFFFu : 0x80000000u); }
__device__ __forceinline__ int t5_bucket(int rel) {
    const int n = rel < 0 ? -rel : rel; int large;
    if (n < 12) large = 8; else if (n < 16) large = 9; else if (n < 23) large = 10; else if (n < 32) large = 11; else if (n < 46) large = 12; else if (n < 64) large = 13; else if (n < 91) large = 14; else large = 15;
    return (rel > 0 ? 16 : 0) + (n < 8 ? n : large);
}
#define IDX_FMA_ABS(s_, x_, w_) asm("v_fma_f32 %0, |%1|, %2, %0" : "+v"(s_) : "v"(x_), "v"(w_))
template <int NS>
__device__ __forceinline__ void idx_scores(f32x16 (&S)[NS], const h16x8 (&a)[NS][4], const LAS unsigned char* ql, int foff, int sw, int hh, const LAS float* wl) {
    {   h16x8 qf[4];
#pragma unroll
        for (int s = 0; s < 4; ++s) qf[s] = *(const LAS h16x8*)(ql + 8 * 4096 + foff + (((2 * s + hh) ^ sw) << 4));
#pragma unroll
        for (int sub = 0; sub < NS; ++sub) { f32x16 acc = {};
#pragma unroll
            for (int s = 0; s < 4; ++s) acc = __builtin_amdgcn_mfma_f32_32x32x16_f16(a[sub][s], qf[s], acc, 0, 0, 0);
            S[sub] = acc; } }
#pragma unroll 1
    for (int h = 0; h < 8; ++h) {
        h16x8 qf[4]; const float wh = wl[h];
#pragma unroll
        for (int s = 0; s < 4; ++s) qf[s] = *(const LAS h16x8*)(ql + h * 4096 + foff + (((2 * s + hh) ^ sw) << 4));
        f32x16 acc[NS];
#pragma unroll
        for (int sub = 0; sub < NS; ++sub) { acc[sub] = f32x16{};
#pragma unroll
            for (int s = 0; s < 4; ++s) acc[sub] = __builtin_amdgcn_mfma_f32_32x32x16_f16(a[sub][s], qf[s], acc[sub], 0, 0, 0); }
#pragma unroll
        for (int sub = 0; sub < NS; ++sub) {
            asm volatile("s_nop 15" : "+v"(acc[sub]), "+v"(S[sub]));
#pragma unroll
            for (int i = 0; i < 16; ++i) IDX_FMA_ABS(S[sub][i], acc[sub][i], wh); }
    }
#pragma unroll
    for (int sub = 0; sub < NS; ++sub) asm volatile("s_nop 1" : "+v"(S[sub]));
}
__device__ __forceinline__ float inv_norm_cdf(float p) { const float x = 2.0f * p - 1.0f, ln = logf(fmaxf(1.0f - x * x, 1e-30f)), a = 0.147f, t = 2.0f / (3.14159265f * a) + 0.5f * ln;
    const float e = sqrtf(fmaxf(sqrtf(t * t - ln / a) - t, 0.f)); return 1.41421356f * (x < 0.f ? -e : e); }
__device__ __forceinline__ unsigned char* idx_slot(unsigned char* ws, int p) { return (p < 127) ? ws + WS_H + (size_t)p * IDX_SLOT_BYTES : (p < 254) ? ws + 198 * MiB + (size_t)(p - 127) * IDX_SLOT_BYTES : ws + WS_W1GU + (size_t)(p - 254) * IDX_SLOT_BYTES; }
__device__ __forceinline__ void idx_phase(Frame& F, const Args& A) {
    unsigned char* ws = A.ws;
    const h16* QS = (const h16*)(ws + WS_QS); const h16* KI = (const h16*)(ws + WS_KI); const float* WI = (const float*)(ws + WS_WI);
    unsigned* MASK = (unsigned*)(ws + WS_MASK);
    LAS unsigned char* L = F.lds;
    int tid_o = F.tid; asm volatile("" : "+v"(tid_o));
    const int tid = tid_o, lane = tid & 63, wave = F.wave, r = lane & 31, hh = lane >> 5;
    LAS float* WL = (LAS float*)(L + IL_WL); LAS int* INFO = (LAS int*)(L + IL_INFO); LAS unsigned* CNT = (LAS unsigned*)(L + IL_CNT);
    LAS unsigned* HIST = (LAS unsigned*)(L + IL_HIST); LAS unsigned* MAXCC = (LAS unsigned*)(L + IL_MAXCC);
    for (int p = blockIdx.x; p < 256; p += F.G) {
        const int b = p >> 7, jj = p & 127;
        unsigned char* slot = idx_slot(ws, p);
#pragma unroll 1
        for (int uu = 0; uu < 2; ++uu) {
            const int j = uu ? 255 - jj : jj;
            const int q0 = 32 * j, rowb = b * SEQ + q0, N = ((j >> 1) + 1) * 64, NC = N >> 6;
            unsigned* mrow = MASK + ((size_t)(b * 128) * 8192 + q0) * 2;
            v4u* codes = (v4u*)(slot + (uu ? (size_t)((jj >> 1) + 1) * 2048 : 0));
            if (N <= TOPK) {
                for (int i = tid; i < NC * 64; i += NTHR) mrow[(size_t)(i >> 6) * 16384 + (i & 63)] = 0xFFFFFFFFu;
                continue;
            }
            __syncthreads();
#pragma unroll
            for (int i = 0; i < 4; ++i) { const int idx = tid + NTHR * i, q = idx >> 6, cc = idx & 63, head = cc >> 3, c8 = cc & 7;
                const v4u v = *(const GAS v4u*)(QS + (size_t)(rowb + q) * 512 + cc * 8);
                *(LAS v4u*)(L + IL_QL + head * 4096 + q * 128 + ((c8 ^ (q & 7)) << 4)) = v; }
            if (tid < 256) WL[tid] = WI[(size_t)rowb * 8 + tid];
            for (int i = tid; i < 8192; i += NTHR) HIST[i] = 0u;
            if (tid < 32) CNT[tid] = 0u;
            if (tid == 0) MAXCC[0] = 0u;
            __syncthreads();
            { const int q = tid >> 4, dg = tid & 15, c8 = dg >> 1; float a0 = 0.f, a1 = 0.f, a2 = 0.f, a3 = 0.f;
              const int o = q * 128 + ((c8 ^ (q & 7)) << 4) + (dg & 1) * 8;
#pragma unroll
              for (int h = 0; h < 8; ++h) { const h16x4 v = *(const LAS h16x4*)(L + IL_QL + h * 4096 + o); const float wv = WL[q * 8 + h];
                  a0 += wv * (float)v[0]; a1 += wv * (float)v[1]; a2 += wv * (float)v[2]; a3 += wv * (float)v[3]; }
              v2u pk; pk.x = cvt_pk_h16(a0, a1); pk.y = cvt_pk_h16(a2, a3); *(LAS v2u*)(L + IL_QL + 8 * 4096 + o) = pk; }
            __syncthreads();
            const LAS float* w = WL + r * 8;
            const int foff = r * 128, sw = r & 7;
            const h16* kbat = KI + (size_t)(b * SEQ) * 64;
            const h16* kbase = kbat + (size_t)r * 64 + 8 * hh;
            const LAS unsigned char* ql = L + IL_QL;
#define IDX_LOADA(dst, c) do { _Pragma("unroll") for (int sub_ = 0; sub_ < 2; ++sub_) _Pragma("unroll") for (int s_ = 0; s_ < 4; ++s_) \
                dst[sub_][s_] = *(const h16x8*)(kbase + (size_t)(64 * (c) + 32 * sub_) * 64 + 16 * s_); } while (0)
            h16x8 a[2][4]; f32x16 S[2];
            IDX_LOADA(a, 0); idx_scores<2>(S, a, ql, foff, sw, hh, w);
            float s1 = 0.f, s2 = 0.f;
#pragma unroll
            for (int sub = 0; sub < 2; ++sub)
#pragma unroll
                for (int i = 0; i < 16; ++i) { s1 += S[sub][i]; s2 += S[sub][i] * S[sub][i]; }
            s1 += __shfl_xor(s1, 32); s2 += __shfl_xor(s2, 32);
            const float mean = s1 * (1.0f / 64.0f), sd = sqrtf(fmaxf(s2 * (1.0f / 64.0f) - mean * mean, 1e-30f));
            const float zN = inv_norm_cdf(1.0f - (float)TOPK / (float)N);
            const float inv_w = 64.0f / sd, off = -(mean + (zN - 1.0f) * sd) * inv_w;
            { int c = wave; if (c < NC) IDX_LOADA(a, c);
              for (; c < NC; c += 8) {
                idx_scores<2>(S, a, ql, foff, sw, hh, w);
                if (c + 8 < NC) IDX_LOADA(a, c + 8);
                unsigned cw[8];
#pragma unroll
                for (int k = 0; k < 8; ++k) cw[k] = 0u;
#pragma unroll
                for (int sub = 0; sub < 2; ++sub)
#pragma unroll
                    for (int i = 0; i < 16; ++i) { const int e = 16 * sub + i; unsigned u; { const float bf = __builtin_fmaf(S[sub][i], inv_w, off); asm("v_cvt_u32_f32 %0, %1" : "=v"(u) : "v"(bf)); }
                        u = u < 255u ? u : 255u;
                        if (u) __hip_atomic_fetch_add(HIST + u * 32 + r, 1u, __ATOMIC_RELAXED, __HIP_MEMORY_SCOPE_WORKGROUP);
                        cw[e >> 2] |= u << (8 * (e & 3)); }
                codes[(size_t)(c * 64 + lane) * 2] = (v4u){cw[0], cw[1], cw[2], cw[3]}; codes[(size_t)(c * 64 + lane) * 2 + 1] = (v4u){cw[4], cw[5], cw[6], cw[7]};
              } }
            VM_WAIT(); __syncthreads();
            { LAS unsigned* PS = (LAS unsigned*)(L + IL_PS); const int rg = wave * 2 + hh; unsigned sum = 0u;
#pragma unroll
              for (int k = 0; k < 16; ++k) sum += HIST[(rg * 16 + k) * 32 + r];
              PS[rg * 32 + r] = sum;
              __syncthreads();
              if (wave == 0 && hh == 0) { const int q = r; unsigned cum = 0u; int rsel = 0; unsigned ps[16];
#pragma unroll
                  for (int k = 0; k < 16; ++k) ps[k] = PS[k * 32 + q];
                  bool found = false; unsigned above = 0u;
#pragma unroll
                  for (int k = 15; k >= 0; --k) { if (!found) { if (cum + ps[k] >= (unsigned)TOPK) { found = true; rsel = k; above = cum; } else cum += ps[k]; } }
                  int bsel = -1; unsigned cb = 0u, ca = 0u; cum = above;
                  for (int k = 15; k >= 0; --k) { const unsigned cn = HIST[(rsel * 16 + k) * 32 + q]; if (bsel < 0) { if (cum + cn >= (unsigned)TOPK) { bsel = rsel * 16 + k; cb = cn; ca = cum; } else cum += cn; } }
                  int slow = (!found || bsel <= 0 || bsel >= 255 || cb > (unsigned)IDX_CAP) ? 1 : 0;
#ifdef IDX_FORCE_SLOW
                  if (((rowb + q) % 251) == 0) slow = 1;
#endif
                  INFO[q * 4 + 0] = bsel; INFO[q * 4 + 1] = TOPK - (int)ca; INFO[q * 4 + 2] = slow; }
            }
            __syncthreads();
            const unsigned cstar = (unsigned)INFO[r * 4 + 0];
            LAS unsigned* cand = (LAS unsigned*)(L + IL_CAND);
            { int c = wave; v4u w0, w1; if (c < NC) { w0 = codes[(size_t)(c * 64 + lane) * 2]; w1 = codes[(size_t)(c * 64 + lane) * 2 + 1]; }
            for (; c < NC; c += 8) {
                const unsigned cw[8] = {w0.x, w0.y, w0.z, w0.w, w1.x, w1.y, w1.z, w1.w};
                if (c + 8 < NC) { w0 = codes[(size_t)((c + 8) * 64 + lane) * 2]; w1 = codes[(size_t)((c + 8) * 64 + lane) * 2 + 1]; }
                unsigned selw = 0u, cndw = 0u;
#pragma unroll
                for (int e = 0; e < 32; ++e) { const unsigned u = (cw[e >> 2] >> (8 * (e & 3))) & 0xFFu; selw = selw * 2u + (u > cstar ? 1u : 0u); cndw = cndw * 2u + (u == cstar ? 1u : 0u); }
                selw = (selw >> 16) | (selw << 16); cndw = (cndw >> 16) | (cndw << 16);
                mrow[(size_t)c * 16384 + (r * 2 + hh)] = selw;
                unsigned bits = cndw;
                while (bits) { const int bp = 31 - __clz((int)bits); bits &= ~(1u << bp); const int sub = bp >> 4, i = 15 - (bp & 15);
                    const unsigned key = (unsigned)(64 * c + 32 * sub + crow(i, hh));
                    const unsigned pos = __hip_atomic_fetch_add(CNT + r, 1u, __ATOMIC_RELAXED, __HIP_MEMORY_SCOPE_WORKGROUP);
                    if (pos < (unsigned)IDX_CAP) cand[(r * IDX_CAP + pos) * 2 + 1] = key; }
            } }
            VM_WAIT(); __syncthreads();
            if (tid < 32) { const unsigned cc = CNT[tid]; if (cc > (unsigned)IDX_CAP) INFO[tid * 4 + 2] = 1; else if (!INFO[tid * 4 + 2]) __hip_atomic_fetch_max(MAXCC, cc, __ATOMIC_RELAXED, __HIP_MEMORY_SCOPE_WORKGROUP); }
            __syncthreads();
            { const int maxcc = (int)MAXCC[0]; LAS float* scr = (LAS float*)(L + IL_SCR + wave * 4096);
              const unsigned myc = CNT[r] <= (unsigned)IDX_CAP ? CNT[r] : 0u;
              for (int i = wave; i < maxcc; i += 8) {
                  const unsigned key = ((unsigned)i < myc) ? cand[(r * IDX_CAP + i) * 2 + 1] : 0u;
                  h16x8 a1[1][4]; f32x16 S1[1];
#pragma unroll
                  for (int s = 0; s < 4; ++s) a1[0][s] = *(const h16x8*)(kbat + (size_t)key * 64 + 16 * s + 8 * hh);
                  idx_scores<1>(S1, a1, ql, foff, sw, hh, w);
#pragma unroll
                  for (int k = 0; k < 16; ++k) scr[k * 64 + lane] = S1[0][k];
                  LDS_WAIT();
                  const float val = scr[((r & 3) + 4 * (r >> 3)) * 64 + r + 32 * ((r >> 2) & 1)];
                  if (hh == 0 && (unsigned)i < myc) cand[(r * IDX_CAP + i) * 2] = __float_as_uint(val);
                  LDS_WAIT();
              } }
            __syncthreads();
#pragma unroll 1
            for (int k = 0; k < 4; ++k) { const int q = 4 * wave + k; const unsigned cc = CNT[q]; const int need = INFO[q * 4 + 1];
                if (INFO[q * 4 + 2]) continue;
                for (unsigned i = lane; i < cc; i += 64) { const float si = __uint_as_float(cand[(q * IDX_CAP + i) * 2]); const unsigned ki = cand[(q * IDX_CAP + i) * 2 + 1]; int rank = 0;
                    for (unsigned jx = 0; jx < cc; ++jx) { const float sj = __uint_as_float(cand[(q * IDX_CAP + jx) * 2]); const unsigned kj = cand[(q * IDX_CAP + jx) * 2 + 1]; rank += (sj > si || (sj == si && kj < ki)) ? 1 : 0; }
                    if (rank < need) { const unsigned c = ki >> 6, sub = (ki >> 5) & 1u, row = ki & 31u, hk = (row >> 2) & 1u, rr = (row & 3u) + 4u * (row >> 3);
                        __hip_atomic_fetch_or(mrow + (size_t)c * 16384 + (q * 2 + hk), 1u << (16u * sub + 15u - rr), __ATOMIC_RELAXED, __HIP_MEMORY_SCOPE_AGENT); } }
            }
            __syncthreads();
#pragma unroll 1
            for (int q = 0; q < 32; ++q) {
                if (!INFO[q * 4 + 2]) continue;
                LAS float* s_score = (LAS float*)(L + SL_SCORE); LAS unsigned* s_hist = (LAS unsigned*)(L + SL_HIST); LAS unsigned* s_ctl = (LAS unsigned*)(L + SL_CTL);
                __syncthreads();
                for (int s = tid; s < N; s += NTHR) {
                    const h16* kr = KI + (size_t)(b * SEQ + s) * 64; float kv[64];
#pragma unroll
                    for (int i = 0; i < 8; ++i) { const h16x8 t8 = *(const h16x8*)(kr + 8 * i);
#pragma unroll
                        for (int e = 0; e < 8; ++e) kv[8 * i + e] = (float)t8[e]; }
                    float sc = 0.f;
#pragma unroll 1
                    for (int h = 0; h < 9; ++h) { float d = 0.f;
#pragma unroll
                        for (int c8 = 0; c8 < 8; ++c8) { const h16x8 qv = *(const LAS h16x8*)(L + IL_QL + h * 4096 + q * 128 + ((c8 ^ (q & 7)) << 4));
#pragma unroll
                            for (int e = 0; e < 8; ++e) d += (float)qv[e] * kv[8 * c8 + e]; }
                        sc += (h == 8) ? d : fabsf(d) * WL[q * 8 + h]; }
                    s_score[s] = sc;
                }
                __syncthreads();
                unsigned prefix = 0u, msk = 0u, remaining = TOPK, n_eq = 0u;
                for (int pass = 0; pass < 4; ++pass) {
                    const int shift = 24 - 8 * pass;
                    if (tid < 256) s_hist[tid] = 0u;
                    __syncthreads();
                    for (int s = tid; s < N; s += NTHR) { const unsigned key = ord_key(s_score[s]); if ((key & msk) == prefix) __hip_atomic_fetch_add(s_hist + ((key >> shift) & 255u), 1u, __ATOMIC_RELAXED, __HIP_MEMORY_SCOPE_WORKGROUP); }
                    __syncthreads();
                    if (wave == 0) {
                        const unsigned h0 = s_hist[4 * lane], h1 = s_hist[4 * lane + 1], h2 = s_hist[4 * lane + 2], h3 = s_hist[4 * lane + 3];
                        unsigned v = h0 + h1 + h2 + h3;
#pragma unroll
                        for (int o = 1; o < 64; o <<= 1) { const unsigned tv = __shfl_down(v, o); if (lane + o < 64) v += tv; }
                        unsigned above = __shfl_down(v, 1); if (lane == 63) above = 0u;
                        if (v >= remaining && above < remaining) {
                            unsigned cum = above; int dsel; unsigned rem; unsigned hv;
                            if (cum + h3 >= remaining) { dsel = 3; rem = remaining - cum; hv = h3; }
                            else { cum += h3; if (cum + h2 >= remaining) { dsel = 2; rem = remaining - cum; hv = h2; }
                            else { cum += h2; if (cum + h1 >= remaining) { dsel = 1; rem = remaining - cum; hv = h1; }
                            else { cum += h1; dsel = 0; rem = remaining - cum; hv = h0; } } }
                            s_ctl[0] = (unsigned)(4 * lane + dsel); s_ctl[1] = rem; s_ctl[4] = hv; }
                    }
                    __syncthreads();
                    prefix |= s_ctl[0] << shift; msk |= 255u << shift; remaining = s_ctl[1]; n_eq = s_ctl[4];
                    __syncthreads();
                }
                const unsigned tu = (prefix & 0x80000000u) ? (prefix ^ 0x80000000u) : ~prefix; const float thr = __uint_as_float(tu);
                unsigned idx_cut = 0xFFFFFFFFu;
                if (n_eq > remaining) {
                    if (tid == 0) { unsigned cnt = 0, cut = 0; for (int s = 0; s < N; ++s) if (s_score[s] == thr) { ++cnt; if (cnt == remaining) { cut = (unsigned)s; break; } } s_ctl[3] = cut; }
                    __syncthreads();
                    idx_cut = s_ctl[3];
                }
                int i0 = tid; asm volatile("" : "+v"(i0));
                for (int i = i0; i < NC * 2; i += NTHR) { const int c = i >> 1, hk = i & 1; unsigned word = 0u;
#pragma unroll
                    for (int sub = 0; sub < 2; ++sub)
#pragma unroll
                        for (int rr = 0; rr < 16; ++rr) { const int key = 64 * c + 32 * sub + crow(rr, hk); const float sc = s_score[key];
                            if (sc > thr || (sc == thr && (unsigned)key <= idx_cut)) word |= 1u << (16 * sub + 15 - rr); }
                    mrow[(size_t)c * 16384 + (q * 2 + hk)] = word; }
                __syncthreads();
            }
#undef IDX_LOADA
        }
    }
}

namespace at {
typedef short s16x4 __attribute__((ext_vector_type(4)));
constexpr int NSLOT = 3, SLOTB = 8192;
constexpr int LDS_K = 0, LDS_V = NSLOT * SLOTB, LDS_WS = 2 * NSLOT * SLOTB, LDS_TB = LDS_WS + 8 * 256, LDS_OST = 53248, LDS_BYTES = LDS_OST + 8 * 4096;
constexpr float LOG2E = 1.4426950408889634f;
__device__ __forceinline__ void glds16(const void* gsrc, unsigned lds_dst) { unsigned keep;
    asm volatile("s_mov_b32 %0, m0\n\ts_mov_b32 m0, %2\n\ts_nop 0\n\tglobal_load_lds_dwordx4 %1, off\n\ts_mov_b32 m0, %0" : "=&s"(keep) : "v"(gsrc), "s"(lds_dst) : "memory"); }
#define AT_WAIT_BAR(N) asm volatile("s_waitcnt vmcnt(" #N ") lgkmcnt(0)\n\ts_barrier" ::: "memory")
__device__ __forceinline__ h16x8 vtr8(const LAS unsigned char* p0, const LAS unsigned char* p1) {
    const s16x4 lo = __builtin_amdgcn_ds_read_tr16_b64_v4i16((LAS s16x4*)p0), hi = __builtin_amdgcn_ds_read_tr16_b64_v4i16((LAS s16x4*)p1);
    typedef short s16x8 __attribute__((ext_vector_type(8)));
    const s16x8 v = {lo[0], lo[1], lo[2], lo[3], hi[0], hi[1], hi[2], hi[3]}; return __builtin_bit_cast(h16x8, v); }
__device__ __forceinline__ h16x8 pack8(const f32x16& p, int b) {
    v4u w; w.x = cvt_pk_h16(p[b], p[b + 1]); w.y = cvt_pk_h16(p[b + 2], p[b + 3]); w.z = cvt_pk_h16(p[b + 4], p[b + 5]); w.w = cvt_pk_h16(p[b + 6], p[b + 7]); return __builtin_bit_cast(h16x8, w); }

__device__ __forceinline__ void attn_unit(int b, int h, int qb, const h16* Q, const h16* K, const h16* V, const unsigned* MASK, const float* relb, h16* O, LAS unsigned char* shm) {
    int tid_o = threadIdx.x; asm volatile("" : "+v"(tid_o));
    const int tid = tid_o, lane = tid & 63, r32 = lane & 31, hi = lane >> 5; const int wid = __builtin_amdgcn_readfirstlane(tid >> 6);
    const long rowbase = (long)b * SEQ; const int q0 = qb * 256, qw = q0 + wid * 32, cq = qw >> 6, NT = 4 * qb + 4;
    const h16* Qw = Q + (rowbase + qw) * 512 + h * 64;
    const h16* Kh = K + rowbase * 512 + h * 64; const h16* Vh = V + rowbase * 512 + h * 64;
    const unsigned lds0 = (unsigned)(uintptr_t)shm;
    LAS float* wsf = (LAS float*)(shm + LDS_WS) + wid * 64;
    LAS float* Tb = (LAS float*)(shm + LDS_TB);
    const h16* ksrc = Kh + (long)lane * 512 + wid * 8;
    const h16* vsrc = Vh + (long)(16 * (wid & 3) + (lane >> 2)) * 512 + (wid >> 2) * 32 + (lane & 3) * 8;
    const unsigned kdst = lds0 + LDS_K + wid * 1024, vdst = lds0 + LDS_V + wid * 1024;
#define AT_DMA_K(t, slot) glds16(ksrc + (long)(t) * 64 * 512, (unsigned)__builtin_amdgcn_readfirstlane(kdst + (slot)))
#define AT_DMA_V(t, slot) glds16(vsrc + (long)(t) * 64 * 512, (unsigned)__builtin_amdgcn_readfirstlane(vdst + (slot)))
    AT_DMA_K(0, 0); AT_DMA_V(0, 0); AT_DMA_K(1, SLOTB); AT_DMA_V(1, SLOTB);
    if (tid < 255) Tb[tid] = relb[t5_bucket(tid - 191) * 8 + h] * LOG2E;
    const float b15l = relb[15 * 8 + h] * LOG2E;
    h16x8 qr[4];
#pragma unroll
    for (int d0 = 0; d0 < 4; ++d0) qr[d0] = *(const h16x8*)(Qw + (long)r32 * 512 + d0 * 16 + hi * 8);
    const unsigned* mk = MASK + ((size_t)(b * 128) * 8192 + (qw + r32)) * 2 + hi;
    const LAS unsigned char* kp0 = shm + LDS_K + hi * 1024 + r32 * 16;
    const LAS unsigned char* vp0 = shm + LDS_V + ((lane >> 4) & 1) * 32 + (lane & 3) * 8 + (4 * hi + ((lane & 15) >> 2)) * 64;
    f32x16 o[2]; o[0] = f32x16{}; o[1] = f32x16{};
    float mref = 0.f, l = 0.f;
    int slot = 0, slot2 = 2 * SLOTB;
    unsigned mw_next = mk[0];
#pragma unroll 1
    for (int t = 0; t < NT; ++t) {
        const unsigned mw = mw_next; if (t + 1 < NT) mw_next = mk[(size_t)(t + 1) * 16384];
        if (t + 1 < NT) { AT_WAIT_BAR(2); } else { AT_WAIT_BAR(0); }
        if (t + 2 < NT) { AT_DMA_K(t + 2, slot2); AT_DMA_V(t + 2, slot2); }
        if (t <= cq) {
            const bool nearb = (t >= cq - 2);
            const float c0 = (nearb ? 0.f : b15l) - mref;
            f32x16 p0, p1;
#pragma unroll
            for (int r = 0; r < 16; ++r) { p0[r] = c0; p1[r] = c0; }
            const LAS unsigned char* kb = kp0 + slot;
#pragma unroll
            for (int d0 = 0; d0 < 4; ++d0) { const h16x8 k0 = *(const LAS h16x8*)(kb + d0 * 2048), k1 = *(const LAS h16x8*)(kb + d0 * 2048 + 512);
                p0 = __builtin_amdgcn_mfma_f32_32x32x16_f16(k0, qr[d0], p0, 0, 0, 0); p1 = __builtin_amdgcn_mfma_f32_32x32x16_f16(k1, qr[d0], p1, 0, 0, 0); }
            if (nearb) { const int ib = 64 * t - (qw + r32) + 191 + 4 * hi;
#pragma unroll
                for (int r = 0; r < 16; ++r) { const int kk = (r & 3) + 8 * (r >> 2); p0[r] += Tb[ib + kk]; p1[r] += Tb[ib + 32 + kk]; } }
            float mx = __builtin_fmaxf(__builtin_fmaxf(p0[0], p0[1]), p1[0]);
#pragma unroll
            for (int r = 1; r < 16; ++r) mx = __builtin_fmaxf(__builtin_fmaxf(mx, p0[r]), p1[r]);
            { auto rr = __builtin_amdgcn_permlane32_swap(__float_as_uint(mx), __float_as_uint(mx), false, false); mx = fmaxf(__uint_as_float(rr[0]), __uint_as_float(rr[1])); }
            if (t == 0 || __any(mx > 8.0f)) {
                const float d = (t == 0) ? mx : fmaxf(mx, 0.f); mref += d;
#pragma unroll
                for (int r = 0; r < 16; ++r) { p0[r] -= d; p1[r] -= d; }
                const float f = __builtin_amdgcn_exp2f(-d); l *= f;
                if (t != 0) { if (hi == 0) wsf[r32] = f; LDS_WAIT();
#pragma unroll
                    for (int r = 0; r < 16; ++r) { const float fr = wsf[crow(r, hi)]; o[0][r] *= fr; o[1][r] *= fr; } }
            }
#pragma unroll
            for (int r = 0; r < 16; ++r) {
                unsigned t0, t1;
                asm("v_bfe_i32 %0, %1, %2, 1" : "=v"(t0) : "v"(mw), "n"(15 - r)); asm("v_bfe_i32 %0, %1, %2, 1" : "=v"(t1) : "v"(mw), "n"(31 - r));
                p0[r] = __uint_as_float(__float_as_uint(__builtin_amdgcn_exp2f(p0[r])) & t0);
                p1[r] = __uint_as_float(__float_as_uint(__builtin_amdgcn_exp2f(p1[r])) & t1); }
            const h16x8 pa0 = pack8(p0, 0), pa1 = pack8(p0, 8), pa2 = pack8(p1, 0), pa3 = pack8(p1, 8);
            { typedef _Float16 h2 __attribute__((ext_vector_type(2))); const h2 one2 = {(h16)1.0f, (h16)1.0f}; float ps = 0.f;
#pragma unroll
              for (int k = 0; k < 4; ++k) { const h16x8 pk = (k == 0) ? pa0 : (k == 1) ? pa1 : (k == 2) ? pa2 : pa3;
#pragma unroll
                  for (int e = 0; e < 4; ++e) { const h2 pr = {pk[2 * e], pk[2 * e + 1]}; ps = __builtin_amdgcn_fdot2(pr, one2, ps, false); } }
              l += ps; }
            const LAS unsigned char* vb = vp0 + slot;
#pragma unroll
            for (int d0 = 0; d0 < 2; ++d0) {
                const h16x8 v0 = vtr8(vb + d0 * 4096, vb + d0 * 4096 + 512), v1 = vtr8(vb + d0 * 4096 + 1024, vb + d0 * 4096 + 1024 + 512);
                const h16x8 v2 = vtr8(vb + d0 * 4096 + 2048, vb + d0 * 4096 + 2048 + 512), v3 = vtr8(vb + d0 * 4096 + 3072, vb + d0 * 4096 + 3072 + 512);
                o[d0] = __builtin_amdgcn_mfma_f32_32x32x16_f16(pa0, v0, o[d0], 0, 0, 0); o[d0] = __builtin_amdgcn_mfma_f32_32x32x16_f16(pa1, v1, o[d0], 0, 0, 0);
                o[d0] = __builtin_amdgcn_mfma_f32_32x32x16_f16(pa2, v2, o[d0], 0, 0, 0); o[d0] = __builtin_amdgcn_mfma_f32_32x32x16_f16(pa3, v3, o[d0], 0, 0, 0); }
        }
        slot2 = slot; slot = (slot == (NSLOT - 1) * SLOTB) ? 0 : slot + SLOTB;
    }
    { auto rr = __builtin_amdgcn_permlane32_swap(__float_as_uint(l), __float_as_uint(l), false, false); l = __uint_as_float(rr[0]) + __uint_as_float(rr[1]); }
    if (hi == 0) wsf[32 + r32] = l;
    LDS_WAIT();
    h16* Ow = O + (rowbase + qw) * 512 + h * 64;
    { LAS h16* stg = (LAS h16*)(shm + LDS_OST) + wid * 2048;
#pragma unroll
      for (int r = 0; r < 16; ++r) { const int orow = crow(r, hi); const float rl = 1.0f / wsf[32 + orow];
#pragma unroll
          for (int d0 = 0; d0 < 2; ++d0) stg[orow * 64 + d0 * 32 + r32] = (h16)(o[d0][r] * rl); }
      LDS_WAIT();
#pragma unroll
      for (int i = 0; i < 4; ++i) { const int row = i * 8 + (lane >> 3), ch = lane & 7; const v4u v = *(const LAS v4u*)(stg + row * 64 + ch * 8); *(GAS v4u*)(Ow + (long)row * 512 + ch * 8) = v; } }
    asm volatile("s_waitcnt lgkmcnt(0)\n\ts_barrier" ::: "memory");
#undef AT_DMA_K
#undef AT_DMA_V
}
__device__ __forceinline__ void attn_phase(Frame& F, const Args& A) {
    unsigned char* ws = A.ws;
    for (int v = F.vcu; v < 256; v += F.G) {
        const int bh = v >> 4, s = v & 15;
#pragma unroll 1
        for (int i = 0; i < 2; ++i) attn_unit(bh >> 3, bh & 7, i ? 31 - s : s, (const h16*)(ws + WS_Q), (const h16*)(ws + WS_K), (const h16*)(ws + WS_V), (const unsigned*)(ws + WS_MASK), A.in[12], (h16*)(ws + WS_O), F.lds + RING_OFF);
    }
}
#undef AT_WAIT_BAR
}

__device__ __forceinline__ void attn_norm_phase(Frame& F, const Args& A) {
    unsigned char* ws = A.ws; const h16* O = (const h16*)(ws + WS_O); h16* MERGED = (h16*)(ws + WS_MERGED);
    const f32x4 g0 = *(const f32x4*)(A.in[20] + 8 * F.lane), g1 = *(const f32x4*)(A.in[20] + 8 * F.lane + 4);
    const int gw = F.vcu * NWAVES + F.wave, NGW = F.G * NWAVES;
    for (int row = gw; row < M; row += NGW) {
        const h16x8 v = *(const h16x8*)(O + (size_t)row * 512 + 8 * F.lane); float f[8]; float s = 0.f;
#pragma unroll
        for (int e = 0; e < 8; ++e) { f[e] = (float)v[e]; s += f[e] * f[e]; }
        const float rstd = 1.0f / sqrtf(wave_sum(s) * (1.0f / DATT) + EPS);
        v4u o; o.x = cvt_pk_h16(f[0] * rstd * g0.x, f[1] * rstd * g0.y); o.y = cvt_pk_h16(f[2] * rstd * g0.z, f[3] * rstd * g0.w);
        o.z = cvt_pk_h16(f[4] * rstd * g1.x, f[5] * rstd * g1.y); o.w = cvt_pk_h16(f[6] * rstd * g1.z, f[7] * rstd * g1.w);
        *(GAS v4u*)(MERGED + (size_t)row * 1024 + 8 * F.lane) = o;
    }
}

__global__ void __launch_bounds__(NTHR, 2) fwd_kernel(Args args) {
    extern __shared__ __attribute__((aligned(16))) unsigned char lds[];
    Frame F;
    F.lds = (LAS unsigned char*)lds;
    F.MISC = (volatile LAS unsigned*)(F.lds + MISC_OFF);
    F.tid = threadIdx.x; F.lane = F.tid & 63; F.wave = __builtin_amdgcn_readfirstlane(F.tid >> 6);
    F.G = gridDim.x; { const int bx = blockIdx.x; F.vcu = (F.G % 8 == 0) ? (bx % 8) * (F.G / 8) + bx / 8 : bx; }
    unsigned char* ws = args.ws;
    F.ctl = (gu32*)(ws + WS_CTL);
    for (int u = F.tid; u < (LDS_BYTES - LDSCTL_OFF) / 4; u += NTHR) ((LAS unsigned*)(F.lds + LDSCTL_OFF))[u] = 0u;
    __syncthreads();
    XcdBarrier bar; bar.bar = (unsigned*)(F.ctl + CW_BAR); bar.x = 0; bar.st = nullptr;
    if (N_LAUNCHES == 1) bar = xcd_barrier_post((unsigned*)(F.ctl + CW_BAR), F.MISC + 8);
    const int lo = args.ph_lo, hi = args.ph_hi;
#define IN(k) (lo <= (k) && (k) < hi)
#define SEAM(k) do { if (IN(k) && IN((k) + 1)) xcd_barrier(bar); } while (0)
    const float* mod = (const float*)(ws + WS_MOD);
    h16* H = (h16*)(ws + WS_H); h16* ACT = (h16*)(ws + WS_ACT); float* Y = (float*)(ws + WS_Y);
    const int bx = (int)blockIdx.x;

    if (IN(0)) { p0_prologue(F, args); } SEAM(0);
    if (IN(1)) { thin_phase<false, true>(F, mod, nullptr, nullptr, 0.f, 0, args.in[0], nullptr, args.in[4], 0, 1, H); } SEAM(1);
    if (IN(2)) { pg8::Gemm g{H, (const h16*)(ws + WS_W1GU), M, NGU, D}; pg8::StaticOrder S; S.init(M, NGU, F.G, bx);
        pg8::EpiSwiGLU E{ACT, FF}; pg8::gemm_phase<pg8::EpiSwiGLU, pg8::StaticOrder, true>(F.lds + RING_OFF, g, S, E); } SEAM(2);
    if (IN(3)) { pg8::Gemm g{ACT, (const h16*)(ws + WS_W1D), M, D, FF}; pg8::StaticOrder S; S.init(M, D, F.G, bx);
        pg8::EpiF32 E{Y, D}; pg8::gemm_phase<pg8::EpiF32, pg8::StaticOrder, false>(F.lds + RING_OFF, g, S, E); } SEAM(3);
    if (IN(4)) { thin_phase<true, true>(F, mod, Y, args.in[5], 0.5f, 2, args.in[0], args.out, args.in[9], 3, 4, H); } SEAM(4);
    if (IN(5)) { pg8::Gemm g{H, (const h16*)(ws + WS_WIN), M, NPROJ, D}; pg8::StaticOrder S; S.init(M, NPROJ, F.G, bx);
        pg8::EpiProj E{ws + WS_Q, (size_t)(WS_K - WS_Q), (h16*)(ws + WS_QS), (h16*)(ws + WS_KI), (float*)(ws + WS_WI), (h16*)(ws + WS_LRU)};
        pg8::gemm_phase<pg8::EpiProj, pg8::StaticOrder, true>(F.lds + RING_OFF, g, S, E); } SEAM(5);
    if (IN(6)) { lru_phase<false>(F, args); } if (IN(6) && IN(7)) __syncthreads();
    if (IN(7)) { idx_phase(F, args); } SEAM(7);
    if (IN(8)) { lru_phase<true>(F, args); } if (IN(8) && IN(9)) __syncthreads();
    if (IN(9)) { at::attn_phase(F, args); } SEAM(9);
    if (IN(10)) { attn_norm_phase(F, args); } SEAM(10);
    if (IN(11)) { pg8::Gemm g{(const h16*)(ws + WS_MERGED), (const h16*)(ws + WS_WOUT), M, D, D}; pg8::StaticOrder S; S.init(M, D, F.G, bx);
        pg8::EpiF32 E{Y, D}; pg8::gemm_phase<pg8::EpiF32, pg8::StaticOrder, false>(F.lds + RING_OFF, g, S, E); } SEAM(11);
    if (IN(12)) { thin_phase<true, true>(F, mod, Y, args.in[10], 1.0f, 5, args.out, args.out, args.in[23], 6, 7, H); } SEAM(12);
    if (IN(13)) { pg8::Gemm g{H, (const h16*)(ws + WS_W2GU), M, NGU, D}; pg8::StaticOrder S; S.init(M, NGU, F.G, bx);
        pg8::EpiSwiGLU E{ACT, FF}; pg8::gemm_phase<pg8::EpiSwiGLU, pg8::StaticOrder, true>(F.lds + RING_OFF, g, S, E); } SEAM(13);
    if (IN(14)) { pg8::Gemm g{ACT, (const h16*)(ws + WS_W2D), M, D, FF}; pg8::StaticOrder S; S.init(M, D, F.G, bx);
        pg8::EpiF32 E{Y, D}; pg8::gemm_phase<pg8::EpiF32, pg8::StaticOrder, false>(F.lds + RING_OFF, g, S, E); } SEAM(14);
    if (IN(15)) { thin_phase<true, false>(F, mod, Y, args.in[24], 0.5f, 8, args.out, args.out, nullptr, 0, 0, nullptr); }
#undef IN
#undef SEAM
}

extern "C" void kernel_launch(void* const* d_in, const int* in_sizes, int n_in, void* d_out, int out_size, void* d_ws, size_t ws_size, hipStream_t stream) {
    static int grid = 0;
    if (grid == 0) {
        if (n_in != 28 || in_sizes[0] != M * D || out_size != M * D || ws_size < WS_END) { fprintf(stderr, "kernel_launch: unexpected shapes (n_in %d, in0 %d, out %d, ws %zu); nothing launched\n", n_in, n_in > 0 ? in_sizes[0] : -1, out_size, ws_size); grid = -1; return; }
        int dev = 0, cus = 0, per_cu = 0;
        if (hipGetDevice(&dev) != hipSuccess || hipDeviceGetAttribute(&cus, hipDeviceAttributeMultiprocessorCount, dev) != hipSuccess) { grid = -1; return; }
        if (hipFuncSetAttribute((const void*)fwd_kernel, hipFuncAttributeMaxDynamicSharedMemorySize, LDS_BYTES) != hipSuccess) { fprintf(stderr, "kernel_launch: hipFuncSetAttribute failed\n"); grid = -1; return; }
        if (hipOccupancyMaxActiveBlocksPerMultiprocessor(&per_cu, (const void*)fwd_kernel, NTHR, LDS_BYTES) != hipSuccess || per_cu < 1) { fprintf(stderr, "kernel_launch: occupancy query reports %d\n", per_cu); }
        (void)hipGetLastError();
        grid = cus;
    }
    if (grid < 0) return;
    if (hipMemsetAsync((char*)d_ws + WS_CTL, 0, CTL_ZERO_BYTES, stream) != hipSuccess) return;
    Args a{};
    for (int i = 0; i < 28; ++i) a.in[i] = (const float*)d_in[i];
    a.out = (float*)d_out; a.ws = (unsigned char*)d_ws;
    if (N_LAUNCHES == 1) { a.ph_lo = 0; a.ph_hi = N_PHASES; a.li = 0; hipLaunchKernelGGL(fwd_kernel, dim3(grid), dim3(NTHR), LDS_BYTES, stream, a); }
    else { for (int p = 0; p < N_PHASES; ++p) { a.ph_lo = p; a.ph_hi = p + 1; a.li = p; const int reps = (p == PROBE_PHASE) ? 2 : 1;
        for (int rr = 0; rr < reps; ++rr) hipLaunchKernelGGL(fwd_kernel, dim3(grid), dim3(NTHR), LDS_BYTES, stream, a); } }
}
```

```cpp
#include <hip/hip_runtime.h>
#include <cstdio>
#include <cstdint>

#ifndef PROBE_PHASE
#define PROBE_PHASE -1
#endif
#ifndef PROBE_DIAG
#define PROBE_DIAG 0
#endif
#ifndef MK_N_LAUNCHES
#define MK_N_LAUNCHES 1
#endif

namespace pg8 {
#define PG8_LAS __attribute__((address_space(3)))
typedef _Float16 h16;
typedef _Float16 h16x8 __attribute__((ext_vector_type(8)));
typedef _Float16 h16x2 __attribute__((ext_vector_type(2)));
typedef float f32x4 __attribute__((ext_vector_type(4)));
typedef float f32x2 __attribute__((ext_vector_type(2)));
typedef unsigned u32x4 __attribute__((ext_vector_type(4)));
constexpr int BM = 256, BK = 64, HALF = 128, HTB = HALF * BK * 2, STAGE_BYTES = 8 * HTB, NXCD = 8, WGM = 8;

__host__ __device__ __forceinline__ int lds_byte(int r, int c) { const int st = (r >> 4) * 2 + (c >> 5), rr = r & 15, cc = c & 31, ob = rr * 64 + cc * 2; return st * 1024 + (ob ^ (((ob >> 9) & 1) << 5)); }
__host__ __device__ __forceinline__ void stage_rc(int b, int& R, int& C) { const int st = b / 1024, sb = b % 1024, swz = sb ^ (((sb >> 9) & 1) << 5); R = (st >> 1) * 16 + swz / 64; C = (st & 1) * 32 + (swz % 64) / 2; }
__host__ __device__ __forceinline__ int perm32(int rho) { const int n = rho >> 4, i = rho & 15; return 8 * (i >> 2) + 4 * n + (i & 3); }

struct Unit { int pm, pn; };
struct Gemm { const h16* A; const h16* Bt; int M, N, K; };

struct StaticOrder {
    int nM, nN, nwg, G, c;
    __host__ __device__ void init(int M, int N, int G_, int c_) { nM = M / BM; nN = N / BM; nwg = nM * nN; G = G_; c = c_; }
    __host__ __device__ bool next(int i, Unit& u) const {
        const long L = (long)i * G + c; if (L >= nwg) return false;
        int wgid = (int)L; { const int q = nwg / NXCD, r = nwg % NXCD, xcd = wgid % NXCD, off = wgid / NXCD; wgid = (xcd < r ? xcd * (q + 1) : r * (q + 1) + (xcd - r) * q) + off; }
        const int nig = WGM * nN, gid = wgid / nig, fm = gid * WGM, gsz = (nM - fm) < WGM ? (nM - fm) : WGM;
        u.pm = fm + ((wgid % nig) % gsz); u.pn = (wgid % nig) / gsz; return true;
    }
    __device__ __forceinline__ void a_ready(const Unit&) const {}
    __device__ __forceinline__ void done(const Unit&) const {}
};

__device__ __forceinline__ unsigned cvt_pk_h16(float lo, float hi) { f32x2 v = {lo, hi}; h16x2 h = __builtin_convertvector(v, h16x2); return __builtin_bit_cast(unsigned, h); }

struct EpiF32 {
    static constexpr bool PERM = false, AFTER_DRAIN = false;
    float* C; int ldc;
    __device__ __forceinline__ void operator()(const f32x4 (&acc)[2][2][4][2], const Unit& u, int wr, int wc, int fr, int fq) const {
        const int row0 = u.pm * BM + wr * 64 + fr, col0 = u.pn * BM + wc * 32 + 4 * fq;
#pragma unroll
        for (int ai = 0; ai < 2; ++ai)
#pragma unroll
            for (int m = 0; m < 4; ++m) { float* rowp = C + (size_t)(row0 + ai * HALF + m * 16) * ldc + col0;
#pragma unroll
                for (int bj = 0; bj < 2; ++bj)
#pragma unroll
                    for (int n = 0; n < 2; ++n) *(f32x4*)(rowp + bj * HALF + n * 16) = acc[ai][bj][m][n]; }
    }
};
struct EpiSwiGLU {
    static constexpr bool PERM = true, AFTER_DRAIN = false;
    h16* O; int ldc;
    __device__ __forceinline__ void operator()(const f32x4 (&acc)[2][2][4][2], const Unit& u, int wr, int wc, int fr, int fq) const {
        const int row0 = u.pm * BM + wr * 64 + fr, col0 = u.pn * HALF + wc * 32 + 8 * fq;
#pragma unroll
        for (int ai = 0; ai < 2; ++ai)
#pragma unroll
            for (int m = 0; m < 4; ++m) { h16* rowp = O + (size_t)(row0 + ai * HALF + m * 16) * ldc + col0;
                float v[8];
#pragma unroll
                for (int n = 0; n < 2; ++n)
#pragma unroll
                    for (int i = 0; i < 4; ++i) { const float g = acc[ai][0][m][n][i], up = acc[ai][1][m][n][i];
                        const float e = __builtin_amdgcn_exp2f(-1.4426950408889634f * g); v[4 * n + i] = g * __builtin_amdgcn_rcpf(1.0f + e) * up; }
                u32x4 w; w.x = cvt_pk_h16(v[0], v[1]); w.y = cvt_pk_h16(v[2], v[3]); w.z = cvt_pk_h16(v[4], v[5]); w.w = cvt_pk_h16(v[6], v[7]);
                *(u32x4*)rowp = w; }
    }
};
struct EpiProj {
    static constexpr bool PERM = true, AFTER_DRAIN = false;
    unsigned char* qkv; size_t qkv_stride; h16* QS; h16* KI; float* WI; h16* LRU;
    __device__ __forceinline__ void store_h16(const f32x4 (&acc)[2][2][4][2], h16* base, int ld, int row0, int c0, float sc) const {
#pragma unroll
        for (int ai = 0; ai < 2; ++ai)
#pragma unroll
            for (int m = 0; m < 4; ++m) { h16* rowp = base + (size_t)(row0 + ai * HALF + m * 16) * ld + c0;
#pragma unroll
                for (int bj = 0; bj < 2; ++bj) { const f32x4 v0 = acc[ai][bj][m][0] * sc, v1 = acc[ai][bj][m][1] * sc;
                    u32x4 w; w.x = cvt_pk_h16(v0[0], v0[1]); w.y = cvt_pk_h16(v0[2], v0[3]); w.z = cvt_pk_h16(v1[0], v1[1]); w.w = cvt_pk_h16(v1[2], v1[3]);
                    *(u32x4*)(rowp + bj * HALF) = w; } }
    }
    __device__ __forceinline__ void operator()(const f32x4 (&acc)[2][2][4][2], const Unit& u, int wr, int wc, int fr, int fq) const {
        const int row0 = u.pm * BM + wr * 64 + fr, cw = wc * 32 + 8 * fq; const int pn = u.pn;
        if (pn < 6) { store_h16(acc, (h16*)(qkv + (size_t)(pn >> 1) * qkv_stride), 512, row0, (pn & 1) * 256 + cw, pn < 2 ? 0.125f * 1.4426950408889634f : 1.0f); }
        else if (pn >= 9) { store_h16(acc, LRU, 1024, row0, (pn - 9) * 256 + cw, 1.0f); }
        else if (pn < 8) { store_h16(acc, QS, 512, row0, (pn - 6) * 256 + cw, 0.125f); }
        else {
#pragma unroll
            for (int ai = 0; ai < 2; ++ai)
#pragma unroll
                for (int m = 0; m < 4; ++m) { const size_t row = (size_t)(row0 + ai * HALF + m * 16); const f32x4 v0 = acc[ai][0][m][0], v1 = acc[ai][0][m][1];
                    if (cw < 64) { u32x4 w; w.x = cvt_pk_h16(v0[0], v0[1]); w.y = cvt_pk_h16(v0[2], v0[3]); w.z = cvt_pk_h16(v1[0], v1[1]); w.w = cvt_pk_h16(v1[2], v1[3]); *(u32x4*)(KI + row * 64 + cw) = w; }
                    else if (cw == 64) { const float sc = 0.5f * 0.35355339059327373f; *(f32x4*)(WI + row * 8) = v0 * sc; *(f32x4*)(WI + row * 8 + 4) = v1 * sc; } }
        }
    }
};

template <class Epi, class Sched, bool ALIGN_EPI = false>
__device__ __forceinline__ void gemm_phase(PG8_LAS unsigned char* lds, const Gemm g, const Sched& S, const Epi& E) {
    const int tid = threadIdx.x, wid = __builtin_amdgcn_readfirstlane(tid >> 6), lane = tid & 63, wr = wid >> 2, wc = wid & 3, fr = lane & 15, fq = lane >> 4;
    const int K = g.K, nt = K / BK;
    unsigned voffA[2], voffB[2];
#pragma unroll
    for (int i = 0; i < 2; ++i) { int R, C; stage_rc(tid * 16 + i * 8192, R, C); const int Rb = Epi::PERM ? ((R & ~31) + perm32(R & 31)) : R;
        voffA[i] = (unsigned)(R * K + C) * 2u; voffB[i] = (unsigned)(Rb * K + C) * 2u; }
    const size_t kstep = (size_t)(BK * 2);
    const size_t hstep = (size_t)HALF * K * 2;
    const size_t tstep = 2 * hstep;
    const unsigned ldsw = (unsigned)wid * 1024u;
    const int aoff = lds_byte(wr * 64 + fr, fq * 8), boff = lds_byte(wc * 32 + fr, fq * 8);
#define PG8_SA(b, h) (((b) * 2 + (h)) * HTB)
#define PG8_SB(b, h) ((4 + (b) * 2 + (h)) * HTB)
#define PG8_STAGE(bufoff, gbase, voff) do { _Pragma("unroll") for (int _i = 0; _i < 2; ++_i) \
        __builtin_amdgcn_global_load_lds((const unsigned*)((const char*)(gbase) + (voff)[_i]), (PG8_LAS unsigned*)(lds + (bufoff) + ldsw + _i * 8192), 16, 0, 0); } while (0)
#define PG8_LDA(dst, b, h) do { _Pragma("unroll") for (int m = 0; m < 4; ++m) _Pragma("unroll") for (int k = 0; k < 2; ++k) dst[m][k] = *(const PG8_LAS h16x8*)(lds + PG8_SA(b, h) + aoff + m * 2048 + k * 1024); } while (0)
#define PG8_LDB(dst, b, h) do { _Pragma("unroll") for (int n = 0; n < 2; ++n) _Pragma("unroll") for (int k = 0; k < 2; ++k) dst[n][k] = *(const PG8_LAS h16x8*)(lds + PG8_SB(b, h) + boff + n * 2048 + k * 1024); } while (0)
#define PG8_MMA(ai, bj, At, Bt) do { __builtin_amdgcn_s_setprio(1); _Pragma("unroll") for (int m = 0; m < 4; ++m) _Pragma("unroll") for (int n = 0; n < 2; ++n) _Pragma("unroll") for (int k = 0; k < 2; ++k) \
        acc[ai][bj][m][n] = __builtin_amdgcn_mfma_f32_16x16x32_f16(Bt[n][k], At[m][k], acc[ai][bj][m][n], 0, 0, 0); __builtin_amdgcn_s_setprio(0); } while (0)
#define PG8_WAIT_V(n) asm volatile("s_waitcnt vmcnt(" #n ")" ::: "memory")
#define PG8_WAIT_L(n) asm volatile("s_waitcnt lgkmcnt(" #n ")" ::: "memory")
#define PG8_BAR __builtin_amdgcn_s_barrier()
#define PG8_SCHED __builtin_amdgcn_sched_barrier(0)
    Unit cur, nxt; int ui = 0;
    if (!S.next(0, cur)) return;
    f32x4 acc[2][2][4][2];
#pragma unroll
    for (int a = 0; a < 2; ++a)
#pragma unroll
        for (int b = 0; b < 2; ++b)
#pragma unroll
            for (int m = 0; m < 4; ++m)
#pragma unroll
                for (int n = 0; n < 2; ++n) acc[a][b][m][n] = (f32x4){0.f, 0.f, 0.f, 0.f};
    h16x8 At[4][2], B0[2][2], B1[2][2];
    const char* cA = (const char*)g.A + (size_t)cur.pm * tstep; const char* cB = (const char*)g.Bt + (size_t)cur.pn * tstep;
    S.a_ready(cur);
    PG8_STAGE(PG8_SB(0, 0), cB, voffB); PG8_STAGE(PG8_SB(0, 1), cB + hstep, voffB); PG8_STAGE(PG8_SA(0, 0), cA, voffA); PG8_STAGE(PG8_SA(0, 1), cA + hstep, voffA);
    if (wr == 1) PG8_BAR;
    PG8_WAIT_V(2); PG8_BAR;
    PG8_STAGE(PG8_SB(1, 0), cB + kstep, voffB); PG8_STAGE(PG8_SA(1, 0), cA + kstep, voffA); PG8_STAGE(PG8_SB(1, 1), cB + hstep + kstep, voffB);
    PG8_WAIT_V(6); PG8_BAR;
    for (;;) {
        const bool has_next = S.next(ui + 1, nxt);
        const char* nA = has_next ? (const char*)g.A + (size_t)nxt.pm * tstep : cA; const char* nB = has_next ? (const char*)g.Bt + (size_t)nxt.pn * tstep : cB;
        for (int t = 0; t < nt; t += 2) {
            const bool last = (t == nt - 2);
            const char* a1 = cA + (size_t)(t + 1) * kstep;
            const char* a2 = last ? nA : cA + (size_t)(t + 2) * kstep; const char* b2 = last ? nB : cB + (size_t)(t + 2) * kstep;
            const char* a3 = a2 + kstep; const char* b3 = b2 + kstep;
            if (last && has_next) S.a_ready(nxt);
            PG8_LDB(B0, 0, 0); PG8_LDB(B1, 0, 1); PG8_SCHED; PG8_LDA(At, 0, 0); PG8_STAGE(PG8_SA(1, 1), a1 + hstep, voffA);
            PG8_WAIT_V(8); PG8_WAIT_L(0); PG8_BAR; PG8_MMA(0, 0, At, B0); PG8_MMA(0, 1, At, B1); PG8_BAR; PG8_SCHED;
            PG8_LDA(At, 0, 1); PG8_STAGE(PG8_SB(0, 0), b2, voffB); PG8_STAGE(PG8_SB(0, 1), b2 + hstep, voffB); PG8_STAGE(PG8_SA(0, 0), a2, voffA);
            PG8_WAIT_V(8); PG8_WAIT_L(0); PG8_BAR; PG8_MMA(1, 0, At, B0); PG8_MMA(1, 1, At, B1); PG8_BAR; PG8_SCHED;
            PG8_LDB(B0, 1, 0); PG8_LDB(B1, 1, 1); PG8_SCHED; PG8_LDA(At, 1, 0); PG8_STAGE(PG8_SA(0, 1), a2 + hstep, voffA);
            PG8_WAIT_V(8); PG8_WAIT_L(0); PG8_BAR; PG8_MMA(0, 0, At, B0); PG8_MMA(0, 1, At, B1); PG8_BAR; PG8_SCHED;
            PG8_LDA(At, 1, 1); PG8_STAGE(PG8_SB(1, 0), b3, voffB); PG8_STAGE(PG8_SB(1, 1), b3 + hstep, voffB); PG8_STAGE(PG8_SA(1, 0), a3, voffA);
            PG8_WAIT_V(8); PG8_WAIT_L(0); PG8_BAR; PG8_MMA(1, 0, At, B0); PG8_MMA(1, 1, At, B1); PG8_BAR; PG8_SCHED;
        }
        if constexpr (ALIGN_EPI) { if (wr == 0) PG8_BAR; }
        E(acc, cur, wr, wc, fr, fq); S.done(cur);
        if (!has_next) break;
#pragma unroll
        for (int a = 0; a < 2; ++a)
#pragma unroll
            for (int b = 0; b < 2; ++b)
#pragma unroll
                for (int m = 0; m < 4; ++m)
#pragma unroll
                    for (int n = 0; n < 2; ++n) acc[a][b][m][n] = (f32x4){0.f, 0.f, 0.f, 0.f};
        cur = nxt; cA = nA; cB = nB; ++ui;
        if constexpr (ALIGN_EPI) { if (wr == 1) PG8_BAR; }
    }
    PG8_WAIT_V(0);
    if constexpr (!ALIGN_EPI) { if (wr == 0) PG8_BAR; }
    PG8_BAR;
#undef PG8_SA
#undef PG8_SB
#undef PG8_STAGE
#undef PG8_LDA
#undef PG8_LDB
#undef PG8_MMA
#undef PG8_WAIT_V
#undef PG8_WAIT_L
#undef PG8_BAR
#undef PG8_SCHED
}
}

constexpr int NWAVES = 8, NTHR = NWAVES * 64;
constexpr int N_LAUNCHES = MK_N_LAUNCHES;
constexpr int N_PHASES = 16;
constexpr int BATCH = 2, SEQ = 8192, D = 1024, FF = 2816, M = BATCH * SEQ;
constexpr int NGU = 2 * FF;
constexpr int NPROJ = 3328;
constexpr int DIN = 3144;
constexpr int NH = 8, HD = 64, DATT = 512, DLRU = 512, TOPK = 256, CHUNK = 64;
constexpr int LCH = 32, NLCH = SEQ / LCH;
constexpr float EPS = 1e-6f;

constexpr size_t MiB = 1u << 20;
constexpr size_t WS_CTL = 0, CTL_ZERO_BYTES = 1 * MiB;
constexpr size_t WS_MOD = 1 * MiB;
constexpr size_t WS_LRUW = 2 * MiB;
constexpr size_t WS_LRUS = 246 * MiB;
constexpr size_t WS_W1GU = 3 * MiB, WS_W1D = 14 * MiB, WS_WIN = 20 * MiB, WS_WOUT = 27 * MiB, WS_W2GU = 29 * MiB, WS_W2D = 40 * MiB;
constexpr size_t WS_H = 46 * MiB;
constexpr size_t WS_ACT = 78 * MiB;
constexpr size_t WS_Y = 166 * MiB;
constexpr size_t WS_Q = 78 * MiB, WS_K = 94 * MiB, WS_V = 110 * MiB;
constexpr size_t WS_QS = 126 * MiB;
constexpr size_t WS_O = 142 * MiB;
constexpr size_t WS_KI = 158 * MiB;
constexpr size_t WS_WI = 160 * MiB;
constexpr size_t WS_MASK = 230 * MiB;
constexpr size_t WS_LRU = 166 * MiB;
constexpr size_t WS_MERGED = WS_H;
constexpr size_t WS_END = 248 * MiB;
constexpr int CW_BAR = 4096;

constexpr int RING_OFF = 0, RING_BYTES = 131072;
constexpr int LDSCTL_OFF = RING_BYTES, MISC_OFF = LDSCTL_OFF + 320;
constexpr int LDS_BYTES = 147456;

#define GAS __attribute__((address_space(1)))
#define LAS __attribute__((address_space(3)))
typedef _Float16 h16;
typedef unsigned v4u __attribute__((ext_vector_type(4)));
typedef unsigned v2u __attribute__((ext_vector_type(2)));
typedef float f32x4 __attribute__((ext_vector_type(4)));
typedef _Float16 h16x8 __attribute__((ext_vector_type(8)));
typedef _Float16 h16x4 __attribute__((ext_vector_type(4)));
typedef GAS unsigned gu32;
#define RLX_AGENT __ATOMIC_RELAXED, __HIP_MEMORY_SCOPE_AGENT
#define LDS_WAIT() asm volatile("s_waitcnt lgkmcnt(0)" ::: "memory")
#define VM_WAIT() asm volatile("s_waitcnt vmcnt(0)" ::: "memory")
using pg8::cvt_pk_h16;

#define XB_TMO      128
#define XB_XCNT(j)  (256  + 64 * (j))
#define XB_XSUB(j)  (1280 + 64 * (j))
#define XB_XGEN(j)  (2304 + 64 * (j))
#define XB_TOP      3328
#define XB_TOPGEN   3392
#define XCD_BAR_WORDS 3456
#define XB_SPIN_CAP (1u << 18)
__device__ __forceinline__ unsigned xb_ld(unsigned* p)              { return __hip_atomic_load(p, __ATOMIC_RELAXED, __HIP_MEMORY_SCOPE_AGENT); }
__device__ __forceinline__ unsigned xb_add(unsigned* p, unsigned v) { return __hip_atomic_fetch_add(p, v, __ATOMIC_RELAXED, __HIP_MEMORY_SCOPE_AGENT); }
__device__ __forceinline__ unsigned xb_xcc_id() { return (unsigned)__builtin_amdgcn_s_getreg((3 << 11) | 20) & 0xFu; }
#define XB_SPIN(cond, bar) do { unsigned _sp = 0; while (cond) { __builtin_amdgcn_s_sleep(1); \
    if ((++_sp & 255u) == 0u) { if (xb_ld(&(bar)[XB_TMO])) break; if (_sp > XB_SPIN_CAP) { atomicAdd(&(bar)[XB_TMO], 1u); break; } } } } while (0)
struct XcdBarrier { unsigned* bar; unsigned x; volatile LAS unsigned* st; };
__device__ __forceinline__ XcdBarrier xcd_barrier_post(unsigned* bar, volatile LAS unsigned* st) {
    XcdBarrier b; b.bar = bar; b.x = xb_xcc_id(); b.st = st;
    if (threadIdx.x == 0) (void)xb_add(&bar[XB_XCNT(b.x)], 1u);
    return b;
}
__device__ __forceinline__ void xcd_barrier_complete(unsigned* bar, unsigned x, unsigned& nloc, unsigned& nx) {
    const unsigned G = gridDim.x * gridDim.y * gridDim.z;
    unsigned sum, cnt, mine, sp = 0u;
    for (;;) {
        sum = 0u; cnt = 0u; mine = 0u;
#pragma unroll
        for (unsigned j = 0; j < 16; ++j) { const unsigned c = xb_ld(&bar[XB_XCNT(j)]); sum += c; cnt += (c > 0u) ? 1u : 0u; mine = (j == x) ? c : mine; }
        if (sum == G) break;
        __builtin_amdgcn_s_sleep(1);
        if ((++sp & 255u) == 0u) { if (xb_ld(&bar[XB_TMO])) break; if (sp > XB_SPIN_CAP) { atomicAdd(&bar[XB_TMO], 1u); break; } }
    }
    nloc = mine > 0u ? mine : 1u; nx = cnt > 0u ? cnt : 1u;
}
__device__ __forceinline__ void xcd_barrier(const XcdBarrier& b) {
    asm volatile("s_waitcnt vmcnt(0)" ::: "memory");
    __syncthreads();
    if (threadIdx.x == 0) {
        unsigned* bar = b.bar;
        __builtin_amdgcn_s_waitcnt(0);
        unsigned nloc = b.st[0], nx = b.st[1];
        if (nloc == 0u) { xcd_barrier_complete(bar, b.x, nloc, nx); b.st[0] = nloc; b.st[1] = nx; }
        const unsigned old = xb_add(&bar[XB_XSUB(b.x)], 1u);
        const unsigned gen = old / nloc;
        if (old + 1u == (gen + 1u) * nloc) {
            __builtin_amdgcn_fence(__ATOMIC_RELEASE, "agent");
            asm volatile("s_waitcnt vmcnt(0)" ::: "memory");
            const unsigned og = xb_add(&bar[XB_TOP], 1u);
            const unsigned tg = og / nx;
            if (og + 1u == (tg + 1u) * nx) xb_add(&bar[XB_TOPGEN], 1u);
            else XB_SPIN(xb_ld(&bar[XB_TOPGEN]) == tg, bar);
            __builtin_amdgcn_fence(__ATOMIC_ACQUIRE, "agent");
            xb_add(&bar[XB_XGEN(b.x)], 1u);
            asm volatile("s_waitcnt vmcnt(0)" ::: "memory");
        } else {
            XB_SPIN(xb_ld(&bar[XB_XGEN(b.x)]) == gen, bar);
            __builtin_amdgcn_fence(__ATOMIC_ACQUIRE, "agent");
            asm volatile("s_waitcnt vmcnt(0)" ::: "memory");
        }
    }
    __syncthreads();
}

struct Frame {
    LAS unsigned char* lds;
    volatile LAS unsigned* MISC;
    gu32* ctl;
    int tid, lane, wave;
    int vcu, G;
};
struct Args { const float* in[28]; float* out; unsigned char* ws; int ph_lo, ph_hi, li, pad; };

__device__ __forceinline__ float wave_sum(float v) {
#pragma unroll
    for (int o = 1; o < 64; o <<= 1) v += __shfl_xor(v, o);
    return v;
}
__device__ __forceinline__ float wave_max(float v) {
#pragma unroll
    for (int o = 1; o < 64; o <<= 1) v = fmaxf(v, __shfl_xor(v, o));
    return v;
}

struct MapId { __device__ __forceinline__ int operator()(int n) const { return n; } };
struct MapGU { int half; __device__ __forceinline__ int operator()(int n) const { return (n >> 7) * 256 + half * 128 + (n & 127); } };
struct MapIn { __device__ __forceinline__ int operator()(int n) const { return n < 2120 ? n : n + 184; } };
template <class RowMap>
__device__ __forceinline__ void p0_transpose_item(const float* W, int K, int N, h16* WT, RowMap rm, LAS float* scr, int item, int lane) {
    const int nblk = (N + 31) / 32, kb = item / nblk, nb = item % nblk, k0 = 64 * kb, n0 = 32 * nb;
    const int nl = n0 + (lane & 31);
#pragma unroll 8
    for (int i = 0; i < 32; ++i) { const int kk = 2 * i + (lane >> 5); scr[kk * 33 + (lane & 31)] = (nl < N) ? W[(size_t)(k0 + kk) * N + nl] : 0.f; }
    LDS_WAIT(); asm volatile("" ::: "memory");
    const int c = lane & 7;
#pragma unroll
    for (int j = 0; j < 4; ++j) { const int nn = (lane >> 3) + 8 * j; const LAS float* s = scr + (8 * c) * 33 + nn;
        v4u o; o.x = cvt_pk_h16(s[0 * 33], s[1 * 33]); o.y = cvt_pk_h16(s[2 * 33], s[3 * 33]); o.z = cvt_pk_h16(s[4 * 33], s[5 * 33]); o.w = cvt_pk_h16(s[6 * 33], s[7 * 33]);
        if (n0 + nn < N) *(GAS v4u*)(WT + (size_t)rm(n0 + nn) * K + k0 + 8 * c) = o; }
    LDS_WAIT(); asm volatile("" ::: "memory");
}

__device__ __forceinline__ void p0_prologue(Frame& F, const Args& A) {
    unsigned char* ws = A.ws;
    if (blockIdx.x < 36) {
        LAS float* sc = (LAS float*)(F.lds);
        LAS float* red = (LAS float*)(F.lds + 8192);
        const float* c = A.in[1];
        for (int i = F.tid; i < 2048; i += NTHR) { const float v = c[i]; sc[i] = v / (1.0f + __expf(-v)); }
        __syncthreads();
        const float* wa = A.in[2]; const int col = blockIdx.x * 256 + 4 * F.lane;
        f32x4 a0 = {0.f, 0.f, 0.f, 0.f}, a1 = {0.f, 0.f, 0.f, 0.f};
        const int kb = F.wave * 128;
#pragma unroll 8
        for (int k = 0; k < 128; ++k) { const f32x4 w = *(const f32x4*)(wa + (size_t)(kb + k) * 9216 + col); a0 += w * sc[kb + k]; a1 += w * sc[1024 + kb + k]; }
        *(LAS f32x4*)(red + (F.wave * 2 + 0) * 256 + 4 * F.lane) = a0; *(LAS f32x4*)(red + (F.wave * 2 + 1) * 256 + 4 * F.lane) = a1;
        __syncthreads();
        { const int b = F.tid >> 8, j = F.tid & 255; float s = 0.f;
#pragma unroll
          for (int w = 0; w < 8; ++w) s += red[(w * 2 + b) * 256 + j];
          const int cc = blockIdx.x * 256 + j; ((float*)(ws + WS_MOD))[b * 9216 + cc] = s + A.in[3][cc]; }
        __syncthreads();
    }
    LAS float* scr = (LAS float*)(F.lds + RING_OFF + F.wave * 16384);
    const int gw = F.vcu * NWAVES + F.wave, NGW = F.G * NWAVES;
    constexpr int I_GU = (D / 64) * (FF / 32), I_DN = (FF / 64) * (D / 32), I_IN = (D / 64) * ((DIN + 31) / 32), I_OUT = (D / 64) * (D / 32);
    constexpr int NITEMS = 6 * I_GU + I_IN + I_OUT; static_assert(I_GU == I_DN, "items");
    h16* W1GU = (h16*)(ws + WS_W1GU); h16* W1D = (h16*)(ws + WS_W1D); h16* WIN = (h16*)(ws + WS_WIN); h16* WOUT = (h16*)(ws + WS_WOUT); h16* W2GU = (h16*)(ws + WS_W2GU); h16* W2D = (h16*)(ws + WS_W2D);
    for (int it = gw; it < NITEMS; it += NGW) {
        int r = it;
        if (r < I_GU) { p0_transpose_item(A.in[6], D, FF, W1GU, MapGU{0}, scr, r, F.lane); continue; } r -= I_GU;
        if (r < I_GU) { p0_transpose_item(A.in[7], D, FF, W1GU, MapGU{1}, scr, r, F.lane); continue; } r -= I_GU;
        if (r < I_DN) { p0_transpose_item(A.in[8], FF, D, W1D, MapId{}, scr, r, F.lane); continue; } r -= I_DN;
        if (r < I_IN) { p0_transpose_item(A.in[11], D, DIN, WIN, MapIn{}, scr, r, F.lane); continue; } r -= I_IN;
        if (r < I_OUT) { p0_transpose_item(A.in[22], D, D, WOUT, MapId{}, scr, r, F.lane); continue; } r -= I_OUT;
        if (r < I_GU) { p0_transpose_item(A.in[25], D, FF, W2GU, MapGU{0}, scr, r, F.lane); continue; } r -= I_GU;
        if (r < I_GU) { p0_transpose_item(A.in[26], D, FF, W2GU, MapGU{1}, scr, r, F.lane); continue; } r -= I_GU;
        p0_transpose_item(A.in[27], FF, D, W2D, MapId{}, scr, r, F.lane);
    }
    for (int tk = gw; tk < 128; tk += NGW) { const int s4 = tk & 3, jt = (tk >> 2) & 1, g = (tk >> 3) & 7, gate = tk >> 6; const float* W = A.in[gate ? 17 : 15]; const int r = F.lane & 31, hh = F.lane >> 5;
        float v[8];
#pragma unroll
        for (int e = 0; e < 8; ++e) v[e] = W[(g * 64 + 16 * s4 + 8 * hh + e) * 64 + 32 * jt + r];
        v4u o; o.x = cvt_pk_h16(v[0], v[1]); o.y = cvt_pk_h16(v[2], v[3]); o.z = cvt_pk_h16(v[4], v[5]); o.w = cvt_pk_h16(v[6], v[7]);
        *(GAS v4u*)(ws + WS_LRUW + ((size_t)tk * 64 + F.lane) * 16) = o; }
    for (int i = blockIdx.x * NTHR + F.tid; i < 184 * 128; i += F.G * NTHR) *(GAS v4u*)(WIN + (size_t)2120 * D + (size_t)i * 8) = (v4u){0u, 0u, 0u, 0u};
}

template <bool HAS_Y, bool HAS_H>
__device__ __forceinline__ void thin_phase(Frame& F, const float* mod, const float* yin, const float* gpost, float gscale, int mg,
                                           const float* xin, float* xout, const float* gpre, int msh, int msc, h16* hout) {
    LAS float* TA = (LAS float*)(F.lds); LAS float* TB = TA + 2048; LAS float* TC = TB + 2048;
    for (int i = F.tid; i < 2048; i += NTHR) { const int b = i >> 10, cidx = i & 1023;
        if (HAS_Y) TA[i] = gscale * mod[b * 9216 + mg * 1024 + cidx] * gpost[cidx];
        if (HAS_H) { TB[i] = gpre[cidx] * (1.0f + mod[b * 9216 + msc * 1024 + cidx]); TC[i] = mod[b * 9216 + msh * 1024 + cidx]; } }
    __syncthreads();
    const int gw = F.vcu * NWAVES + F.wave, NGW = F.G * NWAVES;
    for (int row = gw; row < M; row += NGW) {
        const int b = row >> 13;
        const GAS f32x4* xr = (const GAS f32x4*)(xin + (size_t)row * D) + F.lane;
        f32x4 x[4];
#pragma unroll
        for (int j = 0; j < 4; ++j) x[j] = xr[64 * j];
        if (HAS_Y) {
            const GAS f32x4* yr = (const GAS f32x4*)(yin + (size_t)row * D) + F.lane;
            f32x4 y[4]; float s = 0.f;
#pragma unroll
            for (int j = 0; j < 4; ++j) { y[j] = yr[64 * j]; s += (y[j].x * y[j].x + y[j].y * y[j].y) + (y[j].z * y[j].z + y[j].w * y[j].w); }
            const float rstd = 1.0f / sqrtf(wave_sum(s) * (1.0f / D) + EPS);
            GAS f32x4* xo = (GAS f32x4*)(xout + (size_t)row * D) + F.lane;
#pragma unroll
            for (int j = 0; j < 4; ++j) { const f32x4 ta = *(const LAS f32x4*)(TA + b * 1024 + 4 * F.lane + 256 * j); x[j] = x[j] + ta * (y[j] * rstd); xo[64 * j] = x[j]; }
        }
        if (HAS_H) {
            float s = 0.f;
#pragma unroll
            for (int j = 0; j < 4; ++j) s += (x[j].x * x[j].x + x[j].y * x[j].y) + (x[j].z * x[j].z + x[j].w * x[j].w);
            const float rstd = 1.0f / sqrtf(wave_sum(s) * (1.0f / D) + EPS);
            GAS v2u* ho = (GAS v2u*)(hout + (size_t)row * D) + F.lane;
#pragma unroll
            for (int j = 0; j < 4; ++j) { const f32x4 tb = *(const LAS f32x4*)(TB + b * 1024 + 4 * F.lane + 256 * j), tc = *(const LAS f32x4*)(TC + b * 1024 + 4 * F.lane + 256 * j);
                const f32x4 h = (x[j] * rstd) * tb + tc; v2u o; o.x = cvt_pk_h16(h.x, h.y); o.y = cvt_pk_h16(h.z, h.w); ho[64 * j] = o; }
        }
    }
    __syncthreads();
}

__device__ __forceinline__ float gelu_tanh(float x) { const float u = 0.7978845608028654f * (x + 0.044715f * x * x * x); const float e = __builtin_amdgcn_exp2f(2.0f * 1.4426950408889634f * u); const float t = 1.0f - 2.0f * __builtin_amdgcn_rcpf(e + 1.0f); return 0.5f * x * (1.0f + t); }
__device__ __forceinline__ float fast_sigmoid(float z) { return __builtin_amdgcn_rcpf(1.0f + __builtin_amdgcn_exp2f(-1.4426950408889634f * z)); }
__device__ __forceinline__ float lane_partner(float x, int hh) { auto rr = __builtin_amdgcn_permlane32_swap(__float_as_uint(x), __float_as_uint(x), false, false); return __uint_as_float(hh ? rr[0] : rr[1]); }
typedef float f32x16 __attribute__((ext_vector_type(16)));
__device__ __forceinline__ int crow(int r, int hi) { return (r & 3) + 8 * (r >> 2) + 4 * hi; }
constexpr int LL_XC = 0, LL_OUT = 32768, LL_CAR = 131072 + 1024;
template <bool PASS_B>
__device__ __forceinline__ void lru_phase(Frame& F, const Args& A) {
    unsigned char* ws = A.ws;
    const h16* LRU = (const h16*)(ws + WS_LRU); float* SA = (float*)(ws + WS_LRUS); float* SB = SA + BATCH * NLCH * DLRU;
    h16* MERGED = (h16*)(ws + WS_MERGED);
    int tid_o = F.tid; asm volatile("" : "+v"(tid_o));
    const int tid = tid_o, lane = tid & 63, g = F.wave, r = lane & 31, hh = lane >> 5;
    LAS unsigned char* XC = F.lds + LL_XC; LAS float* OUT = (LAS float*)(F.lds + LL_OUT); LAS float* CAR = (LAS float*)(F.lds + LL_CAR);
    const h16x8* LW = (const h16x8*)(ws + WS_LRUW);
    float ba[2], bi[2], sp8[2];
#pragma unroll
    for (int jt = 0; jt < 2; ++jt) { const int ch = g * 64 + 32 * jt + r; ba[jt] = A.in[16][ch]; bi[jt] = A.in[18][ch]; const float lam = A.in[19][ch]; sp8[jt] = 8.0f * ((lam < -15.f) ? -lam : log1pf(__expf(-lam))); }
    for (int p = blockIdx.x; p < 256; p += F.G) {
#pragma unroll 1
        for (int uu = 0; uu < 2; ++uu) {
            const int b = p >> 7, c = uu ? 255 - (p & 127) : (p & 127), t0 = c * LCH;
            const h16* xb = LRU + (size_t)(b * SEQ) * 1024;
            __syncthreads();
            if (PASS_B) { float H = 0.f; const float* pa = SA + (size_t)(b * NLCH) * DLRU + tid; const float* pb = SB + (size_t)(b * NLCH) * DLRU + tid;
#pragma unroll 1
                for (int cc0 = 0; cc0 < c; cc0 += 16) {
                    float fa[16], fb[16];
#pragma unroll
                    for (int k = 0; k < 16; ++k) { const int ci = (cc0 + k < c) ? cc0 + k : c - 1; fa[k] = pa[(size_t)ci * DLRU]; fb[k] = pb[(size_t)ci * DLRU]; }
#pragma unroll
                    for (int k = 0; k < 16; ++k) { const bool ok = cc0 + k < c; H = (ok ? fa[k] : 1.0f) * H + (ok ? fb[k] : 0.0f); } }
                CAR[tid] = H; }
            asm volatile("" ::: "memory");
            { h16x8 xr[7]; f32x4 cwv[4][2], cbv[2];
              cbv[0] = *(const f32x4*)(A.in[14] + 8 * lane); cbv[1] = *(const f32x4*)(A.in[14] + 8 * lane + 4);
#pragma unroll
              for (int jx = 0; jx < 4; ++jx) { cwv[jx][0] = *(const f32x4*)(A.in[13] + jx * DLRU + 8 * lane); cwv[jx][1] = *(const f32x4*)(A.in[13] + jx * DLRU + 8 * lane + 4); }
#pragma unroll
              for (int k = 0; k < 7; ++k) { const int t = t0 + 4 * g - 3 + k; if (t >= 0) xr[k] = *(const h16x8*)(xb + (size_t)t * 1024 + 8 * lane); else xr[k] = (h16x8){0, 0, 0, 0, 0, 0, 0, 0}; }
#pragma unroll
              for (int tt = 0; tt < 4; ++tt) { float v[8];
#pragma unroll
                  for (int e = 0; e < 8; ++e) v[e] = cbv[e >> 2][e & 3] + (float)xr[tt][e] * cwv[0][e >> 2][e & 3] + (float)xr[tt + 1][e] * cwv[1][e >> 2][e & 3] + (float)xr[tt + 2][e] * cwv[2][e >> 2][e & 3] + (float)xr[tt + 3][e] * cwv[3][e >> 2][e & 3];
                  v4u o; o.x = cvt_pk_h16(v[0], v[1]); o.y = cvt_pk_h16(v[2], v[3]); o.z = cvt_pk_h16(v[4], v[5]); o.w = cvt_pk_h16(v[6], v[7]);
                  const int row = 4 * g + tt; *(LAS v4u*)(XC + row * 1024 + ((lane ^ (row & 7)) << 4)) = o; } }
            __syncthreads();
            h16x8 af[4];
#pragma unroll
            for (int s = 0; s < 4; ++s) af[s] = *(const LAS h16x8*)(XC + r * 1024 + (((g * 8 + 2 * s + hh) ^ (r & 7)) << 4));
#pragma unroll 1
            for (int jt = 0; jt < 2; ++jt) {
                float gt[16];
                if (PASS_B) {
#pragma unroll
                    for (int i = 0; i < 16; ++i) gt[i] = (float)xb[(size_t)(t0 + crow(i, hh)) * 1024 + 512 + g * 64 + 32 * jt + r]; }
                float av[16], bv[16];
                const int ch = g * 64 + 32 * jt + r;
                {   h16x8 wf[4];
#pragma unroll
                    for (int s = 0; s < 4; ++s) wf[s] = LW[(((0 * 8 + g) * 2 + jt) * 4 + s) * 64 + lane];
                    f32x16 za = {};
#pragma unroll
                    for (int s = 0; s < 4; ++s) za = __builtin_amdgcn_mfma_f32_32x32x16_f16(af[s], wf[s], za, 0, 0, 0);
#pragma unroll
                    for (int i = 0; i < 16; ++i) { const float rg = fast_sigmoid(za[i] + (jt ? ba[1] : ba[0])); const float la = -(jt ? sp8[1] : sp8[0]) * rg, y = 2.0f * la;
                        const float em = (y > -0.03f) ? -y * (1.0f + y * (0.5f + y * (0.16666667f + y * 0.041666668f))) : 1.0f - __expf(y);
                        av[i] = __expf(la); bv[i] = __builtin_amdgcn_sqrtf(em); } }
                {   h16x8 wf[4];
#pragma unroll
                    for (int s = 0; s < 4; ++s) wf[s] = LW[(((1 * 8 + g) * 2 + jt) * 4 + s) * 64 + lane];
                    f32x16 zi = {};
#pragma unroll
                    for (int s = 0; s < 4; ++s) zi = __builtin_amdgcn_mfma_f32_32x32x16_f16(af[s], wf[s], zi, 0, 0, 0);
#pragma unroll
                    for (int i = 0; i < 16; ++i) { const int t = crow(i, hh); const float ig = fast_sigmoid(zi[i] + (jt ? bi[1] : bi[0]));
                        const float xcv = (float)*(const LAS h16*)(XC + t * 1024 + ((((ch >> 3)) ^ (t & 7)) << 4) + (ch & 7) * 2);
                        bv[i] *= ig * xcv; } }
                float GA[4], GB[4];
#pragma unroll
                for (int k = 0; k < 4; ++k) { float Ak = av[4 * k], Bk = bv[4 * k];
#pragma unroll
                    for (int e = 1; e < 4; ++e) { Bk = av[4 * k + e] * Bk + bv[4 * k + e]; Ak *= av[4 * k + e]; }
                    GA[k] = Ak; GB[k] = Bk; }
                float state = PASS_B ? CAR[ch] : 0.f; float cin[4];
#pragma unroll
                for (int k = 0; k < 4; ++k) { const float out0 = GA[k] * state + GB[k]; const float p0 = lane_partner(out0, hh); const float in1 = hh ? p0 : state; cin[k] = in1;
                    const float out1 = GA[k] * in1 + GB[k]; const float p1 = lane_partner(out1, hh); state = hh ? out1 : p1; }
                if (!PASS_B) { float P = (GA[0] * GA[1]) * (GA[2] * GA[3]); P *= lane_partner(P, hh);
                    if (hh == 0) { SA[(size_t)(b * NLCH + c) * DLRU + ch] = P; SB[(size_t)(b * NLCH + c) * DLRU + ch] = state; } }
                else {
#pragma unroll
                    for (int k = 0; k < 4; ++k) { float h = cin[k];
#pragma unroll
                        for (int e = 0; e < 4; ++e) { const int i = 4 * k + e; h = av[i] * h + bv[i]; OUT[crow(i, hh) * 512 + ch] = h * gelu_tanh(gt[i]); } } }
            }
            if (PASS_B) {
                __syncthreads();
#pragma unroll
                for (int k = 0; k < 4; ++k) { const int tt = 4 * g + k;
                    const f32x4 o0 = *(const LAS f32x4*)(OUT + tt * 512 + 8 * lane), o1 = *(const LAS f32x4*)(OUT + tt * 512 + 8 * lane + 4);
                    const float s = (o0.x * o0.x + o0.y * o0.y) + (o0.z * o0.z + o0.w * o0.w) + (o1.x * o1.x + o1.y * o1.y) + (o1.z * o1.z + o1.w * o1.w);
                    const float rstd = 1.0f / sqrtf(wave_sum(s) * (1.0f / DLRU) + EPS);
                    const f32x4 g0 = *(const f32x4*)(A.in[21] + 8 * lane), g1 = *(const f32x4*)(A.in[21] + 8 * lane + 4);
                    v4u o; o.x = cvt_pk_h16(o0.x * rstd * g0.x, o0.y * rstd * g0.y); o.y = cvt_pk_h16(o0.z * rstd * g0.z, o0.w * rstd * g0.w);
                    o.z = cvt_pk_h16(o1.x * rstd * g1.x, o1.y * rstd * g1.y); o.w = cvt_pk_h16(o1.z * rstd * g1.z, o1.w * rstd * g1.w);
                    *(GAS v4u*)(MERGED + (size_t)(b * SEQ + t0 + tt) * 1024 + 512 + 8 * lane) = o; }
            }
        }
    }
}

constexpr int IDX_CAP = 128;
constexpr int IL_QL = 0, IL_WL = 36864, IL_INFO = 37888, IL_CNT = 38400, IL_PS = 38912, IL_MAXCC = 40960, IL_HIST = 65536  , IL_CAND = 98304  , IL_SCR = 65536  ;
constexpr int SL_SCORE = 65536, SL_HIST = 98304, SL_CTL = 99328;
constexpr size_t IDX_SLOT_BYTES = 129 * 2048;
__device__ __forceinline__ unsigned ord_key(float f) { const unsigned u = __float_as_uint(f); return u ^ ((u >> 31) ? 0xFFFFFFFFu : 0x80000000u); }
__device__ __forceinline__ int t5_bucket(int rel) {
    const int n = rel < 0 ? -rel : rel; int large;
    if (n < 12) large = 8; else if (n < 16) large = 9; else if (n < 23) large = 10; else if (n < 32) large = 11; else if (n < 46) large = 12; else if (n < 64) large = 13; else if (n < 91) large = 14; else large = 15;
    return (rel > 0 ? 16 : 0) + (n < 8 ? n : large);
}
#define IDX_FMA_ABS(s_, x_, w_) asm("v_fma_f32 %0, |%1|, %2, %0" : "+v"(s_) : "v"(x_), "v"(w_))
template <int NS>
__device__ __forceinline__ void idx_scores(f32x16 (&S)[NS], const h16x8 (&a)[NS][4], const LAS unsigned char* ql, int foff, int sw, int hh, const LAS float* wl) {
    {   h16x8 qf[4];
#pragma unroll
        for (int s = 0; s < 4; ++s) qf[s] = *(const LAS h16x8*)(ql + 8 * 4096 + foff + (((2 * s + hh) ^ sw) << 4));
#pragma unroll
        for (int sub = 0; sub < NS; ++sub) { f32x16 acc = {};
#pragma unroll
            for (int s = 0; s < 4; ++s) acc = __builtin_amdgcn_mfma_f32_32x32x16_f16(a[sub][s], qf[s], acc, 0, 0, 0);
            S[sub] = acc; } }
#pragma unroll 1
    for (int h = 0; h < 8; ++h) {
        h16x8 qf[4]; const float wh = wl[h];
#pragma unroll
        for (int s = 0; s < 4; ++s) qf[s] = *(const LAS h16x8*)(ql + h * 4096 + foff + (((2 * s + hh) ^ sw) << 4));
        f32x16 acc[NS];
#pragma unroll
        for (int sub = 0; sub < NS; ++sub) { acc[sub] = f32x16{};
#pragma unroll
            for (int s = 0; s < 4; ++s) acc[sub] = __builtin_amdgcn_mfma_f32_32x32x16_f16(a[sub][s], qf[s], acc[sub], 0, 0, 0); }
#pragma unroll
        for (int sub = 0; sub < NS; ++sub) {
            asm volatile("s_nop 15" : "+v"(acc[sub]), "+v"(S[sub]));
#pragma unroll
            for (int i = 0; i < 16; ++i) IDX_FMA_ABS(S[sub][i], acc[sub][i], wh); }
    }
#pragma unroll
    for (int sub = 0; sub < NS; ++sub) asm volatile("s_nop 1" : "+v"(S[sub]));
}
__device__ __forceinline__ float inv_norm_cdf(float p) { const float x = 2.0f * p - 1.0f, ln = logf(fmaxf(1.0f - x * x, 1e-30f)), a = 0.147f, t = 2.0f / (3.14159265f * a) + 0.5f * ln;
    const float e = sqrtf(fmaxf(sqrtf(t * t - ln / a) - t, 0.f)); return 1.41421356f * (x < 0.f ? -e : e); }
__device__ __forceinline__ unsigned char* idx_slot(unsigned char* ws, int p) { return (p < 127) ? ws + WS_H + (size_t)p * IDX_SLOT_BYTES : (p < 254) ? ws + 198 * MiB + (size_t)(p - 127) * IDX_SLOT_BYTES : ws + WS_W1GU + (size_t)(p - 254) * IDX_SLOT_BYTES; }
__device__ __forceinline__ void idx_phase(Frame& F, const Args& A) {
    unsigned char* ws = A.ws;
    const h16* QS = (const h16*)(ws + WS_QS); const h16* KI = (const h16*)(ws + WS_KI); const float* WI = (const float*)(ws + WS_WI);
    unsigned* MASK = (unsigned*)(ws + WS_MASK);
    LAS unsigned char* L = F.lds;
    int tid_o = F.tid; asm volatile("" : "+v"(tid_o));
    const int tid = tid_o, lane = tid & 63, wave = F.wave, r = lane & 31, hh = lane >> 5;
    LAS float* WL = (LAS float*)(L + IL_WL); LAS int* INFO = (LAS int*)(L + IL_INFO); LAS unsigned* CNT = (LAS unsigned*)(L + IL_CNT);
    LAS unsigned* HIST = (LAS unsigned*)(L + IL_HIST); LAS unsigned* MAXCC = (LAS unsigned*)(L + IL_MAXCC);
#if PROBE_DIAG
    const int diag = A.pad;
#else
    constexpr int diag = 0;
#endif
    for (int p = blockIdx.x; p < 256; p += F.G) {
        const int b = p >> 7, jj = p & 127;
        unsigned char* slot = idx_slot(ws, p);
#pragma unroll 1
        for (int uu = 0; uu < 2; ++uu) {
            const int j = uu ? 255 - jj : jj;
            const int q0 = 32 * j, rowb = b * SEQ + q0, N = ((j >> 1) + 1) * 64, NC = N >> 6;
            unsigned* mrow = MASK + ((size_t)(b * 128) * 8192 + q0) * 2;
            v4u* codes = (v4u*)(slot + (uu ? (size_t)((jj >> 1) + 1) * 2048 : 0));
            if (N <= TOPK) {
                for (int i = tid; i < NC * 64; i += NTHR) mrow[(size_t)(i >> 6) * 16384 + (i & 63)] = 0xFFFFFFFFu;
                continue;
            }
            __syncthreads();
#pragma unroll
            for (int i = 0; i < 4; ++i) { const int idx = tid + NTHR * i, q = idx >> 6, cc = idx & 63, head = cc >> 3, c8 = cc & 7;
                const v4u v = *(const GAS v4u*)(QS + (size_t)(rowb + q) * 512 + cc * 8);
                *(LAS v4u*)(L + IL_QL + head * 4096 + q * 128 + ((c8 ^ (q & 7)) << 4)) = v; }
            if (tid < 256) WL[tid] = WI[(size_t)rowb * 8 + tid];
            for (int i = tid; i < 8192; i += NTHR) HIST[i] = 0u;
            if (tid < 32) CNT[tid] = 0u;
            if (tid == 0) MAXCC[0] = 0u;
            __syncthreads();
            { const int q = tid >> 4, dg = tid & 15, c8 = dg >> 1; float a0 = 0.f, a1 = 0.f, a2 = 0.f, a3 = 0.f;
              const int o = q * 128 + ((c8 ^ (q & 7)) << 4) + (dg & 1) * 8;
#pragma unroll
              for (int h = 0; h < 8; ++h) { const h16x4 v = *(const LAS h16x4*)(L + IL_QL + h * 4096 + o); const float wv = WL[q * 8 + h];
                  a0 += wv * (float)v[0]; a1 += wv * (float)v[1]; a2 += wv * (float)v[2]; a3 += wv * (float)v[3]; }
              v2u pk; pk.x = cvt_pk_h16(a0, a1); pk.y = cvt_pk_h16(a2, a3); *(LAS v2u*)(L + IL_QL + 8 * 4096 + o) = pk; }
            __syncthreads();
            const LAS float* w = WL + r * 8;
            const int foff = r * 128, sw = r & 7;
            const h16* kbat = KI + (size_t)(b * SEQ) * 64;
            const h16* kbase = kbat + (size_t)r * 64 + 8 * hh;
            const LAS unsigned char* ql = L + IL_QL;
#define IDX_LOADA(dst, c) do { _Pragma("unroll") for (int sub_ = 0; sub_ < 2; ++sub_) _Pragma("unroll") for (int s_ = 0; s_ < 4; ++s_) \
                dst[sub_][s_] = *(const h16x8*)(kbase + (size_t)(64 * (c) + 32 * sub_) * 64 + 16 * s_); } while (0)
            h16x8 a[2][4]; f32x16 S[2];
            S[0] = f32x16{}; S[1] = f32x16{};
            if (!(diag & 16)) { const int cs = (wave * NC) >> 3; IDX_LOADA(a, cs); idx_scores<2>(S, a, ql, foff, sw, hh, w); }
            float s1 = 0.f, s2 = 0.f;
#pragma unroll
            for (int sub = 0; sub < 2; ++sub)
#pragma unroll
                for (int i = 0; i < 16; ++i) { s1 += S[sub][i]; s2 += S[sub][i] * S[sub][i]; }
            s1 += __shfl_xor(s1, 32); s2 += __shfl_xor(s2, 32);
            { LAS float* ST = (LAS float*)(L + IL_PS);
              if (hh == 0) { ST[(wave * 32 + r) * 2] = s1; ST[(wave * 32 + r) * 2 + 1] = s2; }
              __syncthreads();
              s1 = 0.f; s2 = 0.f;
#pragma unroll
              for (int k = 0; k < 8; ++k) { s1 += ST[(k * 32 + r) * 2]; s2 += ST[(k * 32 + r) * 2 + 1]; }
              __syncthreads(); }
            const float mean = s1 * (1.0f / 512.0f), sd = sqrtf(fmaxf(s2 * (1.0f / 512.0f) - mean * mean, 1e-30f));
            const float zN = inv_norm_cdf(1.0f - (float)TOPK / (float)N);
            const float inv_w = 128.0f / sd, off = -(mean + (zN - 1.0f) * sd) * inv_w;
            if (!(diag & 32)) { int c = wave; if (c < NC) IDX_LOADA(a, c);
              for (; c < NC; c += 8) {
                if (!(diag & 1)) idx_scores<2>(S, a, ql, foff, sw, hh, w);
                if (c + 8 < NC) IDX_LOADA(a, c + 8);
                if (diag & 2) continue;
                unsigned cw[8];
#pragma unroll
                for (int k = 0; k < 8; ++k) cw[k] = 0u;
#pragma unroll
                for (int sub = 0; sub < 2; ++sub)
#pragma unroll
                    for (int i = 0; i < 16; ++i) { const int e = 16 * sub + i; unsigned u; { const float bf = __builtin_fmaf(S[sub][i], inv_w, off); asm("v_cvt_u32_f32 %0, %1" : "=v"(u) : "v"(bf)); }
                        u = u < 255u ? u : 255u;
                        if (u) __hip_atomic_fetch_add(HIST + u * 32 + r, 1u, __ATOMIC_RELAXED, __HIP_MEMORY_SCOPE_WORKGROUP);
                        cw[e >> 2] |= u << (8 * (e & 3)); }
                codes[(size_t)(c * 64 + lane) * 2] = (v4u){cw[0], cw[1], cw[2], cw[3]}; codes[(size_t)(c * 64 + lane) * 2 + 1] = (v4u){cw[4], cw[5], cw[6], cw[7]};
              } }
            VM_WAIT(); __syncthreads();
            { LAS unsigned* PS = (LAS unsigned*)(L + IL_PS); const int rg = wave * 2 + hh; unsigned sum = 0u;
#pragma unroll
              for (int k = 0; k < 16; ++k) sum += HIST[(rg * 16 + k) * 32 + r];
              PS[rg * 32 + r] = sum;
              __syncthreads();
              if (wave == 0 && hh == 0) { const int q = r; unsigned cum = 0u; int rsel = 0; unsigned ps[16];
#pragma unroll
                  for (int k = 0; k < 16; ++k) ps[k] = PS[k * 32 + q];
                  bool found = false; unsigned above = 0u;
#pragma unroll
                  for (int k = 15; k >= 0; --k) { if (!found) { if (cum + ps[k] >= (unsigned)TOPK) { found = true; rsel = k; above = cum; } else cum += ps[k]; } }
                  int bsel = -1; unsigned cb = 0u, ca = 0u; cum = above;
                  for (int k = 15; k >= 0; --k) { const unsigned cn = HIST[(rsel * 16 + k) * 32 + q]; if (bsel < 0) { if (cum + cn >= (unsigned)TOPK) { bsel = rsel * 16 + k; cb = cn; ca = cum; } else cum += cn; } }
                  int slow = (!found || bsel <= 0 || bsel >= 255 || cb > (unsigned)IDX_CAP) ? 1 : 0;
#ifdef IDX_FORCE_SLOW
                  if (((rowb + q) % 251) == 0) slow = 1;
#endif
                  INFO[q * 4 + 0] = bsel; INFO[q * 4 + 1] = TOPK - (int)ca; INFO[q * 4 + 2] = slow; }
            }
            __syncthreads();
            const unsigned cstar = (unsigned)INFO[r * 4 + 0];
            LAS unsigned* cand = (LAS unsigned*)(L + IL_CAND);
            if (!(diag & 4)) { int c = wave; v4u w0, w1; if (c < NC) { w0 = codes[(size_t)(c * 64 + lane) * 2]; w1 = codes[(size_t)(c * 64 + lane) * 2 + 1]; }
            for (; c < NC; c += 8) {
                const unsigned cw[8] = {w0.x, w0.y, w0.z, w0.w, w1.x, w1.y, w1.z, w1.w};
                if (c + 8 < NC) { w0 = codes[(size_t)((c + 8) * 64 + lane) * 2]; w1 = codes[(size_t)((c + 8) * 64 + lane) * 2 + 1]; }
                unsigned selw = 0u, cndw = 0u;
#pragma unroll
                for (int e = 0; e < 32; ++e) { const unsigned u = (cw[e >> 2] >> (8 * (e & 3))) & 0xFFu; selw = selw * 2u + (u > cstar ? 1u : 0u); cndw = cndw * 2u + (u == cstar ? 1u : 0u); }
                selw = (selw >> 16) | (selw << 16); cndw = (cndw >> 16) | (cndw << 16);
                mrow[(size_t)c * 16384 + (r * 2 + hh)] = selw;
                unsigned bits = cndw;
                while (bits) { const int bp = 31 - __clz((int)bits); bits &= ~(1u << bp); const int sub = bp >> 4, i = 15 - (bp & 15);
                    const unsigned key = (unsigned)(64 * c + 32 * sub + crow(i, hh));
                    const unsigned pos = __hip_atomic_fetch_add(CNT + r, 1u, __ATOMIC_RELAXED, __HIP_MEMORY_SCOPE_WORKGROUP);
                    if (pos < (unsigned)IDX_CAP) cand[(r * IDX_CAP + pos) * 2 + 1] = key; }
            } }
            VM_WAIT(); __syncthreads();
            if (tid < 32) { const unsigned cc = CNT[tid]; if (cc > (unsigned)IDX_CAP) INFO[tid * 4 + 2] = 1; else if (!INFO[tid * 4 + 2]) __hip_atomic_fetch_max(MAXCC, cc, __ATOMIC_RELAXED, __HIP_MEMORY_SCOPE_WORKGROUP); }
            __syncthreads();
            if (!(diag & 8)) { const int maxcc = (int)MAXCC[0]; LAS float* scr = (LAS float*)(L + IL_SCR + wave * 4096);
              const unsigned myc = CNT[r] <= (unsigned)IDX_CAP ? CNT[r] : 0u;
              h16x8 a1[1][4];
              { const int i = wave; if (i < maxcc) { const unsigned key = ((unsigned)i < myc) ? cand[(r * IDX_CAP + i) * 2 + 1] : 0u;
#pragma unroll
                    for (int s = 0; s < 4; ++s) a1[0][s] = *(const h16x8*)(kbat + (size_t)key * 64 + 16 * s + 8 * hh); } }
              for (int i = wave; i < maxcc; i += 8) {
                  f32x16 S1[1];
                  idx_scores<1>(S1, a1, ql, foff, sw, hh, w);
                  if (i + 8 < maxcc) { const unsigned key = ((unsigned)(i + 8) < myc) ? cand[(r * IDX_CAP + i + 8) * 2 + 1] : 0u;
#pragma unroll
                      for (int s = 0; s < 4; ++s) a1[0][s] = *(const h16x8*)(kbat + (size_t)key * 64 + 16 * s + 8 * hh); }
#pragma unroll
                  for (int k = 0; k < 16; ++k) scr[k * 64 + lane] = S1[0][k];
                  LDS_WAIT();
                  const float val = scr[((r & 3) + 4 * (r >> 3)) * 64 + r + 32 * ((r >> 2) & 1)];
                  if (hh == 0 && (unsigned)i < myc) cand[(r * IDX_CAP + i) * 2] = __float_as_uint(val);
                  LDS_WAIT();
              } }
            __syncthreads();
#pragma unroll 1
            for (int k = 0; k < 4; ++k) { const int q = 4 * wave + k; const unsigned cc = CNT[q]; const int need = INFO[q * 4 + 1];
                if (INFO[q * 4 + 2]) continue;
                for (unsigned i = lane; i < cc; i += 64) { const float si = __uint_as_float(cand[(q * IDX_CAP + i) * 2]); const unsigned ki = cand[(q * IDX_CAP + i) * 2 + 1]; int rank = 0;
                    for (unsigned jx = 0; jx < cc; ++jx) { const float sj = __uint_as_float(cand[(q * IDX_CAP + jx) * 2]); const unsigned kj = cand[(q * IDX_CAP + jx) * 2 + 1]; rank += (sj > si || (sj == si && kj < ki)) ? 1 : 0; }
                    if (rank < need) { const unsigned c = ki >> 6, sub = (ki >> 5) & 1u, row = ki & 31u, hk = (row >> 2) & 1u, rr = (row & 3u) + 4u * (row >> 3);
                        __hip_atomic_fetch_or(mrow + (size_t)c * 16384 + (q * 2 + hk), 1u << (16u * sub + 15u - rr), __ATOMIC_RELAXED, __HIP_MEMORY_SCOPE_AGENT); } }
            }
            __syncthreads();
#pragma unroll 1
            for (int q = 0; q < 32; ++q) {
                if (!INFO[q * 4 + 2] || (diag & 64)) continue;
                LAS float* s_score = (LAS float*)(L + SL_SCORE); LAS unsigned* s_hist = (LAS unsigned*)(L + SL_HIST); LAS unsigned* s_ctl = (LAS unsigned*)(L + SL_CTL);
                __syncthreads();
                for (int s = tid; s < N; s += NTHR) {
                    const h16* kr = KI + (size_t)(b * SEQ + s) * 64; float kv[64];
#pragma unroll
                    for (int i = 0; i < 8; ++i) { const h16x8 t8 = *(const h16x8*)(kr + 8 * i);
#pragma unroll
                        for (int e = 0; e < 8; ++e) kv[8 * i + e] = (float)t8[e]; }
                    float sc = 0.f;
#pragma unroll 1
                    for (int h = 0; h < 9; ++h) { float d = 0.f;
#pragma unroll
                        for (int c8 = 0; c8 < 8; ++c8) { const h16x8 qv = *(const LAS h16x8*)(L + IL_QL + h * 4096 + q * 128 + ((c8 ^ (q & 7)) << 4));
#pragma unroll
                            for (int e = 0; e < 8; ++e) d += (float)qv[e] * kv[8 * c8 + e]; }
                        sc += (h == 8) ? d : fabsf(d) * WL[q * 8 + h]; }
                    s_score[s] = sc;
                }
                __syncthreads();
                unsigned prefix = 0u, msk = 0u, remaining = TOPK, n_eq = 0u;
                for (int pass = 0; pass < 4; ++pass) {
                    const int shift = 24 - 8 * pass;
                    if (tid < 256) s_hist[tid] = 0u;
                    __syncthreads();
                    for (int s = tid; s < N; s += NTHR) { const unsigned key = ord_key(s_score[s]); if ((key & msk) == prefix) __hip_atomic_fetch_add(s_hist + ((key >> shift) & 255u), 1u, __ATOMIC_RELAXED, __HIP_MEMORY_SCOPE_WORKGROUP); }
                    __syncthreads();
                    if (wave == 0) {
                        const unsigned h0 = s_hist[4 * lane], h1 = s_hist[4 * lane + 1], h2 = s_hist[4 * lane + 2], h3 = s_hist[4 * lane + 3];
                        unsigned v = h0 + h1 + h2 + h3;
#pragma unroll
                        for (int o = 1; o < 64; o <<= 1) { const unsigned tv = __shfl_down(v, o); if (lane + o < 64) v += tv; }
                        unsigned above = __shfl_down(v, 1); if (lane == 63) above = 0u;
                        if (v >= remaining && above < remaining) {
                            unsigned cum = above; int dsel; unsigned rem; unsigned hv;
                            if (cum + h3 >= remaining) { dsel = 3; rem = remaining - cum; hv = h3; }
                            else { cum += h3; if (cum + h2 >= remaining) { dsel = 2; rem = remaining - cum; hv = h2; }
                            else { cum += h2; if (cum + h1 >= remaining) { dsel = 1; rem = remaining - cum; hv = h1; }
                            else { cum += h1; dsel = 0; rem = remaining - cum; hv = h0; } } }
                            s_ctl[0] = (unsigned)(4 * lane + dsel); s_ctl[1] = rem; s_ctl[4] = hv; }
                    }
                    __syncthreads();
                    prefix |= s_ctl[0] << shift; msk |= 255u << shift; remaining = s_ctl[1]; n_eq = s_ctl[4];
                    __syncthreads();
                }
                const unsigned tu = (prefix & 0x80000000u) ? (prefix ^ 0x80000000u) : ~prefix; const float thr = __uint_as_float(tu);
                unsigned idx_cut = 0xFFFFFFFFu;
                if (n_eq > remaining) {
                    if (tid == 0) { unsigned cnt = 0, cut = 0; for (int s = 0; s < N; ++s) if (s_score[s] == thr) { ++cnt; if (cnt == remaining) { cut = (unsigned)s; break; } } s_ctl[3] = cut; }
                    __syncthreads();
                    idx_cut = s_ctl[3];
                }
                int i0 = tid; asm volatile("" : "+v"(i0));
                for (int i = i0; i < NC * 2; i += NTHR) { const int c = i >> 1, hk = i & 1; unsigned word = 0u;
#pragma unroll
                    for (int sub = 0; sub < 2; ++sub)
#pragma unroll
                        for (int rr = 0; rr < 16; ++rr) { const int key = 64 * c + 32 * sub + crow(rr, hk); const float sc = s_score[key];
                            if (sc > thr || (sc == thr && (unsigned)key <= idx_cut)) word |= 1u << (16 * sub + 15 - rr); }
                    mrow[(size_t)c * 16384 + (q * 2 + hk)] = word; }
                __syncthreads();
            }
#undef IDX_LOADA
        }
    }
}

namespace at {
typedef short s16x4 __attribute__((ext_vector_type(4)));
constexpr int NSLOT = 3, SLOTB = 8192;
constexpr int LDS_K = 0, LDS_V = NSLOT * SLOTB, LDS_WS = 2 * NSLOT * SLOTB, LDS_TB = LDS_WS + 8 * 256, LDS_OST = 53248, LDS_BYTES = LDS_OST + 8 * 4096;
constexpr float LOG2E = 1.4426950408889634f;
__device__ __forceinline__ void glds16(const void* gsrc, unsigned lds_dst) { unsigned keep;
    asm volatile("s_mov_b32 %0, m0\n\ts_mov_b32 m0, %2\n\ts_nop 0\n\tglobal_load_lds_dwordx4 %1, off\n\ts_mov_b32 m0, %0" : "=&s"(keep) : "v"(gsrc), "s"(lds_dst) : "memory"); }
#define AT_WAIT_BAR(N) asm volatile("s_waitcnt vmcnt(" #N ") lgkmcnt(0)\n\ts_barrier" ::: "memory")
__device__ __forceinline__ h16x8 vtr8(const LAS unsigned char* p0, const LAS unsigned char* p1) {
    const s16x4 lo = __builtin_amdgcn_ds_read_tr16_b64_v4i16((LAS s16x4*)p0), hi = __builtin_amdgcn_ds_read_tr16_b64_v4i16((LAS s16x4*)p1);
    typedef short s16x8 __attribute__((ext_vector_type(8)));
    const s16x8 v = {lo[0], lo[1], lo[2], lo[3], hi[0], hi[1], hi[2], hi[3]}; return __builtin_bit_cast(h16x8, v); }
__device__ __forceinline__ h16x8 pack8(const f32x16& p, int b) {
    v4u w; w.x = cvt_pk_h16(p[b], p[b + 1]); w.y = cvt_pk_h16(p[b + 2], p[b + 3]); w.z = cvt_pk_h16(p[b + 4], p[b + 5]); w.w = cvt_pk_h16(p[b + 6], p[b + 7]); return __builtin_bit_cast(h16x8, w); }

__device__ __forceinline__ void attn_unit(int b, int h, int qb, const h16* Q, const h16* K, const h16* V, const unsigned* MASK, const float* relb, h16* O, LAS unsigned char* shm) {
    int tid_o = threadIdx.x; asm volatile("" : "+v"(tid_o));
    const int tid = tid_o, lane = tid & 63, r32 = lane & 31, hi = lane >> 5; const int wid = __builtin_amdgcn_readfirstlane(tid >> 6);
    const long rowbase = (long)b * SEQ; const int q0 = qb * 256, qw = q0 + wid * 32, cq = qw >> 6, NT = 4 * qb + 4;
    const h16* Qw = Q + (rowbase + qw) * 512 + h * 64;
    const h16* Kh = K + rowbase * 512 + h * 64; const h16* Vh = V + rowbase * 512 + h * 64;
    const unsigned lds0 = (unsigned)(uintptr_t)shm;
    LAS float* wsf = (LAS float*)(shm + LDS_WS) + wid * 64;
    LAS float* Tb = (LAS float*)(shm + LDS_TB);
    const h16* ksrc = Kh + (long)lane * 512 + wid * 8;
    const h16* vsrc = Vh + (long)(16 * (wid & 3) + (lane >> 2)) * 512 + (wid >> 2) * 32 + (lane & 3) * 8;
    const unsigned kdst = lds0 + LDS_K + wid * 1024, vdst = lds0 + LDS_V + wid * 1024;
#define AT_DMA_K(t, slot) glds16(ksrc + (long)(t) * 64 * 512, (unsigned)__builtin_amdgcn_readfirstlane(kdst + (slot)))
#define AT_DMA_V(t, slot) glds16(vsrc + (long)(t) * 64 * 512, (unsigned)__builtin_amdgcn_readfirstlane(vdst + (slot)))
    AT_DMA_K(0, 0); AT_DMA_V(0, 0); AT_DMA_K(1, SLOTB); AT_DMA_V(1, SLOTB);
    if (tid < 255) Tb[tid] = relb[t5_bucket(tid - 191) * 8 + h] * LOG2E;
    const float b15l = relb[15 * 8 + h] * LOG2E;
    h16x8 qr[4];
#pragma unroll
    for (int d0 = 0; d0 < 4; ++d0) qr[d0] = *(const h16x8*)(Qw + (long)r32 * 512 + d0 * 16 + hi * 8);
    const unsigned* mk = MASK + ((size_t)(b * 128) * 8192 + (qw + r32)) * 2 + hi;
    const LAS unsigned char* kp0 = shm + LDS_K + hi * 1024 + r32 * 16;
    const LAS unsigned char* vp0 = shm + LDS_V + ((lane >> 4) & 1) * 32 + (lane & 3) * 8 + (4 * hi + ((lane & 15) >> 2)) * 64;
    f32x16 o[2]; o[0] = f32x16{}; o[1] = f32x16{};
    float mref = 0.f, l = 0.f;
    int slot = 0, slot2 = 2 * SLOTB;
    unsigned mw_next = mk[0];
#pragma unroll 1
    for (int t = 0; t < NT; ++t) {
        const unsigned mw = mw_next; if (t + 1 < NT) mw_next = mk[(size_t)(t + 1) * 16384];
        if (t + 1 < NT) { AT_WAIT_BAR(2); } else { AT_WAIT_BAR(0); }
        if (t + 2 < NT) { AT_DMA_K(t + 2, slot2); AT_DMA_V(t + 2, slot2); }
        if (t <= cq) {
            const bool nearb = (t >= cq - 2);
            const float c0 = (nearb ? 0.f : b15l) - mref;
            f32x16 p0, p1;
#pragma unroll
            for (int r = 0; r < 16; ++r) { p0[r] = c0; p1[r] = c0; }
            const LAS unsigned char* kb = kp0 + slot;
#pragma unroll
            for (int d0 = 0; d0 < 4; ++d0) { const h16x8 k0 = *(const LAS h16x8*)(kb + d0 * 2048), k1 = *(const LAS h16x8*)(kb + d0 * 2048 + 512);
                p0 = __builtin_amdgcn_mfma_f32_32x32x16_f16(k0, qr[d0], p0, 0, 0, 0); p1 = __builtin_amdgcn_mfma_f32_32x32x16_f16(k1, qr[d0], p1, 0, 0, 0); }
            if (nearb) { const int ib = 64 * t - (qw + r32) + 191 + 4 * hi;
#pragma unroll
                for (int r = 0; r < 16; ++r) { const int kk = (r & 3) + 8 * (r >> 2); p0[r] += Tb[ib + kk]; p1[r] += Tb[ib + 32 + kk]; } }
            float mx = __builtin_fmaxf(__builtin_fmaxf(p0[0], p0[1]), p1[0]);
#pragma unroll
            for (int r = 1; r < 16; ++r) mx = __builtin_fmaxf(__builtin_fmaxf(mx, p0[r]), p1[r]);
            { auto rr = __builtin_amdgcn_permlane32_swap(__float_as_uint(mx), __float_as_uint(mx), false, false); mx = fmaxf(__uint_as_float(rr[0]), __uint_as_float(rr[1])); }
            if (t == 0 || __any(mx > 8.0f)) {
                const float d = (t == 0) ? mx : fmaxf(mx, 0.f); mref += d;
#pragma unroll
                for (int r = 0; r < 16; ++r) { p0[r] -= d; p1[r] -= d; }
                const float f = __builtin_amdgcn_exp2f(-d); l *= f;
                if (t != 0) { if (hi == 0) wsf[r32] = f; LDS_WAIT();
#pragma unroll
                    for (int r = 0; r < 16; ++r) { const float fr = wsf[crow(r, hi)]; o[0][r] *= fr; o[1][r] *= fr; } }
            }
#pragma unroll
            for (int r = 0; r < 16; ++r) {
                unsigned t0, t1;
                asm("v_bfe_i32 %0, %1, %2, 1" : "=v"(t0) : "v"(mw), "n"(15 - r)); asm("v_bfe_i32 %0, %1, %2, 1" : "=v"(t1) : "v"(mw), "n"(31 - r));
                p0[r] = __uint_as_float(__float_as_uint(__builtin_amdgcn_exp2f(p0[r])) & t0);
                p1[r] = __uint_as_float(__float_as_uint(__builtin_amdgcn_exp2f(p1[r])) & t1); }
            const h16x8 pa0 = pack8(p0, 0), pa1 = pack8(p0, 8), pa2 = pack8(p1, 0), pa3 = pack8(p1, 8);
            { typedef _Float16 h2 __attribute__((ext_vector_type(2))); const h2 one2 = {(h16)1.0f, (h16)1.0f}; float ps = 0.f;
#pragma unroll
              for (int k = 0; k < 4; ++k) { const h16x8 pk = (k == 0) ? pa0 : (k == 1) ? pa1 : (k == 2) ? pa2 : pa3;
#pragma unroll
                  for (int e = 0; e < 4; ++e) { const h2 pr = {pk[2 * e], pk[2 * e + 1]}; ps = __builtin_amdgcn_fdot2(pr, one2, ps, false); } }
              l += ps; }
            const LAS unsigned char* vb = vp0 + slot;
#pragma unroll
            for (int d0 = 0; d0 < 2; ++d0) {
                const h16x8 v0 = vtr8(vb + d0 * 4096, vb + d0 * 4096 + 512), v1 = vtr8(vb + d0 * 4096 + 1024, vb + d0 * 4096 + 1024 + 512);
                const h16x8 v2 = vtr8(vb + d0 * 4096 + 2048, vb + d0 * 4096 + 2048 + 512), v3 = vtr8(vb + d0 * 4096 + 3072, vb + d0 * 4096 + 3072 + 512);
                o[d0] = __builtin_amdgcn_mfma_f32_32x32x16_f16(pa0, v0, o[d0], 0, 0, 0); o[d0] = __builtin_amdgcn_mfma_f32_32x32x16_f16(pa1, v1, o[d0], 0, 0, 0);
                o[d0] = __builtin_amdgcn_mfma_f32_32x32x16_f16(pa2, v2, o[d0], 0, 0, 0); o[d0] = __builtin_amdgcn_mfma_f32_32x32x16_f16(pa3, v3, o[d0], 0, 0, 0); }
        }
        slot2 = slot; slot = (slot == (NSLOT - 1) * SLOTB) ? 0 : slot + SLOTB;
    }
    { auto rr = __builtin_amdgcn_permlane32_swap(__float_as_uint(l), __float_as_uint(l), false, false); l = __uint_as_float(rr[0]) + __uint_as_float(rr[1]); }
    if (hi == 0) wsf[32 + r32] = l;
    LDS_WAIT();
    h16* Ow = O + (rowbase + qw) * 512 + h * 64;
    { LAS h16* stg = (LAS h16*)(shm + LDS_OST) + wid * 2048;
#pragma unroll
      for (int r = 0; r < 16; ++r) { const int orow = crow(r, hi); const float rl = 1.0f / wsf[32 + orow];
#pragma unroll
          for (int d0 = 0; d0 < 2; ++d0) stg[orow * 64 + d0 * 32 + r32] = (h16)(o[d0][r] * rl); }
      LDS_WAIT();
#pragma unroll
      for (int i = 0; i < 4; ++i) { const int row = i * 8 + (lane >> 3), ch = lane & 7; const v4u v = *(const LAS v4u*)(stg + row * 64 + ch * 8); *(GAS v4u*)(Ow + (long)row * 512 + ch * 8) = v; } }
    asm volatile("s_waitcnt lgkmcnt(0)\n\ts_barrier" ::: "memory");
#undef AT_DMA_K
#undef AT_DMA_V
}
__device__ __forceinline__ void attn_phase(Frame& F, const Args& A) {
    unsigned char* ws = A.ws;
    for (int v = F.vcu; v < 256; v += F.G) {
        const int bh = v >> 4, s = v & 15;
#pragma unroll 1
        for (int i = 0; i < 2; ++i) attn_unit(bh >> 3, bh & 7, i ? 31 - s : s, (const h16*)(ws + WS_Q), (const h16*)(ws + WS_K), (const h16*)(ws + WS_V), (const unsigned*)(ws + WS_MASK), A.in[12], (h16*)(ws + WS_O), F.lds + RING_OFF);
    }
}
#undef AT_WAIT_BAR
}

__device__ __forceinline__ void attn_norm_phase(Frame& F, const Args& A) {
    unsigned char* ws = A.ws; const h16* O = (const h16*)(ws + WS_O); h16* MERGED = (h16*)(ws + WS_MERGED);
    const f32x4 g0 = *(const f32x4*)(A.in[20] + 8 * F.lane), g1 = *(const f32x4*)(A.in[20] + 8 * F.lane + 4);
    const int gw = F.vcu * NWAVES + F.wave, NGW = F.G * NWAVES;
    for (int row = gw; row < M; row += NGW) {
        const h16x8 v = *(const h16x8*)(O + (size_t)row * 512 + 8 * F.lane); float f[8]; float s = 0.f;
#pragma unroll
        for (int e = 0; e < 8; ++e) { f[e] = (float)v[e]; s += f[e] * f[e]; }
        const float rstd = 1.0f / sqrtf(wave_sum(s) * (1.0f / DATT) + EPS);
        v4u o; o.x = cvt_pk_h16(f[0] * rstd * g0.x, f[1] * rstd * g0.y); o.y = cvt_pk_h16(f[2] * rstd * g0.z, f[3] * rstd * g0.w);
        o.z = cvt_pk_h16(f[4] * rstd * g1.x, f[5] * rstd * g1.y); o.w = cvt_pk_h16(f[6] * rstd * g1.z, f[7] * rstd * g1.w);
        *(GAS v4u*)(MERGED + (size_t)row * 1024 + 8 * F.lane) = o;
    }
}

__global__ void __launch_bounds__(NTHR, 2) fwd_kernel(Args args) {
    extern __shared__ __attribute__((aligned(16))) unsigned char lds[];
    Frame F;
    F.lds = (LAS unsigned char*)lds;
    F.MISC = (volatile LAS unsigned*)(F.lds + MISC_OFF);
    F.tid = threadIdx.x; F.lane = F.tid & 63; F.wave = __builtin_amdgcn_readfirstlane(F.tid >> 6);
    F.G = gridDim.x; { const int bx = blockIdx.x; F.vcu = (F.G % 8 == 0) ? (bx % 8) * (F.G / 8) + bx / 8 : bx; }
    unsigned char* ws = args.ws;
    F.ctl = (gu32*)(ws + WS_CTL);
    for (int u = F.tid; u < (LDS_BYTES - LDSCTL_OFF) / 4; u += NTHR) ((LAS unsigned*)(F.lds + LDSCTL_OFF))[u] = 0u;
    __syncthreads();
    XcdBarrier bar; bar.bar = (unsigned*)(F.ctl + CW_BAR); bar.x = 0; bar.st = nullptr;
    if (N_LAUNCHES == 1) bar = xcd_barrier_post((unsigned*)(F.ctl + CW_BAR), F.MISC + 8);
    const int lo = args.ph_lo, hi = args.ph_hi;
#define IN(k) (lo <= (k) && (k) < hi)
#define SEAM(k) do { if (IN(k) && IN((k) + 1)) xcd_barrier(bar); } while (0)
    const float* mod = (const float*)(ws + WS_MOD);
    h16* H = (h16*)(ws + WS_H); h16* ACT = (h16*)(ws + WS_ACT); float* Y = (float*)(ws + WS_Y);
    const int bx = (int)blockIdx.x;

    if (IN(0)) { p0_prologue(F, args); } SEAM(0);
    if (IN(1)) { thin_phase<false, true>(F, mod, nullptr, nullptr, 0.f, 0, args.in[0], nullptr, args.in[4], 0, 1, H); } SEAM(1);
    if (IN(2)) { pg8::Gemm g{H, (const h16*)(ws + WS_W1GU), M, NGU, D}; pg8::StaticOrder S; S.init(M, NGU, F.G, bx);
        pg8::EpiSwiGLU E{ACT, FF}; pg8::gemm_phase<pg8::EpiSwiGLU, pg8::StaticOrder, true>(F.lds + RING_OFF, g, S, E); } SEAM(2);
    if (IN(3)) { pg8::Gemm g{ACT, (const h16*)(ws + WS_W1D), M, D, FF}; pg8::StaticOrder S; S.init(M, D, F.G, bx);
        pg8::EpiF32 E{Y, D}; pg8::gemm_phase<pg8::EpiF32, pg8::StaticOrder, false>(F.lds + RING_OFF, g, S, E); } SEAM(3);
    if (IN(4)) { thin_phase<true, true>(F, mod, Y, args.in[5], 0.5f, 2, args.in[0], args.out, args.in[9], 3, 4, H); } SEAM(4);
    if (IN(5)) { pg8::Gemm g{H, (const h16*)(ws + WS_WIN), M, NPROJ, D}; pg8::StaticOrder S; S.init(M, NPROJ, F.G, bx);
        pg8::EpiProj E{ws + WS_Q, (size_t)(WS_K - WS_Q), (h16*)(ws + WS_QS), (h16*)(ws + WS_KI), (float*)(ws + WS_WI), (h16*)(ws + WS_LRU)};
        pg8::gemm_phase<pg8::EpiProj, pg8::StaticOrder, true>(F.lds + RING_OFF, g, S, E); } SEAM(5);
    if (IN(6)) { lru_phase<false>(F, args); } if (IN(6) && IN(7)) __syncthreads();
    if (IN(7)) { idx_phase(F, args); } SEAM(7);
    if (IN(8)) { lru_phase<true>(F, args); } if (IN(8) && IN(9)) __syncthreads();
    if (IN(9)) { at::attn_phase(F, args); } SEAM(9);
    if (IN(10)) { attn_norm_phase(F, args); } SEAM(10);
    if (IN(11)) { pg8::Gemm g{(const h16*)(ws + WS_MERGED), (const h16*)(ws + WS_WOUT), M, D, D}; pg8::StaticOrder S; S.init(M, D, F.G, bx);
        pg8::EpiF32 E{Y, D}; pg8::gemm_phase<pg8::EpiF32, pg8::StaticOrder, false>(F.lds + RING_OFF, g, S, E); } SEAM(11);
    if (IN(12)) { thin_phase<true, true>(F, mod, Y, args.in[10], 1.0f, 5, args.out, args.out, args.in[23], 6, 7, H); } SEAM(12);
    if (IN(13)) { pg8::Gemm g{H, (const h16*)(ws + WS_W2GU), M, NGU, D}; pg8::StaticOrder S; S.init(M, NGU, F.G, bx);
        pg8::EpiSwiGLU E{ACT, FF}; pg8::gemm_phase<pg8::EpiSwiGLU, pg8::StaticOrder, true>(F.lds + RING_OFF, g, S, E); } SEAM(13);
    if (IN(14)) { pg8::Gemm g{ACT, (const h16*)(ws + WS_W2D), M, D, FF}; pg8::StaticOrder S; S.init(M, D, F.G, bx);
        pg8::EpiF32 E{Y, D}; pg8::gemm_phase<pg8::EpiF32, pg8::StaticOrder, false>(F.lds + RING_OFF, g, S, E); } SEAM(14);
    if (IN(15)) { thin_phase<true, false>(F, mod, Y, args.in[24], 0.5f, 8, args.out, args.out, nullptr, 0, 0, nullptr); }
#undef IN
#undef SEAM
}

extern "C" void kernel_launch(void* const* d_in, const int* in_sizes, int n_in, void* d_out, int out_size, void* d_ws, size_t ws_size, hipStream_t stream) {
    static int grid = 0;
    if (grid == 0) {
        if (n_in != 28 || in_sizes[0] != M * D || out_size != M * D || ws_size < WS_END) { fprintf(stderr, "kernel_launch: unexpected shapes (n_in %d, in0 %d, out %d, ws %zu); nothing launched\n", n_in, n_in > 0 ? in_sizes[0] : -1, out_size, ws_size); grid = -1; return; }
        int dev = 0, cus = 0, per_cu = 0;
        if (hipGetDevice(&dev) != hipSuccess || hipDeviceGetAttribute(&cus, hipDeviceAttributeMultiprocessorCount, dev) != hipSuccess) { grid = -1; return; }
        if (hipFuncSetAttribute((const void*)fwd_kernel, hipFuncAttributeMaxDynamicSharedMemorySize, LDS_BYTES) != hipSuccess) { fprintf(stderr, "kernel_launch: hipFuncSetAttribute failed\n"); grid = -1; return; }
        if (hipOccupancyMaxActiveBlocksPerMultiprocessor(&per_cu, (const void*)fwd_kernel, NTHR, LDS_BYTES) != hipSuccess || per_cu < 1) { fprintf(stderr, "kernel_launch: occupancy query reports %d\n", per_cu); }
        (void)hipGetLastError();
        grid = cus;
    }
    if (grid < 0) return;
    if (hipMemsetAsync((char*)d_ws + WS_CTL, 0, CTL_ZERO_BYTES, stream) != hipSuccess) return;
    Args a{};
    for (int i = 0; i < 28; ++i) a.in[i] = (const float*)d_in[i];
    a.out = (float*)d_out; a.ws = (unsigned char*)d_ws;
    if (N_LAUNCHES == 1) { a.ph_lo = 0; a.ph_hi = N_PHASES; a.li = 0; hipLaunchKernelGGL(fwd_kernel, dim3(grid), dim3(NTHR), LDS_BYTES, stream, a); }
    else { for (int p = 0; p < N_PHASES; ++p) { a.ph_lo = p; a.ph_hi = p + 1; a.li = p; const int reps = (p == PROBE_PHASE) ? 2 : 1;
        for (int rr = 0; rr < reps; ++rr) { a.pad = (reps == 2 && rr == 0) ? PROBE_DIAG : 0; hipLaunchKernelGGL(fwd_kernel, dim3(grid), dim3(NTHR), LDS_BYTES, stream, a); } } }
}
```
